# Optimizing an MI355X kernel written in HIP

```python
import jax, jax.numpy as jnp
from jax import lax
import numpy as np

D_MODEL = 1024
BATCH = 16
SEQ = 256
DEPTH = 4
DEC_BATCH = 2
DEC_SEQ = 4096
PAST_LEN = 256

GRID_W = 64
N_MIXERS = 3
N_CONV_LAYERS = (DEPTH + 2) // 3
N_POOL_LAYERS = (DEPTH + 1) // 3
N_ATTN_LAYERS = DEPTH // 3
N_HEADS = 8
N_KV_HEADS = 2
HEAD_DIM = 128
ROPE_AXIS_DIM = HEAD_DIM // 2
ROPE_THETA = 10000.0
Q_BLOCK = 128
CONV_WIDTH = 3
POOL_WINDOWS = (2, 4, 8, 16)
N_POOL_GROUPS = 4
POOL_GROUP_DIM = D_MODEL // N_POOL_GROUPS
D_FF = ((8 * D_MODEL // 3 + 255) // 256) * 256
N_MOD = 6
EPS = 1e-6
ATTN_SCALE = HEAD_DIM ** -0.5

kernel_name = 'hybrid_flow_prefix_trunk_step'


def rms_norm(x, w):
    xf = x.astype(jnp.float32)
    y = xf * lax.rsqrt(jnp.mean(xf * xf, axis=-1, keepdims=True) + EPS)
    return (y * w.astype(jnp.float32)).astype(x.dtype)


def adaln(c, w, b):
    m = (jax.nn.silu(c) @ w + b).reshape(c.shape[0], N_MOD, 1, D_MODEL)
    return [m[:, i] for i in range(N_MOD)]


def modulate(x, shift, scale):
    return x * (1 + scale) + shift


def short_conv_mixer(h, w_in, conv_w, w_out):
    b, cg, u = jnp.split(h @ w_in, 3, axis=-1)
    z = cg * u
    zp = jnp.pad(z, ((0, 0), (1, 1), (0, 0)))
    conv = zp[:, :-2] * conv_w[0] + zp[:, 1:-1] * conv_w[1] + zp[:, 2:] * conv_w[2]
    return (b * conv) @ w_out


def pool_mixer(h, w_pool, scale):
    B, T, D = h.shape
    hf = h.astype(jnp.float32)
    cs = jnp.concatenate([jnp.zeros((B, 1, D), jnp.float32), jnp.cumsum(hf, axis=1)], axis=1)
    csg = cs.reshape(B, T + 1, N_POOL_GROUPS, POOL_GROUP_DIM)
    t = jnp.arange(T)
    pooled = []
    for g, w in enumerate(POOL_WINDOWS):
        lo = jnp.clip(t - w // 2, 0, T)
        hi = jnp.clip(t + w // 2, 0, T)
        cnt = (hi - lo).astype(jnp.float32)[None, :, None]
        pooled.append((csg[:, hi, g] - csg[:, lo, g]) / cnt)
    pooled = jnp.stack(pooled, axis=2)
    diff = (pooled - hf.reshape(B, T, N_POOL_GROUPS, POOL_GROUP_DIM)).astype(h.dtype)
    out = jnp.einsum('btgc,gcd->btgd', diff, w_pool).reshape(B, T, D)
    return out * scale


def swiglu(h, w_in, w_out):
    g, u = jnp.split(h @ w_in, 2, axis=-1)
    return (jax.nn.silu(g) * u) @ w_out


def qkv_project(h, w_qkv, q_norm_w, k_norm_w):
    B, T, _ = h.shape
    qkv = h @ w_qkv
    q = qkv[..., :N_HEADS * HEAD_DIM].reshape(B, T, N_HEADS, HEAD_DIM)
    k = qkv[..., N_HEADS * HEAD_DIM:(N_HEADS + N_KV_HEADS) * HEAD_DIM].reshape(B, T, N_KV_HEADS, HEAD_DIM)
    v = qkv[..., (N_HEADS + N_KV_HEADS) * HEAD_DIM:].reshape(B, T, N_KV_HEADS, HEAD_DIM)
    q = rms_norm(q, q_norm_w)
    k = rms_norm(k, k_norm_w)
    return (jnp.transpose(q, (0, 2, 1, 3)), jnp.transpose(k, (0, 2, 1, 3)),
            jnp.transpose(v, (0, 2, 1, 3)))


def rope_axis(x, cos, sin):
    x1, x2 = jnp.split(x, 2, axis=-1)
    return jnp.concatenate([x1 * cos - x2 * sin, x2 * cos + x1 * sin], axis=-1)


def apply_rope_2d(x, cos_r, sin_r, cos_c, sin_c):
    xr = rope_axis(x[..., :ROPE_AXIS_DIM], cos_r.astype(x.dtype), sin_r.astype(x.dtype))
    xc = rope_axis(x[..., ROPE_AXIS_DIM:], cos_c.astype(x.dtype), sin_c.astype(x.dtype))
    return jnp.concatenate([xr, xc], axis=-1)


def block_attention(q, k, v):
    B, Hq, T, Dh = q.shape
    Hkv = k.shape[1]
    G = Hq // Hkv
    nb = T // Q_BLOCK
    qb = jnp.moveaxis(q.reshape(B, Hkv, G, nb, Q_BLOCK, Dh), 3, 0)

    def one_block(qblk):
        s = jnp.einsum('bhgqd,bhkd->bhgqk', qblk, k,
                       preferred_element_type=jnp.float32) * ATTN_SCALE
        p = jax.nn.softmax(s, axis=-1).astype(v.dtype)
        return jnp.einsum('bhgqk,bhkd->bhgqd', p, v)

    ob = lax.map(one_block, qb)
    return jnp.moveaxis(ob, 0, 3).reshape(B, Hq, T, Dh)


def merge_heads(o, w_out):
    B, H, T, Dh = o.shape
    return jnp.transpose(o, (0, 2, 1, 3)).reshape(B, T, H * Dh) @ w_out


def setup_inputs(seed: int = 0) -> dict:
    key = jax.random.key(seed)
    ks = jax.random.split(key, 24)
    nrm = jax.random.normal
    f32 = jnp.float32
    D = D_MODEL
    qkv_out = (N_HEADS + 2 * N_KV_HEADS) * HEAD_DIM
    return {
        'x_prompt': nrm(ks[0], (BATCH, SEQ, D), f32),
        'x_sample': nrm(ks[1], (DEC_BATCH, DEC_SEQ, D), f32),
        'cache_k': nrm(ks[2], (DEC_BATCH, N_ATTN_LAYERS, N_KV_HEADS, PAST_LEN, HEAD_DIM), f32),
        'cache_v': nrm(ks[3], (DEC_BATCH, N_ATTN_LAYERS, N_KV_HEADS, PAST_LEN, HEAD_DIM), f32),
        'c': nrm(ks[4], (DEC_BATCH, D), f32),
        'c_ctx': nrm(ks[5], (D,), f32),
        'norm1_w': 1.0 + 0.05 * nrm(ks[6], (DEPTH, D), f32),
        'norm2_w': 1.0 + 0.05 * nrm(ks[7], (DEPTH, D), f32),
        'ada_w': 0.5 * D ** -0.5 * nrm(ks[8], (DEPTH, D, N_MOD * D), f32),
        'ada_b': 0.01 * nrm(ks[9], (DEPTH, N_MOD * D), f32),
        'conv_in_w': D ** -0.5 * nrm(ks[10], (N_CONV_LAYERS, D, 3 * D), f32),
        'conv_w': CONV_WIDTH ** -0.5 * nrm(ks[11], (N_CONV_LAYERS, CONV_WIDTH, D), f32),
        'conv_out_w': D ** -0.5 * nrm(ks[12], (N_CONV_LAYERS, D, D), f32),
        'pool_w': POOL_GROUP_DIM ** -0.5 * nrm(ks[13], (N_POOL_LAYERS, N_POOL_GROUPS, POOL_GROUP_DIM, POOL_GROUP_DIM), f32),
        'pool_scale': 1.0 + 0.1 * nrm(ks[14], (N_POOL_LAYERS, D), f32),
        'attn_qkv_w': D ** -0.5 * nrm(ks[15], (N_ATTN_LAYERS, D, qkv_out), f32),
        'q_norm_w': 1.0 + 0.05 * nrm(ks[16], (N_ATTN_LAYERS, HEAD_DIM), f32),
        'k_norm_w': 1.0 + 0.05 * nrm(ks[17], (N_ATTN_LAYERS, HEAD_DIM), f32),
        'attn_out_w': (N_HEADS * HEAD_DIM) ** -0.5 * nrm(ks[18], (N_ATTN_LAYERS, N_HEADS * HEAD_DIM, D), f32),
        'ffn_in_w': D ** -0.5 * nrm(ks[19], (DEPTH, D, 2 * D_FF), f32),
        'ffn_out_w': D_FF ** -0.5 * nrm(ks[20], (DEPTH, D_FF, D), f32),
        'final_norm_w': 1.0 + 0.05 * nrm(ks[21], (D,), f32),
    }


def reference(x_prompt, x_sample, cache_k, cache_v, c, c_ctx, norm1_w, norm2_w, ada_w, ada_b,
              conv_in_w, conv_w, conv_out_w, pool_w, pool_scale, attn_qkv_w, q_norm_w, k_norm_w,
              attn_out_w, ffn_in_w, ffn_out_w, final_norm_w):
    T = x_sample.shape[1]
    rows = T // GRID_W
    row = jnp.repeat(jnp.arange(rows), GRID_W).astype(jnp.float32)
    col = jnp.tile(jnp.arange(GRID_W), rows).astype(jnp.float32)
    inv_freq = ROPE_THETA ** (-jnp.arange(0, ROPE_AXIS_DIM, 2, dtype=jnp.float32) / ROPE_AXIS_DIM)
    ang_r = row[:, None] * inv_freq[None, :]
    ang_c = col[:, None] * inv_freq[None, :]
    cos_r, sin_r, cos_c, sin_c = jnp.cos(ang_r), jnp.sin(ang_r), jnp.cos(ang_c), jnp.sin(ang_c)

    xp, xs = x_prompt, x_sample
    new_k, new_v = [], []
    for i in range(DEPTH):
        kind = i % N_MIXERS
        j = i // N_MIXERS
        mod_p = adaln(c_ctx[None, :], ada_w[i], ada_b[i])
        mod_s = adaln(c, ada_w[i], ada_b[i])
        hp = modulate(rms_norm(xp, norm1_w[i]), mod_p[0], mod_p[1])
        hs = modulate(rms_norm(xs, norm1_w[i]), mod_s[0], mod_s[1])
        if kind == 0:
            mp = short_conv_mixer(hp, conv_in_w[j], conv_w[j], conv_out_w[j])
            ms = short_conv_mixer(hs, conv_in_w[j], conv_w[j], conv_out_w[j])
        elif kind == 1:
            mp = pool_mixer(hp, pool_w[j], pool_scale[j])
            ms = pool_mixer(hs, pool_w[j], pool_scale[j])
        else:
            qp, kp, vp = qkv_project(hp, attn_qkv_w[j], q_norm_w[j], k_norm_w[j])
            new_k.append(kp)
            new_v.append(vp)
            mp = merge_heads(block_attention(qp, kp, vp), attn_out_w[j])
            qs, ks_, vs = qkv_project(hs, attn_qkv_w[j], q_norm_w[j], k_norm_w[j])
            qs = apply_rope_2d(qs, cos_r, sin_r, cos_c, sin_c)
            ks_ = apply_rope_2d(ks_, cos_r, sin_r, cos_c, sin_c)
            k_all = jnp.concatenate([cache_k[:, j].astype(ks_.dtype), ks_], axis=2)
            v_all = jnp.concatenate([cache_v[:, j].astype(vs.dtype), vs], axis=2)
            ms = merge_heads(block_attention(qs, k_all, v_all), attn_out_w[j])
        xp = xp + mod_p[2] * mp
        xs = xs + mod_s[2] * ms
        hp = modulate(rms_norm(xp, norm2_w[i]), mod_p[3], mod_p[4])
        hs = modulate(rms_norm(xs, norm2_w[i]), mod_s[3], mod_s[4])
        xp = xp + mod_p[5] * swiglu(hp, ffn_in_w[i], ffn_out_w[i])
        xs = xs + mod_s[5] * swiglu(hs, ffn_in_w[i], ffn_out_w[i])

    y_prompt = rms_norm(xp, final_norm_w)
    y_sample = rms_norm(xs, final_norm_w)
    new_k_arr = jnp.stack(new_k, axis=1)
    new_v_arr = jnp.stack(new_v, axis=1)
    return (y_prompt, y_sample, new_k_arr, new_v_arr)
```

```cpp
#include <hip/hip_runtime.h>
#include <hip/hip_cooperative_groups.h>
#include <cstdio>
#include <cstdint>
namespace cg = cooperative_groups;

#ifndef MK_MULTI
#define MK_MULTI 0
#endif

#ifndef REP_PREP
#define REP_PREP 1
#endif
#ifndef REP_NORM
#define REP_NORM 1
#endif
#ifndef REP_FIN
#define REP_FIN 1
#endif
#ifndef REP_FOUT
#define REP_FOUT 1
#endif
#ifndef REP_CIN
#define REP_CIN 1
#endif
#ifndef REP_ATT
#define REP_ATT 1
#endif
#ifndef REP_EW
#define REP_EW 1
#endif
#ifndef REP_MIXOUT
#define REP_MIXOUT 1
#endif
#ifndef MF_FIN
#define MF_FIN 4
#endif
#ifndef MF_CIN
#define MF_CIN 3
#endif
#ifndef MF_QKV
#define MF_QKV 3
#endif
#ifndef MF_RES
#define MF_RES 3
#endif
#define LAS __attribute__((address_space(3)))
typedef unsigned short bf16_t;
typedef short bf16x8 __attribute__((ext_vector_type(8)));
typedef short s16x4 __attribute__((ext_vector_type(4)));
typedef float f32x4 __attribute__((ext_vector_type(4)));
typedef float f32x16 __attribute__((ext_vector_type(16)));
typedef unsigned u32x4 __attribute__((ext_vector_type(4)));
typedef unsigned u32x2 __attribute__((ext_vector_type(2)));

constexpr int DM = 1024, NP = 4096  , NS = 8192  , MT = NP + NS;
constexpr int SEQP = 256, SEQS = 4096, PAST = 256, SKV_S = PAST + SEQS;
constexpr int DFF = 2816, NMOD = 6, NQKV = 1536;
constexpr int NTHREADS = 512;
constexpr int NSW = 2 * 3072 + 1536 + 4 * 5632;
constexpr int LDS_BYTES = 132 * 1024;

constexpr size_t AL(size_t x) { return (x + 255) / 256 * 256; }
constexpr size_t WS_MOD   = 0;
constexpr size_t WS_CIN   = AL(WS_MOD + 4ull * 3 * 6 * 1024 * 4);
constexpr size_t WS_COUT  = AL(WS_CIN + 2ull * 3072 * 1024 * 2);
constexpr size_t WS_POOL  = AL(WS_COUT + 2ull * 1024 * 1024 * 2);
constexpr size_t WS_QKVW  = AL(WS_POOL + 4ull * 256 * 256 * 2);
constexpr size_t WS_AOUT  = AL(WS_QKVW + 1536ull * 1024 * 2);
constexpr size_t WS_FIN   = AL(WS_AOUT + 1024ull * 1024 * 2);
constexpr size_t WS_FOUT  = AL(WS_FIN + 4ull * 5632 * 1024 * 2);
constexpr size_t WS_X     = AL(WS_FOUT + 4ull * 1024 * 2816 * 2);
constexpr size_t WS_H     = AL(WS_X + (size_t)MT * 1024 * 4);
constexpr size_t WS_A2    = AL(WS_H + (size_t)MT * 1024 * 2);
constexpr size_t WS_BB    = AL(WS_A2 + (size_t)MT * 1024 * 2);
constexpr size_t WS_Z     = AL(WS_BB + (size_t)MT * 1024 * 2);
constexpr size_t WS_ACT   = AL(WS_Z + (size_t)MT * 1024 * 2);
constexpr size_t WS_QKV   = WS_BB;
constexpr size_t WS_Q     = WS_H;
constexpr size_t WS_KP    = AL(WS_ACT + (size_t)MT * 2816 * 2);
constexpr size_t WS_VP    = AL(WS_KP + 16ull * 2 * 256 * 128 * 2);
constexpr size_t WS_KS    = AL(WS_VP + 16ull * 2 * 256 * 128 * 2);
constexpr size_t WS_VS    = AL(WS_KS + 2ull * 2 * SKV_S * 128 * 2);
constexpr size_t WS_SSQ   = AL(WS_VS + 2ull * 2 * SKV_S * 128 * 2);
constexpr size_t WS_SW    = AL(WS_SSQ + (size_t)MT * 16 * 4);
constexpr size_t WS_BAR   = AL(WS_SW + 3ull * 30208 * 4);
constexpr size_t WS_X2    = AL(WS_BAR + 16384);
constexpr size_t WS_END   = AL(WS_X2 + (size_t)MT * 1024 * 4);

struct Params {
    const float* in[22];
    float* out;
    unsigned char* ws;
    int ph_lo, ph_hi;
};

__device__ __forceinline__ unsigned cvt_pk_bf16(float lo, float hi) { unsigned r; asm volatile("v_cvt_pk_bf16_f32 %0, %1, %2" : "=v"(r) : "v"(lo), "v"(hi)); return r; }
__device__ __forceinline__ float bf2f(unsigned short b) { return __uint_as_float(((unsigned)b) << 16); }
__device__ __forceinline__ float bflo(unsigned w) { return __uint_as_float(w << 16); }
__device__ __forceinline__ float bfhi(unsigned w) { return __uint_as_float(w & 0xffff0000u); }
__device__ __forceinline__ float silu_f(float x) { return x * __builtin_amdgcn_rcpf(1.0f + __builtin_amdgcn_exp2f(-1.4426950408889634f * x)); }
__device__ __forceinline__ int tid_opaque() { int t = threadIdx.x; asm volatile("" : "+v"(t)); return t; }
__device__ __forceinline__ float quad_row_sum(float s) {
    { auto r = __builtin_amdgcn_permlane16_swap(__float_as_uint(s), __float_as_uint(s), false, false); s = __uint_as_float(r[0]) + __uint_as_float(r[1]); }
    { auto r = __builtin_amdgcn_permlane32_swap(__float_as_uint(s), __float_as_uint(s), false, false); s = __uint_as_float(r[0]) + __uint_as_float(r[1]); }
    return s;
}
__device__ __forceinline__ float wave_sum(float v) {
#pragma unroll
    for (int o = 32; o >= 1; o >>= 1) v += __shfl_xor(v, o);
    return v;
}

namespace pg8 {
constexpr int BM = 256, BK = 64, HALF = 128, HTB = HALF * BK * 2, STAGE_BYTES = 8 * HTB, NXCD = 8, WGM = 8;
__host__ __device__ __forceinline__ int lds_byte(int r, int c) { const int st = (r >> 4) * 2 + (c >> 5), rr = r & 15, cc = c & 31, ob = rr * 64 + cc * 2; return st * 1024 + (ob ^ (((ob >> 9) & 1) << 5)); }
__host__ __device__ __forceinline__ void stage_rc(int b, int& R, int& C) { const int st = b / 1024, sb = b % 1024, swz = sb ^ (((sb >> 9) & 1) << 5); R = (st >> 1) * 16 + swz / 64; C = (st & 1) * 32 + (swz % 64) / 2; }
__host__ __device__ __forceinline__ int perm32(int rho) { const int n = rho >> 4, i = rho & 15; return 8 * (i >> 2) + 4 * n + (i & 3); }

struct Unit { int pm, pn; };
struct Gemm { const bf16_t* A; const bf16_t* Bt; int M, N, K, lda, a_pn_off; };

struct StaticOrder {
    int nM, nN, nwg, G, c, wgm;
    __device__ void init(int M, int N, int G_, int c_, int tile_rows) { nM = M / tile_rows; nN = N / BM; nwg = nM * nN; G = G_; c = c_; wgm = (nM % 8 == 0) ? nM / 8 : WGM; }
    __device__ bool next(int i, Unit& u) const {
        const long L = (long)i * G + c; if (L >= nwg) return false;
        int wgid = (int)L; { const int q = nwg / NXCD, r = nwg % NXCD, xcd = wgid % NXCD, off = wgid / NXCD; wgid = (xcd < r ? xcd * (q + 1) : r * (q + 1) + (xcd - r) * q) + off; }
        const int nig = wgm * nN, gid = wgid / nig, fm = gid * wgm, gsz = (nM - fm) < wgm ? (nM - fm) : wgm;
        u.pm = fm + ((wgid % nig) % gsz); u.pn = (wgid % nig) / gsz; return true;
    }
};

template <int MF, class Epi>
__device__ __forceinline__ void gemm_phase(LAS unsigned char* lds, const Gemm g, const StaticOrder& S, const Epi& E) {
    const int tid = tid_opaque(), wid = __builtin_amdgcn_readfirstlane(tid >> 6), lane = tid & 63, wr = wid >> 2, wc = wid & 3, fr = lane & 15, fq = lane >> 4;
    const int K = g.K, nt = K / BK, lda = g.lda;
    unsigned voffA[2], voffB[2];
#pragma unroll
    for (int i = 0; i < 2; ++i) { int R, C; stage_rc(tid * 16 + i * 8192, R, C); const int Rb = Epi::PERM ? ((R & ~31) + perm32(R & 31)) : R;
        voffA[i] = (unsigned)(R * lda + C) * 2u; voffB[i] = (unsigned)(Rb * K + C) * 2u; }
    const size_t kstep = (size_t)(BK * 2);
    const size_t hstepA = (size_t)(32 * MF) * lda * 2, hstepB = (size_t)HALF * K * 2;
    const size_t tstepA = 2 * hstepA, tstepB = 2 * hstepB;
    const size_t pnoffA = (size_t)g.a_pn_off * 2;
    const unsigned ldsw = (unsigned)wid * 1024u;
    const int aoff = lds_byte(wr * 16 * MF + fr, fq * 8), boff = lds_byte(wc * 32 + fr, fq * 8);
#define PG8_SA(b, h) (((b) * 2 + (h)) * HTB)
#define PG8_SB(b, h) ((4 + (b) * 2 + (h)) * HTB)
#define PG8_STAGE(bufoff, gbase, voff) do { _Pragma("unroll") for (int _i = 0; _i < 2; ++_i) \
        __builtin_amdgcn_global_load_lds((const unsigned*)((const char*)(gbase) + (voff)[_i]), (LAS unsigned*)(lds + (bufoff) + ldsw + _i * 8192), 16, 0, 0); } while (0)
#define PG8_LDA(dst, b, h) do { _Pragma("unroll") for (int m = 0; m < MF; ++m) _Pragma("unroll") for (int k = 0; k < 2; ++k) dst[m][k] = *(const LAS bf16x8*)(lds + PG8_SA(b, h) + aoff + m * 2048 + k * 1024); } while (0)
#define PG8_LDB(dst, b, h) do { _Pragma("unroll") for (int n = 0; n < 2; ++n) _Pragma("unroll") for (int k = 0; k < 2; ++k) dst[n][k] = *(const LAS bf16x8*)(lds + PG8_SB(b, h) + boff + n * 2048 + k * 1024); } while (0)
#define PG8_MMA(ai, bj, At, Bt) do { __builtin_amdgcn_s_setprio(1); _Pragma("unroll") for (int m = 0; m < MF; ++m) _Pragma("unroll") for (int n = 0; n < 2; ++n) _Pragma("unroll") for (int k = 0; k < 2; ++k) \
        acc[ai][bj][m][n] = __builtin_amdgcn_mfma_f32_16x16x32_bf16(Bt[n][k], At[m][k], acc[ai][bj][m][n], 0, 0, 0); __builtin_amdgcn_s_setprio(0); } while (0)
#define PG8_WAIT_V(n) asm volatile("s_waitcnt vmcnt(" #n ")" ::: "memory")
#define PG8_WAIT_L(n) asm volatile("s_waitcnt lgkmcnt(" #n ")" ::: "memory")
#define PG8_BAR __builtin_amdgcn_s_barrier()
#define PG8_SCHED __builtin_amdgcn_sched_barrier(0)
    Unit cur, nxt; int ui = 0;
    if (!S.next(0, cur)) return;
    f32x4 acc[2][2][MF][2];
#pragma unroll
    for (int a = 0; a < 2; ++a)
#pragma unroll
        for (int b = 0; b < 2; ++b)
#pragma unroll
            for (int m = 0; m < MF; ++m)
#pragma unroll
                for (int n = 0; n < 2; ++n) acc[a][b][m][n] = (f32x4){0.f, 0.f, 0.f, 0.f};
    bf16x8 At[MF][2], B0[2][2], B1[2][2];
    const char* cA = (const char*)g.A + (size_t)cur.pm * tstepA + (size_t)cur.pn * pnoffA; const char* cB = (const char*)g.Bt + (size_t)cur.pn * tstepB;
    PG8_STAGE(PG8_SB(0, 0), cB, voffB); PG8_STAGE(PG8_SA(0, 0), cA, voffA); PG8_STAGE(PG8_SB(0, 1), cB + hstepB, voffB); PG8_STAGE(PG8_SA(0, 1), cA + hstepA, voffA);
    if (wr == 1) PG8_BAR;
    PG8_WAIT_V(4); PG8_BAR;
    PG8_STAGE(PG8_SB(1, 0), cB + kstep, voffB); PG8_STAGE(PG8_SA(1, 0), cA + kstep, voffA); PG8_STAGE(PG8_SB(1, 1), cB + hstepB + kstep, voffB);
    PG8_WAIT_V(6); PG8_BAR;
    for (;;) {
        const bool has_next = S.next(ui + 1, nxt);
        const char* nA = has_next ? (const char*)g.A + (size_t)nxt.pm * tstepA + (size_t)nxt.pn * pnoffA : cA; const char* nB = has_next ? (const char*)g.Bt + (size_t)nxt.pn * tstepB : cB;
        for (int t = 0; t < nt; t += 2) {
            const bool last = (t == nt - 2);
            const char* a1 = cA + (size_t)(t + 1) * kstep;
            const char* a2 = last ? nA : cA + (size_t)(t + 2) * kstep; const char* b2 = last ? nB : cB + (size_t)(t + 2) * kstep;
            const char* a3 = a2 + kstep; const char* b3 = b2 + kstep;
            PG8_LDB(B0, 0, 0); PG8_SCHED; PG8_LDA(At, 0, 0); PG8_STAGE(PG8_SA(1, 1), a1 + hstepA, voffA);
            PG8_WAIT_L(8); PG8_BAR; PG8_WAIT_L(0); PG8_MMA(0, 0, At, B0); PG8_BAR; PG8_SCHED;
            PG8_LDB(B1, 0, 1); PG8_STAGE(PG8_SB(0, 0), b2, voffB);
            PG8_BAR; PG8_WAIT_L(0); PG8_MMA(0, 1, At, B1); PG8_BAR;
            PG8_LDA(At, 0, 1); PG8_STAGE(PG8_SA(0, 0), a2, voffA);
            PG8_BAR; PG8_WAIT_L(0); PG8_MMA(1, 0, At, B0); PG8_BAR; PG8_SCHED;
            PG8_STAGE(PG8_SB(0, 1), b2 + hstepB, voffB);
            PG8_WAIT_V(6); PG8_BAR; PG8_MMA(1, 1, At, B1); PG8_BAR;
            PG8_LDB(B0, 1, 0); PG8_SCHED; PG8_LDA(At, 1, 0); PG8_STAGE(PG8_SA(0, 1), a2 + hstepA, voffA);
            PG8_WAIT_L(8); PG8_BAR; PG8_WAIT_L(0); PG8_MMA(0, 0, At, B0); PG8_BAR; PG8_SCHED;
            PG8_LDB(B1, 1, 1); PG8_STAGE(PG8_SB(1, 0), b3, voffB);
            PG8_BAR; PG8_WAIT_L(0); PG8_MMA(0, 1, At, B1); PG8_BAR;
            PG8_LDA(At, 1, 1); PG8_STAGE(PG8_SA(1, 0), a3, voffA);
            PG8_BAR; PG8_WAIT_L(0); PG8_MMA(1, 0, At, B0); PG8_BAR; PG8_SCHED;
            PG8_STAGE(PG8_SB(1, 1), b3 + hstepB, voffB);
            PG8_WAIT_V(6); PG8_BAR; PG8_MMA(1, 1, At, B1); PG8_BAR;
        }
        E(acc, cur, wr, wc, fr, fq);
        if (!has_next) break;
#pragma unroll
        for (int a = 0; a < 2; ++a)
#pragma unroll
            for (int b = 0; b < 2; ++b)
#pragma unroll
                for (int m = 0; m < MF; ++m)
#pragma unroll
                    for (int n = 0; n < 2; ++n) acc[a][b][m][n] = (f32x4){0.f, 0.f, 0.f, 0.f};
        cur = nxt; cA = nA; cB = nB; ++ui;
    }
    PG8_WAIT_V(0);
    if (wr == 0) PG8_BAR;
    PG8_BAR;
#undef PG8_SA
#undef PG8_SB
#undef PG8_STAGE
#undef PG8_LDA
#undef PG8_LDB
#undef PG8_MMA
#undef PG8_WAIT_V
#undef PG8_WAIT_L
#undef PG8_BAR
#undef PG8_SCHED
}

__device__ __forceinline__ int grp_of_row(int row) { return row < NP ? 0 : (row < NP + SEQS ? 1 : 2); }
__device__ __forceinline__ float row_rstd1(const float* ssq, int row, int fq) {
    const f32x4 p = *(const f32x4*)(ssq + (size_t)row * 16 + fq * 4);
    float s = (p[0] + p[1]) + (p[2] + p[3]);
    s = quad_row_sum(s);
    return __builtin_amdgcn_rsqf(s * (1.0f / 1024.0f) + 1e-6f);
}

template <int MF> struct EpiBf16N {
    static constexpr bool PERM = true;
    bf16_t* C; int ldc; const float* ssq; const float* sw;
    __device__ __forceinline__ void operator()(const f32x4 (&acc)[2][2][MF][2], const Unit& u, int wr, int wc, int fr, int fq) const {
        const int row0 = u.pm * (64 * MF) + wr * (16 * MF) + fr, col0 = u.pn * BM + wc * 32 + 8 * fq;
        f32x4 sv[2][2]; int curg = -1;
#pragma unroll
        for (int ai = 0; ai < 2; ++ai)
#pragma unroll
            for (int m = 0; m < MF; ++m) { const int row = row0 + ai * (32 * MF) + m * 16; bf16_t* rowp = C + (size_t)row * ldc + col0;
                const float rs = row_rstd1(ssq, row, fq); const int grp = grp_of_row(row);
                if (grp != curg) { curg = grp; const float* swp = sw + grp * NSW + col0;
#pragma unroll
                    for (int bj = 0; bj < 2; ++bj) { sv[bj][0] = *(const f32x4*)(swp + bj * HALF); sv[bj][1] = *(const f32x4*)(swp + bj * HALF + 4); } }
#pragma unroll
                for (int bj = 0; bj < 2; ++bj) { const f32x4 v0 = acc[ai][bj][m][0] * rs + sv[bj][0], v1 = acc[ai][bj][m][1] * rs + sv[bj][1];
                    u32x4 w; w.x = cvt_pk_bf16(v0[0], v0[1]); w.y = cvt_pk_bf16(v0[2], v0[3]); w.z = cvt_pk_bf16(v1[0], v1[1]); w.w = cvt_pk_bf16(v1[2], v1[3]);
                    *(u32x4*)(rowp + bj * HALF) = w; } }
    }
};
template <int MF> struct EpiResid {
    static constexpr bool PERM = true;
    const bf16_t* base; bf16_t* out; const float* gate; const float* cscale;
    bf16_t* xg; float* ssq; const float* nw; const float* nscale;
    __device__ __forceinline__ void operator()(const f32x4 (&acc)[2][2][MF][2], const Unit& u, int wr, int wc, int fr, int fq) const {
        const int row0 = u.pm * (64 * MF) + wr * (16 * MF) + fr, col0 = u.pn * BM + wc * 32 + 8 * fq;
        f32x4 gvh[2][2], gnh[2][2]; int curg = -1;
#pragma unroll
        for (int ai = 0; ai < 2; ++ai)
#pragma unroll
            for (int m = 0; m < MF; ++m) { const int row = row0 + ai * (32 * MF) + m * 16; const int grp = grp_of_row(row);
                const bf16_t* bp = base + (size_t)row * DM + col0; bf16_t* op = out + (size_t)row * DM + col0;
                if (grp != curg) { curg = grp;
                    const float* gp = gate + grp * (NMOD * DM) + col0; const float* np_ = nscale + grp * (NMOD * DM) + col0;
#pragma unroll
                    for (int bj = 0; bj < 2; ++bj)
#pragma unroll
                        for (int n = 0; n < 2; ++n) { gvh[bj][n] = *(const f32x4*)(gp + bj * HALF + n * 4); if (cscale) gvh[bj][n] *= *(const f32x4*)(cscale + col0 + bj * HALF + n * 4);
                            gnh[bj][n] = xg ? *(const f32x4*)(nw + col0 + bj * HALF + n * 4) * (1.0f + *(const f32x4*)(np_ + bj * HALF + n * 4)) : (f32x4){0.f, 0.f, 0.f, 0.f}; } }
                float s = 0.f;
#pragma unroll
                for (int bj = 0; bj < 2; ++bj) { f32x4 h[2], x[2];
                    const u32x4 bw = *(const u32x4*)(bp + bj * HALF);
                    const f32x4 b0 = {bflo(bw.x), bfhi(bw.x), bflo(bw.y), bfhi(bw.y)}, b1 = {bflo(bw.z), bfhi(bw.z), bflo(bw.w), bfhi(bw.w)};
#pragma unroll
                    for (int n = 0; n < 2; ++n) {
                        x[n] = (n == 0 ? b0 : b1) + gvh[bj][n] * acc[ai][bj][m][n];
                        s += (x[n][0] * x[n][0] + x[n][1] * x[n][1]) + (x[n][2] * x[n][2] + x[n][3] * x[n][3]);
                        if (xg) h[n] = x[n] * gnh[bj][n]; }
                    { u32x4 w; w.x = cvt_pk_bf16(x[0][0], x[0][1]); w.y = cvt_pk_bf16(x[0][2], x[0][3]); w.z = cvt_pk_bf16(x[1][0], x[1][1]); w.w = cvt_pk_bf16(x[1][2], x[1][3]);
                      *(u32x4*)(op + bj * HALF) = w; }
                    if (xg) { u32x4 w; w.x = cvt_pk_bf16(h[0][0], h[0][1]); w.y = cvt_pk_bf16(h[0][2], h[0][3]); w.z = cvt_pk_bf16(h[1][0], h[1][1]); w.w = cvt_pk_bf16(h[1][2], h[1][3]);
                        *(u32x4*)(xg + (size_t)row * DM + col0 + bj * HALF) = w; } }
                s = quad_row_sum(s);
                if (fq == 0) ssq[(size_t)row * 16 + u.pn * 4 + wc] = s; }
    }
};
template <int MF> struct EpiConvIn {
    static constexpr bool PERM = true;
    bf16_t* Bb; bf16_t* Z; const float* ssq; const float* sw;
    __device__ __forceinline__ void operator()(const f32x4 (&acc)[2][2][MF][2], const Unit& u, int wr, int wc, int fr, int fq) const {
        const int row0 = u.pm * (64 * MF) + wr * (16 * MF) + fr;
        const int swc = u.pn * BM + wc * 32 + 8 * fq;
        f32x4 sv[2][2]; int curg = -1;
        if (u.pn < 4) {
            const int col0 = u.pn * BM + wc * 32 + 8 * fq;
#pragma unroll
            for (int ai = 0; ai < 2; ++ai)
#pragma unroll
                for (int m = 0; m < MF; ++m) { const int row = row0 + ai * (32 * MF) + m * 16; bf16_t* rowp = Bb + (size_t)row * DM + col0;
                    const float rs = row_rstd1(ssq, row, fq); const int grp = grp_of_row(row);
                    if (grp != curg) { curg = grp; const float* swp = sw + grp * NSW + swc;
#pragma unroll
                        for (int bj = 0; bj < 2; ++bj) { sv[bj][0] = *(const f32x4*)(swp + bj * HALF); sv[bj][1] = *(const f32x4*)(swp + bj * HALF + 4); } }
#pragma unroll
                    for (int bj = 0; bj < 2; ++bj) { const f32x4 v0 = acc[ai][bj][m][0] * rs + sv[bj][0], v1 = acc[ai][bj][m][1] * rs + sv[bj][1];
                        u32x4 w; w.x = cvt_pk_bf16(v0[0], v0[1]); w.y = cvt_pk_bf16(v0[2], v0[3]); w.z = cvt_pk_bf16(v1[0], v1[1]); w.w = cvt_pk_bf16(v1[2], v1[3]);
                        *(u32x4*)(rowp + bj * HALF) = w; } }
        } else {
            const int col0 = (u.pn - 4) * HALF + wc * 32 + 8 * fq;
#pragma unroll
            for (int ai = 0; ai < 2; ++ai)
#pragma unroll
                for (int m = 0; m < MF; ++m) { const int row = row0 + ai * (32 * MF) + m * 16; bf16_t* rowp = Z + (size_t)row * DM + col0;
                    const float rs = row_rstd1(ssq, row, fq); const int grp = grp_of_row(row);
                    if (grp != curg) { curg = grp; const float* swp = sw + grp * NSW + swc;
#pragma unroll
                        for (int bj = 0; bj < 2; ++bj) { sv[bj][0] = *(const f32x4*)(swp + bj * HALF); sv[bj][1] = *(const f32x4*)(swp + bj * HALF + 4); } }
                    const f32x4 v0 = (acc[ai][0][m][0] * rs + sv[0][0]) * (acc[ai][1][m][0] * rs + sv[1][0]);
                    const f32x4 v1 = (acc[ai][0][m][1] * rs + sv[0][1]) * (acc[ai][1][m][1] * rs + sv[1][1]);
                    u32x4 w; w.x = cvt_pk_bf16(v0[0], v0[1]); w.y = cvt_pk_bf16(v0[2], v0[3]); w.z = cvt_pk_bf16(v1[0], v1[1]); w.w = cvt_pk_bf16(v1[2], v1[3]);
                    *(u32x4*)rowp = w; }
        }
    }
};
template <int MF> struct EpiSwiglu {
    static constexpr bool PERM = true;
    bf16_t* ACT; const float* ssq; const float* sw;
    __device__ __forceinline__ void operator()(const f32x4 (&acc)[2][2][MF][2], const Unit& u, int wr, int wc, int fr, int fq) const {
        const int row0 = u.pm * (64 * MF) + wr * (16 * MF) + fr, col0 = u.pn * HALF + wc * 32 + 8 * fq;
        const int swc = u.pn * BM + wc * 32 + 8 * fq;
        f32x4 sv[2][2], svn[2]; int curg = -1;
#pragma unroll
        for (int ai = 0; ai < 2; ++ai)
#pragma unroll
            for (int m = 0; m < MF; ++m) { const int row = row0 + ai * (32 * MF) + m * 16; bf16_t* rowp = ACT + (size_t)row * DFF + col0;
                const float rs = row_rstd1(ssq, row, fq); const int grp = grp_of_row(row);
                if (grp != curg) { curg = grp; const float* swp = sw + grp * NSW + swc;
#pragma unroll
                    for (int bj = 0; bj < 2; ++bj) { sv[bj][0] = *(const f32x4*)(swp + bj * HALF); sv[bj][1] = *(const f32x4*)(swp + bj * HALF + 4); }
                    svn[0] = sv[0][0] * -1.4426950408889634f; svn[1] = sv[0][1] * -1.4426950408889634f; }
                const f32x4 sg0 = sv[0][0], sg1 = sv[0][1];
                const f32x4 g0 = acc[ai][0][m][0] * rs + sg0, g1 = acc[ai][0][m][1] * rs + sg1;
                const float rsn = rs * -1.4426950408889634f;
                f32x4 e0 = acc[ai][0][m][0] * rsn + svn[0], e1 = acc[ai][0][m][1] * rsn + svn[1];
                const f32x4 u0 = acc[ai][1][m][0] * rs + sv[1][0], u1 = acc[ai][1][m][1] * rs + sv[1][1];
#pragma unroll
                for (int j = 0; j < 4; ++j) { e0[j] = __builtin_amdgcn_exp2f(e0[j]); e1[j] = __builtin_amdgcn_exp2f(e1[j]); }
                e0 = e0 + 1.0f; e1 = e1 + 1.0f;
#pragma unroll
                for (int j = 0; j < 4; ++j) { e0[j] = __builtin_amdgcn_rcpf(e0[j]); e1[j] = __builtin_amdgcn_rcpf(e1[j]); }
                const f32x4 v0 = (g0 * u0) * e0, v1 = (g1 * u1) * e1;
                u32x4 w; w.x = cvt_pk_bf16(v0[0], v0[1]); w.y = cvt_pk_bf16(v0[2], v0[3]); w.z = cvt_pk_bf16(v1[0], v1[1]); w.w = cvt_pk_bf16(v1[2], v1[3]);
                *(u32x4*)rowp = w; }
    }
};
}

namespace att {
constexpr int D = 128, NW = 8, QBLK = 32, KVBLK = 64;
constexpr float SCALE = 0.088388347648318440f;
constexpr float THR = 8.f;
constexpr int LDQ = 1024, LDK = 128, LDO = 1024;
constexpr size_t SHM_V = KVBLK * D * 2, SHM_K = KVBLK * D * 2, SHM_ATTN = 2 * SHM_V + 2 * SHM_K + NW * 64 * 4;
#define KSWZ(row, colB) ((row) * 256 + ((colB) ^ (((row) & 7) << 4)))
#define SBAR() __builtin_amdgcn_sched_barrier(0)
__device__ __forceinline__ int crow(int r, int hi) { return (r & 3) + 8 * (r >> 2) + 4 * hi; }
__device__ __forceinline__ unsigned cvtpk(float lo, float hi) { unsigned r; asm volatile("v_cvt_pk_bf16_f32 %0, %1, %2" : "=v"(r) : "v"(lo), "v"(hi)); return r; }

__device__ __forceinline__ void partialSM(f32x16& p0, f32x16& p1, float& m_reg, float& mn, float& alpha) {
  constexpr float C = SCALE * 1.4426950408889634f;
  float pmax = p0[0];
#pragma unroll
  for (int r = 1; r < 16; ++r) pmax = fmaxf(pmax, p0[r]);
#pragma unroll
  for (int r = 0; r < 16; ++r) pmax = fmaxf(pmax, p1[r]);
  { auto rr = __builtin_amdgcn_permlane32_swap(__float_as_uint(pmax), __float_as_uint(pmax), false, false);
    pmax = fmaxf(__uint_as_float(rr[0]), __uint_as_float(rr[1])); }
  if (__builtin_expect(__all(pmax - m_reg <= THR / SCALE), 1)) { mn = m_reg; alpha = 1.f; }
  else { mn = fmaxf(m_reg, pmax); alpha = __builtin_amdgcn_exp2f((m_reg - mn) * C); m_reg = mn; }
  float mnC = -mn * C;
#pragma unroll
  for (int r = 0; r < 16; ++r) p0[r] = fmaf(p0[r], C, mnC);
#pragma unroll
  for (int r = 0; r < 16; ++r) p1[r] = fmaf(p1[r], C, mnC);
#pragma unroll
  for (int r = 0; r < 16; ++r) p0[r] = __builtin_amdgcn_exp2f(p0[r]);
}
__device__ __forceinline__ void finishSM(f32x16& p0, f32x16& p1, float alpha, float& l_reg, bf16x8& pa0, bf16x8& pa1, bf16x8& pa2, bf16x8& pa3) {
#pragma unroll
  for (int r = 0; r < 16; ++r) p1[r] = __builtin_amdgcn_exp2f(p1[r]);
  float ps = 0;
#pragma unroll
  for (int r = 0; r < 16; ++r) ps += p0[r];
#pragma unroll
  for (int r = 0; r < 16; ++r) ps += p1[r];
  { auto rr = __builtin_amdgcn_permlane32_swap(__float_as_uint(ps), __float_as_uint(ps), false, false);
    ps = __uint_as_float(rr[0]) + __uint_as_float(rr[1]); }
  l_reg = l_reg * alpha + ps;
#define PK4(P, BASE, OUT) do { unsigned a0 = cvtpk(P[BASE + 0], P[BASE + 1]), a1 = cvtpk(P[BASE + 2], P[BASE + 3]);   \
    unsigned b0 = cvtpk(P[BASE + 4], P[BASE + 5]), b1 = cvtpk(P[BASE + 6], P[BASE + 7]);                              \
    auto r0 = __builtin_amdgcn_permlane32_swap(a0, b0, false, false); auto r1 = __builtin_amdgcn_permlane32_swap(a1, b1, false, false); \
    u32x4 w = {r0[0], r1[0], r0[1], r1[1]}; OUT = *reinterpret_cast<bf16x8*>(&w); } while (0)
  PK4(p0, 0, pa0); PK4(p0, 8, pa1); PK4(p1, 0, pa2); PK4(p1, 8, pa3);
#undef PK4
}
__device__ __forceinline__ void qkt(f32x16& p0, f32x16& p1, const bf16_t* Ks, const bf16x8* qr, int r32, int hi) {
  p0 = f32x16{}; p1 = f32x16{};
#pragma unroll
  for (int d0 = 0; d0 < 8; ++d0) { int cb = (d0 * 16 + hi * 8) * 2;
    bf16x8 b0 = *reinterpret_cast<const bf16x8*>((const char*)Ks + KSWZ(r32, cb));
    bf16x8 b1 = *reinterpret_cast<const bf16x8*>((const char*)Ks + KSWZ(32 + r32, cb));
    p0 = __builtin_amdgcn_mfma_f32_32x32x16_bf16(b0, qr[d0], p0, 0, 0, 0);
    p1 = __builtin_amdgcn_mfma_f32_32x32x16_bf16(b1, qr[d0], p1, 0, 0, 0); }
}
__device__ __forceinline__ int v_st(int k, int c) { const int kk = (k & ~0xC) | ((k & 4) << 1) | ((k & 8) >> 1); return ((kk >> 3) * 4 + (c >> 5)) * 512 + ((kk & 7) * 32 + (c & 31)) * 2; }
__device__ __forceinline__ int v_rd_base(int lane) { return ((lane & 3) << 3) | (((lane >> 2) & 3) << 6) | (((lane >> 4) & 1) << 5) | (((lane >> 5) & 1) << 8); }
constexpr int v_rd_off(int d0, int ks, int half) { return d0 * 512 + ks * 4096 + half * 2048; }
template <int OFF> __device__ __forceinline__ s16x4 tr_read(int vb) {
  s16x4 r; asm volatile("ds_read_b64_tr_b16 %0, %1 offset:%2" : "=&v"(r) : "v"(vb), "i"(OFF) : "memory"); return r;
}
template <int D0> __device__ __forceinline__ void pv_one(f32x16& od, int vb, bf16x8 pa0, bf16x8 pa1, bf16x8 pa2, bf16x8 pa3) {
  const s16x4 l0 = tr_read<v_rd_off(D0, 0, 0)>(vb), h0 = tr_read<v_rd_off(D0, 0, 1)>(vb), l1 = tr_read<v_rd_off(D0, 1, 0)>(vb), h1 = tr_read<v_rd_off(D0, 1, 1)>(vb);
  const s16x4 l2 = tr_read<v_rd_off(D0, 2, 0)>(vb), h2 = tr_read<v_rd_off(D0, 2, 1)>(vb), l3 = tr_read<v_rd_off(D0, 3, 0)>(vb), h3 = tr_read<v_rd_off(D0, 3, 1)>(vb);
  asm volatile("s_waitcnt lgkmcnt(0)" ::: "memory"); SBAR();
#define PK(L, H) (bf16x8){L[0], L[1], L[2], L[3], H[0], H[1], H[2], H[3]}
  od = __builtin_amdgcn_mfma_f32_32x32x16_bf16(pa0, PK(l0, h0), od, 0, 0, 0);
  od = __builtin_amdgcn_mfma_f32_32x32x16_bf16(pa1, PK(l1, h1), od, 0, 0, 0);
  od = __builtin_amdgcn_mfma_f32_32x32x16_bf16(pa2, PK(l2, h2), od, 0, 0, 0);
  od = __builtin_amdgcn_mfma_f32_32x32x16_bf16(pa3, PK(l3, h3), od, 0, 0, 0);
#undef PK
}
__device__ __forceinline__ void pv_d0(f32x16* o, int vb, bf16x8 pa0, bf16x8 pa1, bf16x8 pa2, bf16x8 pa3) {
  pv_one<0>(o[0], vb, pa0, pa1, pa2, pa3); pv_one<1>(o[1], vb, pa0, pa1, pa2, pa3); pv_one<2>(o[2], vb, pa0, pa1, pa2, pa3); pv_one<3>(o[3], vb, pa0, pa1, pa2, pa3);
}

__device__ __forceinline__ void attn_dense_body(const bf16_t* __restrict__ Qb, const bf16_t* __restrict__ Kh, const bf16_t* __restrict__ Vh,
                                                bf16_t* __restrict__ Ob, int seq, char* lds) {
  const int tid = tid_opaque(), wid = tid >> 6, lane = tid & 63, r32 = lane & 31, hi = lane >> 5;
  bf16_t* V_lds = (bf16_t*)lds; bf16_t* K_lds = (bf16_t*)(lds + 2 * SHM_V);
  float* ws = (float*)(lds + 2 * SHM_V + 2 * SHM_K) + wid * 64; float* li_l = ws; float* al_l = ws + 32;
  float m_reg = -1e30f, l_reg = 0; f32x16 o[4] = {}; bf16x8 qr[8];
  const bf16_t* Qw = Qb + (long)(wid * QBLK + r32) * LDQ + hi * 8;
#pragma unroll
  for (int d0 = 0; d0 < 8; ++d0) qr[d0] = *reinterpret_cast<const bf16x8*>(Qw + d0 * 16);
  const int sr = tid >> 4, sc = (tid & 15) * 8, vst0 = v_st(sr, sc), vst1 = v_st(32 + sr, sc);
  const int vb0 = (int)(uintptr_t)V_lds + v_rd_base(lane);
  struct { bf16x8 vs0, vs1, ks0, ks1; } sr_[2];
#define SLOAD(i, k0) do { sr_[i].vs0 = *reinterpret_cast<const bf16x8*>(&Vh[(long)((k0) + sr) * LDK + sc]); sr_[i].vs1 = *reinterpret_cast<const bf16x8*>(&Vh[(long)((k0) + 32 + sr) * LDK + sc]); \
    sr_[i].ks0 = *reinterpret_cast<const bf16x8*>(&Kh[(long)((k0) + sr) * LDK + sc]); sr_[i].ks1 = *reinterpret_cast<const bf16x8*>(&Kh[(long)((k0) + 32 + sr) * LDK + sc]); } while (0)
#define SWRITE(b, i) do { *(bf16x8*)((char*)V_lds + (b) * SHM_V + vst0) = sr_[i].vs0;          \
    *(bf16x8*)((char*)V_lds + (b) * SHM_V + vst1) = sr_[i].vs1; int kc = sc * 2;               \
    *(bf16x8*)((char*)K_lds + (b) * SHM_K + KSWZ(sr, kc)) = sr_[i].ks0;                       \
    *(bf16x8*)((char*)K_lds + (b) * SHM_K + KSWZ(32 + sr, kc)) = sr_[i].ks1; } while (0)
#define SWAIT() asm volatile("s_waitcnt vmcnt(4)" ::: "memory")
#define RESC(a) do { if (__any((a) < 1.f)) { if (hi == 0) al_l[r32] = (a); asm volatile("s_waitcnt lgkmcnt(0)" ::: "memory"); \
    _Pragma("unroll") for (int d = 0; d < 4; ++d) _Pragma("unroll") for (int r = 0; r < 16; ++r) o[d][r] *= al_l[crow(r, hi)]; } } while (0)
  f32x16 pA0, pA1, pB0, pB1; float mnA, mnB, alA, alB; bf16x8 pa0, pa1, pa2, pa3; const int NT = seq / KVBLK;
  constexpr int SE = 0, SO = 1;
  SLOAD(SE, 0); asm volatile("s_waitcnt vmcnt(0)" ::: "memory"); SWRITE(0, SE); __syncthreads();
  qkt(pA0, pA1, K_lds, qr, r32, hi); partialSM(pA0, pA1, m_reg, mnA, alA);
  SLOAD(SO, KVBLK); if (2 < NT) SLOAD(SE, 2 * KVBLK);
  SWAIT(); SWRITE(1, SO); __syncthreads();
  for (int j = 1; j + 1 < NT; j += 2) {
    SBAR(); qkt(pB0, pB1, (bf16_t*)((char*)K_lds + SHM_K), qr, r32, hi);
    finishSM(pA0, pA1, alA, l_reg, pa0, pa1, pa2, pa3); SBAR();
    SLOAD(SO, (j + 2) * KVBLK); SBAR();
    pv_d0(o, vb0, pa0, pa1, pa2, pa3); partialSM(pB0, pB1, m_reg, mnB, alB);
    __syncthreads(); SWAIT(); SWRITE(0, SE);
    RESC(alB); __syncthreads();
    SBAR(); qkt(pA0, pA1, K_lds, qr, r32, hi);
    finishSM(pB0, pB1, alB, l_reg, pa0, pa1, pa2, pa3); SBAR();
    if (j + 3 < NT) SLOAD(SE, (j + 3) * KVBLK); SBAR();
    pv_d0(o, vb0 + (int)SHM_V, pa0, pa1, pa2, pa3); partialSM(pA0, pA1, m_reg, mnA, alA);
    __syncthreads(); SWAIT(); SWRITE(1, SO);
    RESC(alA); __syncthreads();
  }
  SBAR(); qkt(pB0, pB1, (bf16_t*)((char*)K_lds + SHM_K), qr, r32, hi);
  finishSM(pA0, pA1, alA, l_reg, pa0, pa1, pa2, pa3); SBAR();
  pv_d0(o, vb0, pa0, pa1, pa2, pa3); partialSM(pB0, pB1, m_reg, mnB, alB);
  __syncthreads(); RESC(alB);
  finishSM(pB0, pB1, alB, l_reg, pa0, pa1, pa2, pa3); SBAR();
  pv_d0(o, vb0 + (int)SHM_V, pa0, pa1, pa2, pa3);
  if (hi == 0) li_l[r32] = l_reg; asm volatile("s_waitcnt lgkmcnt(0)" ::: "memory");
  float rli[16];
#pragma unroll
  for (int r = 0; r < 16; ++r) rli[r] = __builtin_amdgcn_rcpf(li_l[crow(r, hi)]);
  bf16_t* Ow = Ob + (long)(wid * QBLK) * LDO;
#pragma unroll
  for (int r = 0; r < 16; ++r) { int orow = crow(r, hi);
#pragma unroll
    for (int d0 = 0; d0 < 4; ++d0) Ow[(long)orow * LDO + d0 * 32 + r32] = (bf16_t)(cvtpk(o[d0][r] * rli[r], 0.f) & 0xffffu); }
  __syncthreads();
#undef SLOAD
#undef SWRITE
#undef SWAIT
#undef RESC
}
}

__device__ __forceinline__ int src_col(int mode, int nd) {
    if (mode == 1) { if (nd < 1024) return nd; const int q = nd - 1024, j = q >> 8, r = q & 255; return r < 128 ? 1024 + 128 * j + r : 2048 + 128 * j + (r - 128); }
    if (mode == 2) { const int j = nd >> 8, r = nd & 255; return r < 128 ? 128 * j + r : DFF + 128 * j + (r - 128); }
    return nd;
}
struct CvtRegs { f32x4 v[4]; };
__device__ __forceinline__ void cvt_load(const float* __restrict__ W, int ldw, int mode, int nkt, int u, int tid, CvtRegs& rg) {
    const int kt = u % nkt, ntile = u / nkt, r = tid >> 3, c16 = (tid & 7) * 16;
    const float* src = W + (size_t)(kt * 64 + r) * ldw + src_col(mode, ntile * 128) + c16;
#pragma unroll
    for (int i = 0; i < 4; ++i) rg.v[i] = *(const f32x4*)(src + 4 * i);
}
__device__ __forceinline__ void cvt_matrix(const float* __restrict__ W, int K, int N, bf16_t* __restrict__ Bt, int mode, int& uoff, float* tile, int wk, int nwk) {
    const int tid = tid_opaque(), nkt = K / 64, nu = nkt * (N / 128);
    const int first = (wk - (uoff % nwk) + nwk) % nwk;
    uoff += nu;
    if (first >= nu) return;
    CvtRegs cur, nxt; cvt_load(W, N, mode, nkt, first, tid, cur);
    for (int u = first; u < nu; u += nwk) {
        const int r = tid >> 3, c16 = (tid & 7) * 16;
        float* tp = tile + r * 129 + c16;
#pragma unroll
        for (int i = 0; i < 4; ++i) { tp[4 * i + 0] = cur.v[i][0]; tp[4 * i + 1] = cur.v[i][1]; tp[4 * i + 2] = cur.v[i][2]; tp[4 * i + 3] = cur.v[i][3]; }
        __syncthreads();
        if (u + nwk < nu) cvt_load(W, N, mode, nkt, u + nwk, tid, nxt);
        const int kt = u % nkt, ntile = u / nkt, n = tid >> 2, kc = (tid & 3) * 16;
        const float* rp = tile + kc * 129 + n;
        u32x4 w0, w1;
        w0.x = cvt_pk_bf16(rp[0 * 129], rp[1 * 129]); w0.y = cvt_pk_bf16(rp[2 * 129], rp[3 * 129]); w0.z = cvt_pk_bf16(rp[4 * 129], rp[5 * 129]); w0.w = cvt_pk_bf16(rp[6 * 129], rp[7 * 129]);
        w1.x = cvt_pk_bf16(rp[8 * 129], rp[9 * 129]); w1.y = cvt_pk_bf16(rp[10 * 129], rp[11 * 129]); w1.z = cvt_pk_bf16(rp[12 * 129], rp[13 * 129]); w1.w = cvt_pk_bf16(rp[14 * 129], rp[15 * 129]);
        bf16_t* dst = Bt + (size_t)(ntile * 128 + n) * K + kt * 64 + kc;
        *(u32x4*)dst = w0; *(u32x4*)(dst + 8) = w1;
        __syncthreads();
        cur = nxt;
    }
}

__device__ __forceinline__ void adaln_units(const float* c, const float* c_ctx, const float* ada_w, const float* ada_b, float* MOD, float* lds_f, int& uoff, int l0, int wk, int G) {
    const int tid = tid_opaque();
    float* sv = lds_f;
    float* red = lds_f + 3 * 1024;
    for (int i = tid; i < 3 * 1024; i += NTHREADS) { const int g = i >> 10, k = i & 1023; const float v = g == 0 ? c_ctx[k] : c[(g - 1) * 1024 + k]; sv[i] = silu_f(v); }
    __syncthreads();
    const int nu = 192;
    int first = (wk - (uoff % G) + G) % G;
    const int cq = tid & 7, ks = tid >> 3;
    for (int u = first; u < nu; u += G) {
        const int l = l0, cc = u * 32;
        const float* wp = ada_w + (size_t)l * 1024 * 6144 + cc + cq * 4;
        f32x4 a0 = {0, 0, 0, 0}, a1 = a0, a2 = a0;
#pragma unroll 8
        for (int it = 0; it < 16; ++it) { const int k = ks + 64 * it; const f32x4 w = *(const f32x4*)(wp + (size_t)k * 6144);
            a0 += sv[k] * w; a1 += sv[1024 + k] * w; a2 += sv[2048 + k] * w; }
        float* rp = red + ks * 96 + cq * 4;
#pragma unroll
        for (int j = 0; j < 4; ++j) { rp[j] = a0[j]; rp[32 + j] = a1[j]; rp[64 + j] = a2[j]; }
        __syncthreads();
        if (tid < 96) { float s = 0; for (int q = 0; q < 64; ++q) s += red[q * 96 + tid]; const int g = tid >> 5, n = cc + (tid & 31);
            MOD[((size_t)l * 3 + g) * 6144 + n] = s + ada_b[l * 6144 + n]; }
        __syncthreads();
    }
    uoff += nu;
}

__device__ __forceinline__ void unpack8(const u32x4 w, float* f) { f[0] = bflo(w.x); f[1] = bfhi(w.x); f[2] = bflo(w.y); f[3] = bfhi(w.y); f[4] = bflo(w.z); f[5] = bfhi(w.z); f[6] = bflo(w.w); f[7] = bfhi(w.w); }
__device__ __forceinline__ u32x4 pack8(const float* f) { u32x4 w; w.x = cvt_pk_bf16(f[0], f[1]); w.y = cvt_pk_bf16(f[2], f[3]); w.z = cvt_pk_bf16(f[4], f[5]); w.w = cvt_pk_bf16(f[6], f[7]); return w; }
__device__ __forceinline__ void norm0_phase(const float* __restrict__ xp, const float* __restrict__ xs, const float* __restrict__ nw, const float* __restrict__ scale, bf16_t* __restrict__ XG, float* __restrict__ SSQ, bf16_t* __restrict__ XB) {
    const int tidq = tid_opaque(); const int lane = tidq & 63, wid = tidq >> 6;
    f32x4 wv[4];
#pragma unroll
    for (int j = 0; j < 4; ++j) wv[j] = *(const f32x4*)(nw + j * 256 + lane * 4);
    const int stride = gridDim.x * 8;
    for (int row = blockIdx.x * 8 + wid; row < MT; row += 2 * stride) {
        const int rowb = row + stride < MT ? row + stride : row;
        const float* xa = row < NP ? xp + (size_t)row * DM : xs + (size_t)(row - NP) * DM;
        const float* xb = rowb < NP ? xp + (size_t)rowb * DM : xs + (size_t)(rowb - NP) * DM;
        f32x4 va[4], vb[4];
#pragma unroll
        for (int j = 0; j < 4; ++j) { va[j] = *(const f32x4*)(xa + j * 256 + lane * 4); vb[j] = *(const f32x4*)(xb + j * 256 + lane * 4); }
        const float* sca = scale + (row < NP ? 0 : (row < NP + SEQS ? 1 : 2)) * 6144; const float* scb = scale + (rowb < NP ? 0 : (rowb < NP + SEQS ? 1 : 2)) * 6144;
        float sa = 0, sb = 0;
#pragma unroll
        for (int j = 0; j < 4; ++j) {
            sa += (va[j][0] * va[j][0] + va[j][1] * va[j][1]) + (va[j][2] * va[j][2] + va[j][3] * va[j][3]);
            sb += (vb[j][0] * vb[j][0] + vb[j][1] * vb[j][1]) + (vb[j][2] * vb[j][2] + vb[j][3] * vb[j][3]);
            const f32x4 ha = va[j] * wv[j] * (1.0f + *(const f32x4*)(sca + j * 256 + lane * 4)), hb = vb[j] * wv[j] * (1.0f + *(const f32x4*)(scb + j * 256 + lane * 4));
            u32x2 oa, ob; oa.x = cvt_pk_bf16(ha[0], ha[1]); oa.y = cvt_pk_bf16(ha[2], ha[3]); ob.x = cvt_pk_bf16(hb[0], hb[1]); ob.y = cvt_pk_bf16(hb[2], hb[3]);
            *(u32x2*)(XG + (size_t)row * DM + j * 256 + lane * 4) = oa; *(u32x2*)(XG + (size_t)rowb * DM + j * 256 + lane * 4) = ob;
            u32x2 xa, xb; xa.x = cvt_pk_bf16(va[j][0], va[j][1]); xa.y = cvt_pk_bf16(va[j][2], va[j][3]); xb.x = cvt_pk_bf16(vb[j][0], vb[j][1]); xb.y = cvt_pk_bf16(vb[j][2], vb[j][3]);
            *(u32x2*)(XB + (size_t)row * DM + j * 256 + lane * 4) = xa; *(u32x2*)(XB + (size_t)rowb * DM + j * 256 + lane * 4) = xb; }
        sa = wave_sum(sa); sb = wave_sum(sb);
        if (lane < 16) { SSQ[(size_t)row * 16 + lane] = lane == 0 ? sa : 0.f; SSQ[(size_t)rowb * 16 + lane] = lane == 0 ? sb : 0.f; }
    }
}
__device__ __forceinline__ void sw_rows(const bf16_t* __restrict__ Bt, int N, const float* __restrict__ shift, float* __restrict__ SWo, int wave0, int nwaves) {
    const int lane = tid_opaque() & 63;
    float sh[3][16];
#pragma unroll
    for (int g = 0; g < 3; ++g)
#pragma unroll
        for (int h = 0; h < 2; ++h)
#pragma unroll
            for (int j4 = 0; j4 < 2; ++j4) { const f32x4 t = *(const f32x4*)(shift + g * 6144 + h * 512 + lane * 8 + j4 * 4); sh[g][h * 8 + j4 * 4 + 0] = t[0]; sh[g][h * 8 + j4 * 4 + 1] = t[1]; sh[g][h * 8 + j4 * 4 + 2] = t[2]; sh[g][h * 8 + j4 * 4 + 3] = t[3]; }
    for (int n = wave0; n < N; n += 2 * nwaves) {
        const int n2 = n + nwaves < N ? n + nwaves : n;
        const bf16_t* rp = Bt + (size_t)n * 1024 + lane * 8; const bf16_t* rq = Bt + (size_t)n2 * 1024 + lane * 8;
        const u32x4 a0 = *(const u32x4*)rp, a1 = *(const u32x4*)(rp + 512), b0 = *(const u32x4*)rq, b1 = *(const u32x4*)(rq + 512);
        float w[16], v[16]; unpack8(a0, w); unpack8(a1, w + 8); unpack8(b0, v); unpack8(b1, v + 8);
        float d0 = 0, d1 = 0, d2 = 0, e0 = 0, e1 = 0, e2 = 0;
#pragma unroll
        for (int j = 0; j < 16; ++j) { d0 += sh[0][j] * w[j]; d1 += sh[1][j] * w[j]; d2 += sh[2][j] * w[j]; e0 += sh[0][j] * v[j]; e1 += sh[1][j] * v[j]; e2 += sh[2][j] * v[j]; }
#pragma unroll
        for (int o = 32; o >= 1; o >>= 1) { d0 += __shfl_xor(d0, o); d1 += __shfl_xor(d1, o); d2 += __shfl_xor(d2, o); e0 += __shfl_xor(e0, o); e1 += __shfl_xor(e1, o); e2 += __shfl_xor(e2, o); }
        if (lane == 0) { SWo[n] = d0; SWo[NSW + n] = d1; SWo[2 * NSW + n] = d2; SWo[n2] = e0; SWo[NSW + n2] = e1; SWo[2 * NSW + n2] = e2; }
    }
}
__device__ __forceinline__ void final_norm_phase(const bf16_t* __restrict__ X, const float* __restrict__ SSQ, const float* __restrict__ w, float* __restrict__ out) {
    const int tidq = tid_opaque(); const int lane = tidq & 63, wid = tidq >> 6;
    f32x4 wv[4];
#pragma unroll
    for (int j = 0; j < 4; ++j) wv[j] = *(const f32x4*)(w + j * 256 + lane * 4);
    const int stride = gridDim.x * 8;
    for (int row = blockIdx.x * 8 + wid; row < MT; row += 2 * stride) {
        const int rowb = row + stride < MT ? row + stride : row;
        f32x4 va[4], vb[4];
#pragma unroll
        for (int j = 0; j < 4; ++j) { const u32x2 pa = *(const u32x2*)(X + (size_t)row * DM + j * 256 + lane * 4), pb = *(const u32x2*)(X + (size_t)rowb * DM + j * 256 + lane * 4);
            va[j] = (f32x4){bflo(pa.x), bfhi(pa.x), bflo(pa.y), bfhi(pa.y)}; vb[j] = (f32x4){bflo(pb.x), bfhi(pb.x), bflo(pb.y), bfhi(pb.y)}; }
        float sa = SSQ[(size_t)row * 16 + (lane & 15)], sb = SSQ[(size_t)rowb * 16 + (lane & 15)];
#pragma unroll
        for (int o = 8; o >= 1; o >>= 1) { sa += __shfl_xor(sa, o); sb += __shfl_xor(sb, o); }
        const float ra = 1.0f / sqrtf(sa * (1.0f / 1024.0f) + 1e-6f), rb = 1.0f / sqrtf(sb * (1.0f / 1024.0f) + 1e-6f);
#pragma unroll
        for (int j = 0; j < 4; ++j) { *(f32x4*)(out + (size_t)row * DM + j * 256 + lane * 4) = va[j] * ra * wv[j]; *(f32x4*)(out + (size_t)rowb * DM + j * 256 + lane * 4) = vb[j] * rb * wv[j]; }
    }
}

__device__ __forceinline__ void conv_item_load(const bf16_t* __restrict__ Bb, const bf16_t* __restrict__ Z, long i, u32x4& z0, u32x4& z1, u32x4& z2, u32x4& b) {
    const int row = (int)(i >> 7), c = (int)(i & 127) * 8;
    int t, T; if (row < NP) { t = row & (SEQP - 1); T = SEQP; } else { t = (row - NP) & (SEQS - 1); T = SEQS; }
    const bf16_t* zp = Z + (size_t)row * DM + c;
    const u32x4 zero = {0u, 0u, 0u, 0u};
    z1 = *(const u32x4*)zp; z0 = t > 0 ? *(const u32x4*)(zp - DM) : zero; z2 = t < T - 1 ? *(const u32x4*)(zp + DM) : zero;
    b = *(const u32x4*)(Bb + (size_t)row * DM + c);
}
__device__ __forceinline__ void conv_item_store(const float* __restrict__ cw, bf16_t* __restrict__ A2, long i, const u32x4& z0, const u32x4& z1, const u32x4& z2, const u32x4& b) {
    const int row = (int)(i >> 7), c = (int)(i & 127) * 8;
    float f0[8], f1[8], f2[8], fb[8], o[8];
    unpack8(z0, f0); unpack8(z1, f1); unpack8(z2, f2); unpack8(b, fb);
#pragma unroll
    for (int j = 0; j < 8; ++j) o[j] = fb[j] * (f0[j] * cw[c + j] + f1[j] * cw[1024 + c + j] + f2[j] * cw[2048 + c + j]);
    *(u32x4*)(A2 + (size_t)row * DM + c) = pack8(o);
}
__device__ __forceinline__ void conv_phase(const bf16_t* __restrict__ Bb, const bf16_t* __restrict__ Z, const float* __restrict__ cw, bf16_t* __restrict__ A2) {
    const long total = (long)MT * 128, stride = (long)gridDim.x * NTHREADS;
    for (long i = (long)blockIdx.x * NTHREADS + tid_opaque(); i < total; i += 2 * stride) {
        const long i2 = i + stride < total ? i + stride : i;
        u32x4 a0, a1, a2, ab, c0, c1, c2, cb;
        conv_item_load(Bb, Z, i, a0, a1, a2, ab); conv_item_load(Bb, Z, i2, c0, c1, c2, cb);
        conv_item_store(cw, A2, i, a0, a1, a2, ab); conv_item_store(cw, A2, i2, c0, c1, c2, cb);
    }
}

template <int HW> __device__ __forceinline__ void pool_item(const bf16_t* __restrict__ hp, const float* rl, int t, int T, bf16_t* __restrict__ dp) {
    u32x4 v[2 * HW]; float wgt[2 * HW];
    int cnt = 0;
#pragma unroll
    for (int q = 0; q < 2 * HW; ++q) { const int d = q - HW; const bool ok = (t + d >= 0) && (t + d < T); v[q] = *(const u32x4*)(hp + (long)(ok ? d : 0) * DM); wgt[q] = ok ? rl[d] : 0.f; cnt += ok ? 1 : 0; }
    float s[8], f[8];
#pragma unroll
    for (int j = 0; j < 8; ++j) s[j] = 0.f;
#pragma unroll
    for (int q = 0; q < 2 * HW; ++q) { unpack8(v[q], f);
#pragma unroll
        for (int j = 0; j < 8; ++j) s[j] += f[j] * wgt[q]; }
    unpack8(v[HW], f);
    const float inv = 1.0f / (float)cnt, rt = rl[0];
#pragma unroll
    for (int j = 0; j < 8; ++j) s[j] = s[j] * inv - f[j] * rt;
    *(u32x4*)dp = pack8(s);
}
__device__ __forceinline__ void pool_phase(const bf16_t* __restrict__ XG, const float* __restrict__ SSQ, bf16_t* __restrict__ DIFF, float* lds_f) {
    const int tid = tid_opaque(), wid = tid >> 6, lane = tid & 63, g = wid & 3;
    for (int unit = blockIdx.x; unit < MT / 16; unit += gridDim.x) {
        const int r0 = unit * 16;
        if (tid < 32) { int r = r0 - 8 + tid; r = r < 0 ? 0 : (r > MT - 1 ? MT - 1 : r);
            const f32x4 p0 = *(const f32x4*)(SSQ + (size_t)r * 16), p1 = *(const f32x4*)(SSQ + (size_t)r * 16 + 4), p2 = *(const f32x4*)(SSQ + (size_t)r * 16 + 8), p3 = *(const f32x4*)(SSQ + (size_t)r * 16 + 12);
            const float s = (((p0[0] + p0[1]) + (p0[2] + p0[3])) + ((p1[0] + p1[1]) + (p1[2] + p1[3]))) + (((p2[0] + p2[1]) + (p2[2] + p2[3])) + ((p3[0] + p3[1]) + (p3[2] + p3[3])));
            lds_f[tid] = __builtin_amdgcn_rsqf(s * (1.0f / 1024.0f) + 1e-6f); }
        __syncthreads();
#pragma unroll 1
        for (int pass = 0; pass < 4; ++pass) {
            const int lr = (wid >> 2) * 2 + (lane >> 5) + 4 * pass, row = r0 + lr, c = g * 256 + (lane & 31) * 8;
            int t, T; if (row < NP) { t = row & (SEQP - 1); T = SEQP; } else { t = (row - NP) & (SEQS - 1); T = SEQS; }
            const bf16_t* hp = XG + (size_t)row * DM + c; bf16_t* dp = DIFF + (size_t)row * DM + c; const float* rl = lds_f + lr + 8;
            if (g == 0) pool_item<1>(hp, rl, t, T, dp); else if (g == 1) pool_item<2>(hp, rl, t, T, dp); else if (g == 2) pool_item<4>(hp, rl, t, T, dp); else pool_item<8>(hp, rl, t, T, dp);
        }
        __syncthreads();
    }
}

__device__ __forceinline__ void qkprep_phase(const bf16_t* __restrict__ QKV, const float* __restrict__ qnw, const float* __restrict__ knw, const float* __restrict__ cache_k, const float* __restrict__ cache_v,
                                             bf16_t* __restrict__ Q, bf16_t* __restrict__ KP, bf16_t* __restrict__ VP, bf16_t* __restrict__ KS, bf16_t* __restrict__ VS, float* __restrict__ newk, float* __restrict__ newv) {
    const int tidq = tid_opaque(); const int lane = tidq & 63, wid = tidq >> 6;
    const int half = lane >> 5, i = lane & 31;
    const int d1 = half * 64 + i, d2 = d1 + 32;
    const float qw1 = qnw[d1], qw2 = qnw[d2], kw1 = knw[d1], kw2 = knw[d2];
    const float inv_freq = __builtin_amdgcn_exp2f(-(float)(2 * i) * (13.287712379549449f / 64.0f));
    for (int row = blockIdx.x * 8 + wid; row < MT; row += gridDim.x * 8) {
        const bf16_t* qp = QKV + (size_t)row * NQKV;
        float x1[10], x2[10], vv[2][2];
#pragma unroll
        for (int h = 0; h < 10; ++h) { x1[h] = bf2f(qp[h * 128 + d1]); x2[h] = bf2f(qp[h * 128 + d2]); }
#pragma unroll
        for (int h = 0; h < 2; ++h) { const unsigned t2 = *(const unsigned*)(qp + 1280 + h * 128 + lane * 2); vv[h][0] = bflo(t2); vv[h][1] = bfhi(t2); }
        float cs = 1.f, sn = 0.f; int b, t;
        const bool smp = row >= NP;
        if (smp) { b = (row - NP) >> 12; t = (row - NP) & (SEQS - 1); const float pos = (float)(half == 0 ? (t >> 6) : (t & 63)); const float ang = pos * inv_freq;
            const float nrev = rintf(ang * 0.15915494309189535f); float rr = fmaf(nrev, -6.28318548202514648f, ang); rr = fmaf(nrev, 1.74845553146951715e-07f, rr); sn = __sinf(rr); cs = __cosf(rr); }
        else { b = row >> 8; t = row & (SEQP - 1); }
        float ss[10];
#pragma unroll
        for (int h = 0; h < 10; ++h) ss[h] = x1[h] * x1[h] + x2[h] * x2[h];
#pragma unroll
        for (int o = 32; o >= 1; o >>= 1) {
#pragma unroll
            for (int h = 0; h < 10; ++h) ss[h] += __shfl_xor(ss[h], o); }
#pragma unroll
        for (int h = 0; h < 10; ++h) {
            const float rstd = 1.0f / sqrtf(ss[h] * (1.0f / 128.0f) + 1e-6f);
            const float a1 = x1[h] * rstd * (h < 8 ? qw1 : kw1), a2 = x2[h] * rstd * (h < 8 ? qw2 : kw2);
            if (!smp && h >= 8) { const size_t o = (((size_t)b * 2 + (h - 8)) * SEQP + t) * 128; newk[o + d1] = a1; newk[o + d2] = a2; }
            const float y1 = a1 * cs - a2 * sn, y2 = a2 * cs + a1 * sn;
            const bf16_t o1 = (bf16_t)(cvt_pk_bf16(y1, 0.f) & 0xffffu), o2 = (bf16_t)(cvt_pk_bf16(y2, 0.f) & 0xffffu);
            if (h < 8) { bf16_t* dst = Q + (size_t)row * DM + h * 128; dst[d1] = o1; dst[d2] = o2; }
            else { bf16_t* dst = smp ? KS + (((size_t)b * 2 + (h - 8)) * SKV_S + PAST + t) * 128 : KP + (((size_t)b * 2 + (h - 8)) * SEQP + t) * 128; dst[d1] = o1; dst[d2] = o2; }
        }
#pragma unroll
        for (int h = 0; h < 2; ++h) {
            if (!smp) { const size_t o = (((size_t)b * 2 + h) * SEQP + t) * 128 + lane * 2; *(float2*)(newv + o) = make_float2(vv[h][0], vv[h][1]); }
            bf16_t* dst = smp ? VS + (((size_t)b * 2 + h) * SKV_S + PAST + t) * 128 : VP + (((size_t)b * 2 + h) * SEQP + t) * 128;
            *(unsigned*)(dst + lane * 2) = cvt_pk_bf16(vv[h][0], vv[h][1]);
        }
    }
    const int ncr = 2 * 2 * PAST;
    for (int r = blockIdx.x * 8 + wid; r < 2 * ncr; r += gridDim.x * 8) {
        const bool isv = r >= ncr; const int rr = isv ? r - ncr : r; const int bh = rr >> 8, p = rr & 255;
        const float* src = (isv ? cache_v : cache_k) + ((size_t)bh * PAST + p) * 128 + lane * 2;
        bf16_t* dst = (isv ? VS : KS) + ((size_t)bh * SKV_S + p) * 128 + lane * 2;
        *(unsigned*)dst = cvt_pk_bf16(src[0], src[1]);
    }
}

__device__ __forceinline__ void attn_phase(const bf16_t* Q, const bf16_t* KP, const bf16_t* VP, const bf16_t* KS, const bf16_t* VS, bf16_t* O, char* lds) {
    for (int u = blockIdx.x; u < 384; u += gridDim.x) {
        if (u < 256) { const int b = u >> 7, h = (u >> 4) & 7, qb = u & 15, kvh = h >> 2;
            const size_t row0 = (size_t)NP + (size_t)b * SEQS + qb * 256;
            const size_t ko = ((size_t)b * 2 + kvh) * SKV_S * 128;
            att::attn_dense_body(Q + row0 * DM + h * 128, KS + ko, VS + ko, O + row0 * DM + h * 128, SKV_S, lds);
        } else { const int v = u - 256, b = v >> 3, h = v & 7, kvh = h >> 2;
            const size_t row0 = (size_t)b * SEQP;
            const size_t ko = ((size_t)b * 2 + kvh) * SEQP * 128;
            att::attn_dense_body(Q + row0 * DM + h * 128, KP + ko, VP + ko, O + row0 * DM + h * 128, SEQP, lds);
        }
    }
}

#define XB_TMO      128
#define XB_XCNT(j)  (256  + 64 * (j))
#define XB_XSUB(j)  (1280 + 64 * (j))
#define XB_XGEN(j)  (2304 + 64 * (j))
#define XB_TOP      3328
#define XB_TOPGEN   3392
#define XCD_BAR_WORDS 3456
#define XB_SPIN_CAP (1u << 18)

__device__ __forceinline__ unsigned xb_ld(unsigned* p)              { return __hip_atomic_load(p, __ATOMIC_RELAXED, __HIP_MEMORY_SCOPE_AGENT); }
__device__ __forceinline__ unsigned xb_add(unsigned* p, unsigned v) { return __hip_atomic_fetch_add(p, v, __ATOMIC_RELAXED, __HIP_MEMORY_SCOPE_AGENT); }
__device__ __forceinline__ unsigned xb_xcc_id() { return (unsigned)__builtin_amdgcn_s_getreg((3 << 11) | 20) & 0xFu; }
#define XB_SPIN(cond, bar) do { unsigned _sp = 0; while (cond) { __builtin_amdgcn_s_sleep(1); \
    if ((++_sp & 255u) == 0u) { if (xb_ld(&(bar)[XB_TMO])) break; if (_sp > XB_SPIN_CAP) { atomicAdd(&(bar)[XB_TMO], 1u); break; } } } } while (0)

struct XcdBarrier {
    unsigned* bar; unsigned x;
    volatile LAS unsigned* st;
};

__device__ __forceinline__ XcdBarrier xcd_barrier_post(unsigned* bar, volatile LAS unsigned* st) {
    XcdBarrier b; b.bar = bar; b.x = xb_xcc_id(); b.st = st;
    if (threadIdx.x == 0) (void)xb_add(&bar[XB_XCNT(b.x)], 1u);
    return b;
}
__device__ __forceinline__ void xcd_barrier_complete(unsigned* bar, unsigned x, unsigned& nloc, unsigned& nx) {
    const unsigned G = gridDim.x * gridDim.y * gridDim.z;
    unsigned sum, cnt, mine, sp = 0u;
    for (;;) {
        sum = 0u; cnt = 0u; mine = 0u;
#pragma unroll
        for (unsigned j = 0; j < 16; ++j) { const unsigned c = xb_ld(&bar[XB_XCNT(j)]); sum += c; cnt += (c > 0u) ? 1u : 0u; mine = (j == x) ? c : mine; }
        if (sum == G) break;
        __builtin_amdgcn_s_sleep(1);
        if ((++sp & 255u) == 0u) { if (xb_ld(&bar[XB_TMO])) break; if (sp > XB_SPIN_CAP) { atomicAdd(&bar[XB_TMO], 1u); break; } }
    }
    nloc = mine > 0u ? mine : 1u; nx = cnt > 0u ? cnt : 1u;
}

__device__ __forceinline__ void xcd_barrier(const XcdBarrier& b) {
    asm volatile("s_waitcnt vmcnt(0)" ::: "memory");
    __syncthreads();
    if (threadIdx.x == 0) {
        unsigned* bar = b.bar;
        __builtin_amdgcn_s_waitcnt(0);
        unsigned nloc = b.st[0], nx = b.st[1];
        if (nloc == 0u) { xcd_barrier_complete(bar, b.x, nloc, nx); b.st[0] = nloc; b.st[1] = nx; }
        const unsigned old = xb_add(&bar[XB_XSUB(b.x)], 1u);
        const unsigned gen = old / nloc;
        if (old + 1u == (gen + 1u) * nloc) {
            __builtin_amdgcn_fence(__ATOMIC_RELEASE, "agent");
            asm volatile("s_waitcnt vmcnt(0)" ::: "memory");
            const unsigned og = xb_add(&bar[XB_TOP], 1u);
            const unsigned tg = og / nx;
            if (og + 1u == (tg + 1u) * nx) xb_add(&bar[XB_TOPGEN], 1u);
            else XB_SPIN(xb_ld(&bar[XB_TOPGEN]) == tg, bar);
            __builtin_amdgcn_fence(__ATOMIC_ACQUIRE, "agent");
            xb_add(&bar[XB_XGEN(b.x)], 1u);
            asm volatile("s_waitcnt vmcnt(0)" ::: "memory");
        } else {
            XB_SPIN(xb_ld(&bar[XB_XGEN(b.x)]) == gen, bar);
            __builtin_amdgcn_fence(__ATOMIC_ACQUIRE, "agent");
            asm volatile("s_waitcnt vmcnt(0)" ::: "memory");
        }
    }
    __syncthreads();
}


constexpr int NPH = 2 + 8 * 4 + 1;

typedef const __attribute__((address_space(4))) Params* KPtr;
__device__ __forceinline__ KPtr kargs() { KPtr q = (KPtr)__builtin_amdgcn_kernarg_segment_ptr(); asm volatile("" : "+s"(q)); return q; }
#define WSP(T, off) ((T*)(q->ws + (off)))

__global__ void __launch_bounds__(NTHREADS, 2) fwd_megakernel(Params p) {
    extern __shared__ __attribute__((aligned(16))) unsigned char lds_raw[];
    LAS unsigned char* lds = (LAS unsigned char*)lds_raw;
    cg::grid_group grid = cg::this_grid();
    const int ph_lo = p.ph_lo, ph_hi = p.ph_hi;
    int ph = 0; bool need_sync = false;
    if (ph_lo < 0) grid.sync();
    volatile LAS unsigned* bst = (volatile LAS unsigned*)(lds + 131072 + 2048);
    if (threadIdx.x < 4) bst[threadIdx.x] = 0u;
    __syncthreads();
    XcdBarrier bar; bar.bar = (unsigned*)(p.ws + WS_BAR); bar.x = 0; bar.st = bst;
    if (ph_hi - ph_lo > 1) bar = xcd_barrier_post((unsigned*)(p.ws + WS_BAR), bst);
    if (threadIdx.x == 0) { bst[3] = blockIdx.x; if (ph_hi - ph_lo > 1) bst[2] = xb_add(&((unsigned*)(p.ws + WS_BAR))[3460 + 64 * bar.x], 1u); }
    __syncthreads();
#define PHASE_BEGIN_R(R) if (ph >= ph_lo && ph < ph_hi) { _Pragma("unroll 1") for (int rep_ = 0; rep_ < (R); ++rep_) { if (need_sync) xcd_barrier(bar); need_sync = true; KPtr q = kargs();
#define PHASE_BEGIN PHASE_BEGIN_R(1)
#define PHASE_END } } ++ph;

    PHASE_BEGIN_R(REP_PREP)
    {
        int uoff = 0; float* lf = (float*)lds_raw;
        adaln_units(q->in[4], q->in[5], q->in[8], q->in[9], WSP(float, WS_MOD), lf, uoff, 0, blockIdx.x, gridDim.x);
        cvt_matrix(q->in[10], 1024, 3072, WSP(bf16_t, WS_CIN), 1, uoff, lf, blockIdx.x, gridDim.x);
        cvt_matrix(q->in[12], 1024, 1024, WSP(bf16_t, WS_COUT), 0, uoff, lf, blockIdx.x, gridDim.x);
        cvt_matrix(q->in[19], 1024, 5632, WSP(bf16_t, WS_FIN), 2, uoff, lf, blockIdx.x, gridDim.x);
        cvt_matrix(q->in[20], 2816, 1024, WSP(bf16_t, WS_FOUT), 0, uoff, lf, blockIdx.x, gridDim.x);
    }
    PHASE_END
    PHASE_BEGIN_R(REP_NORM)
    {
        if (threadIdx.x == 0 && ph_hi - ph_lo > 1) {
            unsigned* bw = (unsigned*)(q->ws + WS_BAR); const unsigned per = gridDim.x >> 3; bool ok = (gridDim.x & 7u) == 0u && bar.x < 8u;
            for (unsigned jx = 0; jx < 8; ++jx) ok = ok && (xb_ld(&bw[3460 + 64 * jx]) == per);
            if (ok) bst[3] = bst[2] * 8u + bar.x;
        }
        const float* MOD = WSP(float, WS_MOD); float* SW = WSP(float, WS_SW);
        norm0_phase(q->in[0], q->in[1], q->in[6], MOD + 1 * 1024, WSP(bf16_t, WS_H), WSP(float, WS_SSQ), WSP(bf16_t, WS_X));
        const int w0 = blockIdx.x * 8 + (tid_opaque() >> 6), nw = gridDim.x * 8;
        sw_rows(WSP(bf16_t, WS_CIN), 3072, MOD + 0 * 1024, SW + 0, w0, nw);
        sw_rows(WSP(bf16_t, WS_FIN), 5632, MOD + 3 * 1024, SW + 7680, w0, nw);
    }
    PHASE_END

#pragma unroll 1
    for (int hl = 0; hl < 8; ++hl) {
        const int layer = hl >> 1, part = hl & 1, kind = layer % 3, j = layer / 3;
        if (part == 1) {
            PHASE_BEGIN_R(REP_FIN)
            pg8::Gemm g{WSP(bf16_t, WS_H), WSP(bf16_t, WS_FIN) + (size_t)layer * 5632 * 1024, MT, 5632, 1024, 1024, 0}; pg8::StaticOrder S; S.init(g.M, g.N, gridDim.x, (int)__builtin_amdgcn_readfirstlane(bst[3]), 64 * MF_FIN);
            pg8::gemm_phase<MF_FIN>(lds, g, S, pg8::EpiSwiglu<MF_FIN>{WSP(bf16_t, WS_ACT), WSP(float, WS_SSQ), WSP(float, WS_SW) + 7680 + layer * 5632});
            {
                const int nlast = (MT / (64 * MF_FIN)) * 22 % (int)gridDim.x;
                const int vc = (int)__builtin_amdgcn_readfirstlane(bst[3]);
                if (layer < 3 && nlast > 0 && vc >= nlast) {
                    KPtr q2 = kargs(); int uoff = 0; float* lf = (float*)lds_raw; const int wk = vc - nlast, nwk = gridDim.x - nlast, ln = layer + 1;
                    adaln_units(q2->in[4], q2->in[5], q2->in[8], q2->in[9], (float*)(q2->ws + WS_MOD), lf, uoff, ln, wk, nwk);
                    if (ln == 1) {
#pragma unroll 1
                        for (int gq = 0; gq < 4; ++gq) cvt_matrix(q2->in[13] + (size_t)gq * 65536, 256, 256, (bf16_t*)(q2->ws + WS_POOL) + (size_t)gq * 65536, 0, uoff, lf, wk, nwk);
                    } else if (ln == 2) {
                        cvt_matrix(q2->in[15], 1024, 1536, (bf16_t*)(q2->ws + WS_QKVW), 0, uoff, lf, wk, nwk);
                        cvt_matrix(q2->in[18], 1024, 1024, (bf16_t*)(q2->ws + WS_AOUT), 0, uoff, lf, wk, nwk);
                    } else {
                        cvt_matrix(q2->in[10] + (size_t)1024 * 3072, 1024, 3072, (bf16_t*)(q2->ws + WS_CIN) + (size_t)3072 * 1024, 1, uoff, lf, wk, nwk);
                        cvt_matrix(q2->in[12] + (size_t)1024 * 1024, 1024, 1024, (bf16_t*)(q2->ws + WS_COUT) + (size_t)1024 * 1024, 0, uoff, lf, wk, nwk);
                    }
                    cvt_matrix(q2->in[19] + (size_t)ln * 1024 * 5632, 1024, 5632, (bf16_t*)(q2->ws + WS_FIN) + (size_t)ln * 5632 * 1024, 2, uoff, lf, wk, nwk);
                    cvt_matrix(q2->in[20] + (size_t)ln * 2816 * 1024, 2816, 1024, (bf16_t*)(q2->ws + WS_FOUT) + (size_t)ln * 1024 * 2816, 0, uoff, lf, wk, nwk);
                }
            }
            PHASE_END
        } else if (kind == 0) {
            PHASE_BEGIN_R(REP_CIN)
            pg8::Gemm g{WSP(bf16_t, WS_H), WSP(bf16_t, WS_CIN) + (size_t)j * 3072 * 1024, MT, 3072, 1024, 1024, 0}; pg8::StaticOrder S; S.init(g.M, g.N, gridDim.x, (int)__builtin_amdgcn_readfirstlane(bst[3]), 64 * MF_CIN);
            pg8::gemm_phase<MF_CIN>(lds, g, S, pg8::EpiConvIn<MF_CIN>{WSP(bf16_t, WS_BB), WSP(bf16_t, WS_Z), WSP(float, WS_SSQ), WSP(float, WS_SW) + j * 3072});
            PHASE_END
        } else if (kind == 1) {
            PHASE_BEGIN_R(REP_EW)
            pool_phase(WSP(bf16_t, WS_H), WSP(float, WS_SSQ), WSP(bf16_t, WS_A2), (float*)lds_raw);
            PHASE_END
        } else {
            PHASE_BEGIN
            pg8::Gemm g{WSP(bf16_t, WS_H), WSP(bf16_t, WS_QKVW), MT, NQKV, 1024, 1024, 0}; pg8::StaticOrder S; S.init(g.M, g.N, gridDim.x, (int)__builtin_amdgcn_readfirstlane(bst[3]), 64 * MF_QKV);
            pg8::gemm_phase<MF_QKV>(lds, g, S, pg8::EpiBf16N<MF_QKV>{WSP(bf16_t, WS_QKV), NQKV, WSP(float, WS_SSQ), WSP(float, WS_SW) + 6144});
            PHASE_END
        }
        if (part == 0 && kind == 0) {
            PHASE_BEGIN_R(REP_EW)
            conv_phase(WSP(bf16_t, WS_BB), WSP(bf16_t, WS_Z), q->in[11] + (size_t)j * 3 * 1024, WSP(bf16_t, WS_A2));
            PHASE_END
        } else if (part == 0 && kind == 2) {
            PHASE_BEGIN_R(REP_EW)
            float* new_k = q->out + (size_t)MT * DM; float* new_v = new_k + 16 * 2 * 256 * 128;
            qkprep_phase(WSP(bf16_t, WS_QKV), q->in[16] + j * 128, q->in[17] + j * 128, q->in[2], q->in[3], WSP(bf16_t, WS_Q), WSP(bf16_t, WS_KP), WSP(bf16_t, WS_VP), WSP(bf16_t, WS_KS), WSP(bf16_t, WS_VS), new_k, new_v);
            PHASE_END
        } else { ++ph; }
        if (part == 0 && kind == 2) {
            PHASE_BEGIN_R(REP_ATT)
            attn_phase(WSP(bf16_t, WS_Q), WSP(bf16_t, WS_KP), WSP(bf16_t, WS_VP), WSP(bf16_t, WS_KS), WSP(bf16_t, WS_VS), WSP(bf16_t, WS_A2), (char*)lds_raw);
            PHASE_END
        } else { ++ph; }
        PHASE_BEGIN_R(part ? REP_FOUT : REP_MIXOUT)
        {
            const float* MOD = WSP(float, WS_MOD);
            const float* modl = MOD + (size_t)layer * 3 * 6144;
            pg8::Gemm g; const float* cs = nullptr;
            if (part == 1) g = pg8::Gemm{WSP(bf16_t, WS_ACT), WSP(bf16_t, WS_FOUT) + (size_t)layer * 1024 * 2816, MT, 1024, DFF, DFF, 0};
            else if (kind == 0) g = pg8::Gemm{WSP(bf16_t, WS_A2), WSP(bf16_t, WS_COUT) + (size_t)j * 1024 * 1024, MT, 1024, 1024, 1024, 0};
            else if (kind == 1) { g = pg8::Gemm{WSP(bf16_t, WS_A2), WSP(bf16_t, WS_POOL), MT, 1024, 256, 1024, 256}; cs = q->in[14] + j * 1024; }
            else g = pg8::Gemm{WSP(bf16_t, WS_A2), WSP(bf16_t, WS_AOUT), MT, 1024, 1024, 1024, 0};
            pg8::StaticOrder S; S.init(g.M, g.N, gridDim.x, (int)__builtin_amdgcn_readfirstlane(bst[3]), 64 * MF_RES);
            const float* nw = part == 0 ? q->in[7] + layer * 1024 : q->in[6] + (layer + 1) * 1024;
            const float* nsc = part == 0 ? modl + 4 * 1024 : modl + 3 * 6144 + 1 * 1024;
            bf16_t* xg = hl == 7 ? nullptr : WSP(bf16_t, WS_H);
            bf16_t* xo = rep_ + 1 < (part ? REP_FOUT : REP_MIXOUT) ? WSP(bf16_t, WS_X2) : WSP(bf16_t, WS_X);
            pg8::gemm_phase<MF_RES>(lds, g, S, pg8::EpiResid<MF_RES>{WSP(bf16_t, WS_X), xo, modl + (part ? 5 : 2) * 1024, cs, xg, WSP(float, WS_SSQ), nw, nsc});
            if (part == 1 && layer < 3) {
                const int ln = layer + 1; float* SW = WSP(float, WS_SW); const float* modn = MOD + (size_t)ln * 3 * 6144;
                const int w0 = blockIdx.x * 8 + (tid_opaque() >> 6), nwv = gridDim.x * 8;
                if (ln == 2) sw_rows(WSP(bf16_t, WS_QKVW), 1536, modn, SW + 6144, w0, nwv);
                else if (ln == 3) sw_rows(WSP(bf16_t, WS_CIN) + (size_t)3072 * 1024, 3072, modn, SW + 3072, w0, nwv);
                sw_rows(WSP(bf16_t, WS_FIN) + (size_t)ln * 5632 * 1024, 5632, modn + 3 * 1024, SW + 7680 + ln * 5632, w0, nwv);
            }
        }
        PHASE_END
    }
    PHASE_BEGIN_R(REP_NORM)
    final_norm_phase(WSP(bf16_t, WS_X), WSP(float, WS_SSQ), q->in[21], q->out);
    PHASE_END
#ifdef EXTRA_SYNCS
    if (ph_hi - ph_lo > 1) { for (int i_ = 0; i_ < EXTRA_SYNCS; ++i_) xcd_barrier(bar); }
#endif
#undef PHASE_BEGIN
#undef PHASE_END
}

extern "C" void kernel_launch(void* const* d_in, const int* in_sizes, int n_in, void* d_out, int out_size, void* d_ws, size_t ws_size, hipStream_t stream) {
    static int grid = 0;
    if (grid == 0) {
        if (n_in != 22 || ws_size < WS_END) { fprintf(stderr, "kernel_launch: unexpected n_in %d / ws %zu (need %zu)\n", n_in, ws_size, (size_t)WS_END); grid = -1; return; }
        int dev = 0, cus = 0, per_cu = 0;
        hipGetDevice(&dev);
        hipDeviceGetAttribute(&cus, hipDeviceAttributeMultiprocessorCount, dev);
        if (hipFuncSetAttribute((const void*)fwd_megakernel, hipFuncAttributeMaxDynamicSharedMemorySize, LDS_BYTES) != hipSuccess) { fprintf(stderr, "kernel_launch: hipFuncSetAttribute failed\n"); grid = -1; return; }
        if (hipOccupancyMaxActiveBlocksPerMultiprocessor(&per_cu, (const void*)fwd_megakernel, NTHREADS, LDS_BYTES) != hipSuccess || per_cu < 1) { fprintf(stderr, "kernel_launch: occupancy query gave %d\n", per_cu); per_cu = 1; }
        (void)hipGetLastError();
        grid = cus * per_cu;
        fprintf(stderr, "kernel_launch: grid %d (cus %d x %d)\n", grid, cus, per_cu);
    }
    if (grid < 0) return;
    Params p{};
    for (int i = 0; i < 22; ++i) p.in[i] = (const float*)d_in[i];
    p.out = (float*)d_out; p.ws = (unsigned char*)d_ws;
#if MK_MULTI
    for (int ph = 0; ph < NPH; ++ph) {
        p.ph_lo = ph; p.ph_hi = ph + 1;
        hipLaunchKernelGGL(fwd_megakernel, dim3(grid), dim3(NTHREADS), LDS_BYTES, stream, p);
    }
#else
    p.ph_lo = 0; p.ph_hi = NPH;
    (void)hipMemsetAsync((char*)d_ws + WS_BAR, 0, 16384, stream);
    void* args[] = {&p};
    hipError_t e = hipLaunchCooperativeKernel((const void*)fwd_megakernel, dim3(grid), dim3(NTHREADS), args, LDS_BYTES, stream);
    if (e != hipSuccess) fprintf(stderr, "kernel_launch: cooperative launch failed: %s (grid %d)\n", hipGetErrorString(e), grid);
#endif
}
```

```cpp
#include <hip/hip_runtime.h>
#include <hip/hip_cooperative_groups.h>
#include <cstdio>
#include <cstdint>
namespace cg = cooperative_groups;

#ifndef MK_MULTI
#define MK_MULTI 0
#endif

#ifndef REP_PREP
#define REP_PREP 1
#endif
#ifndef REP_NORM
#define REP_NORM 1
#endif
#ifndef REP_FIN
#define REP_FIN 1
#endif
#ifndef REP_FOUT
#define REP_FOUT 1
#endif
#ifndef REP_CIN
#define REP_CIN 1
#endif
#ifndef REP_ATT
#define REP_ATT 1
#endif
#ifndef REP_EW
#define REP_EW 1
#endif
#ifndef REP_MIXOUT
#define REP_MIXOUT 1
#endif
#ifndef MF_FIN
#define MF_FIN 4
#endif
#ifndef MF_CIN
#define MF_CIN 3
#endif
#ifndef MF_QKV
#define MF_QKV 3
#endif
#ifndef MF_RES
#define MF_RES 3
#endif
#define LAS __attribute__((address_space(3)))
typedef unsigned short bf16_t;
typedef short bf16x8 __attribute__((ext_vector_type(8)));
typedef short s16x4 __attribute__((ext_vector_type(4)));
typedef float f32x4 __attribute__((ext_vector_type(4)));
typedef float f32x16 __attribute__((ext_vector_type(16)));
typedef unsigned u32x4 __attribute__((ext_vector_type(4)));
typedef unsigned u32x2 __attribute__((ext_vector_type(2)));

constexpr int DM = 1024, NP = 4096  , NS = 8192  , MT = NP + NS;
constexpr int SEQP = 256, SEQS = 4096, PAST = 256, SKV_S = PAST + SEQS;
constexpr int DFF = 2816, NMOD = 6, NQKV = 1536;
constexpr int NTHREADS = 512;
constexpr int NSW = 2 * 3072 + 1536 + 4 * 5632;
constexpr int LDS_BYTES = 132 * 1024;

constexpr size_t AL(size_t x) { return (x + 255) / 256 * 256; }
constexpr size_t WS_MOD   = 0;
constexpr size_t WS_CIN   = AL(WS_MOD + 4ull * 3 * 6 * 1024 * 4);
constexpr size_t WS_COUT  = AL(WS_CIN + 2ull * 3072 * 1024 * 2);
constexpr size_t WS_POOL  = AL(WS_COUT + 2ull * 1024 * 1024 * 2);
constexpr size_t WS_QKVW  = AL(WS_POOL + 4ull * 256 * 256 * 2);
constexpr size_t WS_AOUT  = AL(WS_QKVW + 1536ull * 1024 * 2);
constexpr size_t WS_FIN   = AL(WS_AOUT + 1024ull * 1024 * 2);
constexpr size_t WS_FOUT  = AL(WS_FIN + 4ull * 5632 * 1024 * 2);
constexpr size_t WS_X     = AL(WS_FOUT + 4ull * 1024 * 2816 * 2);
constexpr size_t WS_H     = AL(WS_X + (size_t)MT * 1024 * 4);
constexpr size_t WS_A2    = AL(WS_H + (size_t)MT * 1024 * 2);
constexpr size_t WS_BB    = AL(WS_A2 + (size_t)MT * 1024 * 2);
constexpr size_t WS_Z     = AL(WS_BB + (size_t)MT * 1024 * 2);
constexpr size_t WS_ACT   = AL(WS_Z + (size_t)MT * 1024 * 2);
constexpr size_t WS_QKV   = WS_BB;
constexpr size_t WS_Q     = WS_H;
constexpr size_t WS_KP    = AL(WS_ACT + (size_t)MT * 2816 * 2);
constexpr size_t WS_VP    = AL(WS_KP + 16ull * 2 * 256 * 128 * 2);
constexpr size_t WS_KS    = AL(WS_VP + 16ull * 2 * 256 * 128 * 2);
constexpr size_t WS_VS    = AL(WS_KS + 2ull * 2 * SKV_S * 128 * 2);
constexpr size_t WS_SSQ   = AL(WS_VS + 2ull * 2 * SKV_S * 128 * 2);
constexpr size_t WS_SW    = AL(WS_SSQ + (size_t)MT * 16 * 4);
constexpr size_t WS_BAR   = AL(WS_SW + 3ull * 30208 * 4);
constexpr size_t WS_X2    = AL(WS_BAR + 16384);
constexpr size_t WS_END   = AL(WS_X2 + (size_t)MT * 1024 * 4);

struct Params {
    const float* in[22];
    float* out;
    unsigned char* ws;
    int ph_lo, ph_hi;
};

__device__ __forceinline__ unsigned cvt_pk_bf16(float lo, float hi) { unsigned r; asm volatile("v_cvt_pk_bf16_f32 %0, %1, %2" : "=v"(r) : "v"(lo), "v"(hi)); return r; }
__device__ __forceinline__ float bf2f(unsigned short b) { return __uint_as_float(((unsigned)b) << 16); }
__device__ __forceinline__ float bflo(unsigned w) { return __uint_as_float(w << 16); }
__device__ __forceinline__ float bfhi(unsigned w) { return __uint_as_float(w & 0xffff0000u); }
__device__ __forceinline__ float silu_f(float x) { return x * __builtin_amdgcn_rcpf(1.0f + __builtin_amdgcn_exp2f(-1.4426950408889634f * x)); }
__device__ __forceinline__ int tid_opaque() { int t = threadIdx.x; asm volatile("" : "+v"(t)); return t; }
__device__ __forceinline__ float quad_row_sum(float s) {
    { auto r = __builtin_amdgcn_permlane16_swap(__float_as_uint(s), __float_as_uint(s), false, false); s = __uint_as_float(r[0]) + __uint_as_float(r[1]); }
    { auto r = __builtin_amdgcn_permlane32_swap(__float_as_uint(s), __float_as_uint(s), false, false); s = __uint_as_float(r[0]) + __uint_as_float(r[1]); }
    return s;
}
__device__ __forceinline__ float wave_sum(float v) {
#pragma unroll
    for (int o = 32; o >= 1; o >>= 1) v += __shfl_xor(v, o);
    return v;
}

namespace pg8 {
constexpr int BM = 256, BK = 64, HALF = 128, HTB = HALF * BK * 2, STAGE_BYTES = 8 * HTB, NXCD = 8, WGM = 8;
__host__ __device__ __forceinline__ int lds_byte(int r, int c) { const int st = (r >> 4) * 2 + (c >> 5), rr = r & 15, cc = c & 31, ob = rr * 64 + cc * 2; return st * 1024 + (ob ^ (((ob >> 9) & 1) << 5)); }
__host__ __device__ __forceinline__ void stage_rc(int b, int& R, int& C) { const int st = b / 1024, sb = b % 1024, swz = sb ^ (((sb >> 9) & 1) << 5); R = (st >> 1) * 16 + swz / 64; C = (st & 1) * 32 + (swz % 64) / 2; }
__host__ __device__ __forceinline__ int perm32(int rho) { const int n = rho >> 4, i = rho & 15; return 8 * (i >> 2) + 4 * n + (i & 3); }

struct Unit { int pm, pn; };
struct Gemm { const bf16_t* A; const bf16_t* Bt; int M, N, K, lda, a_pn_off; };

struct StaticOrder {
    int nM, nN, nwg, G, c, wgm;
    __device__ void init(int M, int N, int G_, int c_, int tile_rows) { nM = M / tile_rows; nN = N / BM; nwg = nM * nN; G = G_; c = c_; wgm = (nM % 8 == 0) ? nM / 8 : WGM; }
    __device__ bool next(int i, Unit& u) const {
        const long L = (long)i * G + c; if (L >= nwg) return false;
        int wgid = (int)L; { const int q = nwg / NXCD, r = nwg % NXCD, xcd = wgid % NXCD, off = wgid / NXCD; wgid = (xcd < r ? xcd * (q + 1) : r * (q + 1) + (xcd - r) * q) + off; }
        const int nig = wgm * nN, gid = wgid / nig, fm = gid * wgm, gsz = (nM - fm) < wgm ? (nM - fm) : wgm;
        u.pm = fm + ((wgid % nig) % gsz); u.pn = (wgid % nig) / gsz; return true;
    }
};

template <int MF, class Epi>
__device__ __forceinline__ void gemm_phase(LAS unsigned char* lds, const Gemm g, const StaticOrder& S, const Epi& E) {
    const int tid = tid_opaque(), wid = __builtin_amdgcn_readfirstlane(tid >> 6), lane = tid & 63, wr = wid >> 2, wc = wid & 3, fr = lane & 15, fq = lane >> 4;
    const int K = g.K, nt = K / BK, lda = g.lda;
    unsigned voffA[2], voffB[2];
#pragma unroll
    for (int i = 0; i < 2; ++i) { int R, C; stage_rc(tid * 16 + i * 8192, R, C); const int Rb = Epi::PERM ? ((R & ~31) + perm32(R & 31)) : R;
        voffA[i] = (unsigned)(R * lda + C) * 2u; voffB[i] = (unsigned)(Rb * K + C) * 2u; }
    const size_t kstep = (size_t)(BK * 2);
    const size_t hstepA = (size_t)(32 * MF) * lda * 2, hstepB = (size_t)HALF * K * 2;
    const size_t tstepA = 2 * hstepA, tstepB = 2 * hstepB;
    const size_t pnoffA = (size_t)g.a_pn_off * 2;
    const unsigned ldsw = (unsigned)wid * 1024u;
    const int aoff = lds_byte(wr * 16 * MF + fr, fq * 8), boff = lds_byte(wc * 32 + fr, fq * 8);
#define PG8_SA(b, h) (((b) * 2 + (h)) * HTB)
#define PG8_SB(b, h) ((4 + (b) * 2 + (h)) * HTB)
#define PG8_STAGE(bufoff, gbase, voff) do { _Pragma("unroll") for (int _i = 0; _i < 2; ++_i) \
        __builtin_amdgcn_global_load_lds((const unsigned*)((const char*)(gbase) + (voff)[_i]), (LAS unsigned*)(lds + (bufoff) + ldsw + _i * 8192), 16, 0, 0); } while (0)
#define PG8_LDA(dst, b, h) do { _Pragma("unroll") for (int m = 0; m < MF; ++m) _Pragma("unroll") for (int k = 0; k < 2; ++k) dst[m][k] = *(const LAS bf16x8*)(lds + PG8_SA(b, h) + aoff + m * 2048 + k * 1024); } while (0)
#define PG8_LDB(dst, b, h) do { _Pragma("unroll") for (int n = 0; n < 2; ++n) _Pragma("unroll") for (int k = 0; k < 2; ++k) dst[n][k] = *(const LAS bf16x8*)(lds + PG8_SB(b, h) + boff + n * 2048 + k * 1024); } while (0)
#define PG8_MMA(ai, bj, At, Bt) do { __builtin_amdgcn_s_setprio(1); _Pragma("unroll") for (int m = 0; m < MF; ++m) _Pragma("unroll") for (int n = 0; n < 2; ++n) _Pragma("unroll") for (int k = 0; k < 2; ++k) \
        acc[ai][bj][m][n] = __builtin_amdgcn_mfma_f32_16x16x32_bf16(Bt[n][k], At[m][k], acc[ai][bj][m][n], 0, 0, 0); __builtin_amdgcn_s_setprio(0); } while (0)
#define PG8_WAIT_V(n) asm volatile("s_waitcnt vmcnt(" #n ")" ::: "memory")
#define PG8_WAIT_L(n) asm volatile("s_waitcnt lgkmcnt(" #n ")" ::: "memory")
#define PG8_BAR __builtin_amdgcn_s_barrier()
#define PG8_SCHED __builtin_amdgcn_sched_barrier(0)
    Unit cur, nxt; int ui = 0;
    if (!S.next(0, cur)) return;
    f32x4 acc[2][2][MF][2];
#pragma unroll
    for (int a = 0; a < 2; ++a)
#pragma unroll
        for (int b = 0; b < 2; ++b)
#pragma unroll
            for (int m = 0; m < MF; ++m)
#pragma unroll
                for (int n = 0; n < 2; ++n) acc[a][b][m][n] = (f32x4){0.f, 0.f, 0.f, 0.f};
    bf16x8 At[MF][2], B0[2][2], B1[2][2];
    const char* cA = (const char*)g.A + (size_t)cur.pm * tstepA + (size_t)cur.pn * pnoffA; const char* cB = (const char*)g.Bt + (size_t)cur.pn * tstepB;
    PG8_STAGE(PG8_SB(0, 0), cB, voffB); PG8_STAGE(PG8_SA(0, 0), cA, voffA); PG8_STAGE(PG8_SB(0, 1), cB + hstepB, voffB); PG8_STAGE(PG8_SA(0, 1), cA + hstepA, voffA);
    if (wr == 1) PG8_BAR;
    PG8_WAIT_V(4); PG8_BAR;
    PG8_STAGE(PG8_SB(1, 0), cB + kstep, voffB); PG8_STAGE(PG8_SA(1, 0), cA + kstep, voffA); PG8_STAGE(PG8_SB(1, 1), cB + hstepB + kstep, voffB);
    PG8_WAIT_V(6); PG8_BAR;
    for (;;) {
        const bool has_next = S.next(ui + 1, nxt);
        const char* nA = has_next ? (const char*)g.A + (size_t)nxt.pm * tstepA + (size_t)nxt.pn * pnoffA : cA; const char* nB = has_next ? (const char*)g.Bt + (size_t)nxt.pn * tstepB : cB;
        for (int t = 0; t < nt; t += 2) {
            const bool last = (t == nt - 2);
            const char* a1 = cA + (size_t)(t + 1) * kstep;
            const char* a2 = last ? nA : cA + (size_t)(t + 2) * kstep; const char* b2 = last ? nB : cB + (size_t)(t + 2) * kstep;
            const char* a3 = a2 + kstep; const char* b3 = b2 + kstep;
            PG8_LDB(B0, 0, 0); PG8_SCHED; PG8_LDA(At, 0, 0); PG8_STAGE(PG8_SA(1, 1), a1 + hstepA, voffA);
            PG8_WAIT_L(8); PG8_BAR; PG8_WAIT_L(0); PG8_MMA(0, 0, At, B0); PG8_BAR; PG8_SCHED;
            PG8_LDB(B1, 0, 1); PG8_STAGE(PG8_SB(0, 0), b2, voffB);
            PG8_BAR; PG8_WAIT_L(0); PG8_MMA(0, 1, At, B1); PG8_BAR;
            PG8_LDA(At, 0, 1); PG8_STAGE(PG8_SA(0, 0), a2, voffA);
            PG8_BAR; PG8_WAIT_L(0); PG8_MMA(1, 0, At, B0); PG8_BAR; PG8_SCHED;
            PG8_STAGE(PG8_SB(0, 1), b2 + hstepB, voffB);
            PG8_WAIT_V(6); PG8_BAR; PG8_MMA(1, 1, At, B1); PG8_BAR;
            PG8_LDB(B0, 1, 0); PG8_SCHED; PG8_LDA(At, 1, 0); PG8_STAGE(PG8_SA(0, 1), a2 + hstepA, voffA);
            PG8_WAIT_L(8); PG8_BAR; PG8_WAIT_L(0); PG8_MMA(0, 0, At, B0); PG8_BAR; PG8_SCHED;
            PG8_LDB(B1, 1, 1); PG8_STAGE(PG8_SB(1, 0), b3, voffB);
            PG8_BAR; PG8_WAIT_L(0); PG8_MMA(0, 1, At, B1); PG8_BAR;
            PG8_LDA(At, 1, 1); PG8_STAGE(PG8_SA(1, 0), a3, voffA);
            PG8_BAR; PG8_WAIT_L(0); PG8_MMA(1, 0, At, B0); PG8_BAR; PG8_SCHED;
            PG8_STAGE(PG8_SB(1, 1), b3 + hstepB, voffB);
            PG8_WAIT_V(6); PG8_BAR; PG8_MMA(1, 1, At, B1); PG8_BAR;
        }
        E(acc, cur, wr, wc, fr, fq);
        if (!has_next) break;
#pragma unroll
        for (int a = 0; a < 2; ++a)
#pragma unroll
            for (int b = 0; b < 2; ++b)
#pragma unroll
                for (int m = 0; m < MF; ++m)
#pragma unroll
                    for (int n = 0; n < 2; ++n) acc[a][b][m][n] = (f32x4){0.f, 0.f, 0.f, 0.f};
        cur = nxt; cA = nA; cB = nB; ++ui;
    }
    PG8_WAIT_V(0);
    if (wr == 0) PG8_BAR;
    PG8_BAR;
#undef PG8_SA
#undef PG8_SB
#undef PG8_STAGE
#undef PG8_LDA
#undef PG8_LDB
#undef PG8_MMA
#undef PG8_WAIT_V
#undef PG8_WAIT_L
#undef PG8_BAR
#undef PG8_SCHED
}

__device__ __forceinline__ int grp_of_row(int row) { return row < NP ? 0 : (row < NP + SEQS ? 1 : 2); }
__device__ __forceinline__ float row_rstd1(const float* ssq, int row, int fq) {
    const f32x4 p = *(const f32x4*)(ssq + (size_t)row * 16 + fq * 4);
    float s = (p[0] + p[1]) + (p[2] + p[3]);
    s = quad_row_sum(s);
    return __builtin_amdgcn_rsqf(s * (1.0f / 1024.0f) + 1e-6f);
}

template <int MF> struct EpiBf16N {
    static constexpr bool PERM = true;
    bf16_t* C; int ldc; const float* ssq; const float* sw;
    __device__ __forceinline__ void operator()(const f32x4 (&acc)[2][2][MF][2], const Unit& u, int wr, int wc, int fr, int fq) const {
        const int row0 = u.pm * (64 * MF) + wr * (16 * MF) + fr, col0 = u.pn * BM + wc * 32 + 8 * fq;
        f32x4 sv[2][2]; int curg = -1;
#pragma unroll
        for (int ai = 0; ai < 2; ++ai)
#pragma unroll
            for (int m = 0; m < MF; ++m) { const int row = row0 + ai * (32 * MF) + m * 16; bf16_t* rowp = C + (size_t)row * ldc + col0;
                const float rs = row_rstd1(ssq, row, fq); const int grp = grp_of_row(row);
                if (grp != curg) { curg = grp; const float* swp = sw + grp * NSW + col0;
#pragma unroll
                    for (int bj = 0; bj < 2; ++bj) { sv[bj][0] = *(const f32x4*)(swp + bj * HALF); sv[bj][1] = *(const f32x4*)(swp + bj * HALF + 4); } }
#pragma unroll
                for (int bj = 0; bj < 2; ++bj) { const f32x4 v0 = acc[ai][bj][m][0] * rs + sv[bj][0], v1 = acc[ai][bj][m][1] * rs + sv[bj][1];
                    u32x4 w; w.x = cvt_pk_bf16(v0[0], v0[1]); w.y = cvt_pk_bf16(v0[2], v0[3]); w.z = cvt_pk_bf16(v1[0], v1[1]); w.w = cvt_pk_bf16(v1[2], v1[3]);
                    *(u32x4*)(rowp + bj * HALF) = w; } }
    }
};
template <int MF> struct EpiResid {
    static constexpr bool PERM = true;
    const bf16_t* base; bf16_t* out; const float* gate; const float* cscale;
    bf16_t* xg; float* ssq; const float* nw; const float* nscale;
    __device__ __forceinline__ void operator()(const f32x4 (&acc)[2][2][MF][2], const Unit& u, int wr, int wc, int fr, int fq) const {
        const int row0 = u.pm * (64 * MF) + wr * (16 * MF) + fr, col0 = u.pn * BM + wc * 32 + 8 * fq;
        f32x4 gvh[2][2], gnh[2][2]; int curg = -1;
        u32x4 xb[2][MF][2];
#pragma unroll
        for (int ai = 0; ai < 2; ++ai)
#pragma unroll
            for (int m = 0; m < MF; ++m)
#pragma unroll
                for (int bj = 0; bj < 2; ++bj) xb[ai][m][bj] = *(const u32x4*)(base + (size_t)(row0 + ai * (32 * MF) + m * 16) * DM + col0 + bj * HALF);
        asm volatile("" ::: "memory");
#pragma unroll
        for (int ai = 0; ai < 2; ++ai)
#pragma unroll
            for (int m = 0; m < MF; ++m) { const int row = row0 + ai * (32 * MF) + m * 16; const int grp = grp_of_row(row);
                bf16_t* op = out + (size_t)row * DM + col0;
                if (grp != curg) { curg = grp;
                    const float* gp = gate + grp * (NMOD * DM) + col0; const float* np_ = nscale + grp * (NMOD * DM) + col0;
#pragma unroll
                    for (int bj = 0; bj < 2; ++bj)
#pragma unroll
                        for (int n = 0; n < 2; ++n) { gvh[bj][n] = *(const f32x4*)(gp + bj * HALF + n * 4); if (cscale) gvh[bj][n] *= *(const f32x4*)(cscale + col0 + bj * HALF + n * 4);
                            gnh[bj][n] = xg ? *(const f32x4*)(nw + col0 + bj * HALF + n * 4) * (1.0f + *(const f32x4*)(np_ + bj * HALF + n * 4)) : (f32x4){0.f, 0.f, 0.f, 0.f}; } }
                float s = 0.f;
#pragma unroll
                for (int bj = 0; bj < 2; ++bj) { f32x4 h[2], x[2];
                    const u32x4 bw = xb[ai][m][bj];
                    const f32x4 b0 = {bflo(bw.x), bfhi(bw.x), bflo(bw.y), bfhi(bw.y)}, b1 = {bflo(bw.z), bfhi(bw.z), bflo(bw.w), bfhi(bw.w)};
#pragma unroll
                    for (int n = 0; n < 2; ++n) {
                        x[n] = (n == 0 ? b0 : b1) + gvh[bj][n] * acc[ai][bj][m][n];
                        s += (x[n][0] * x[n][0] + x[n][1] * x[n][1]) + (x[n][2] * x[n][2] + x[n][3] * x[n][3]);
                        if (xg) h[n] = x[n] * gnh[bj][n]; }
                    { u32x4 w; w.x = cvt_pk_bf16(x[0][0], x[0][1]); w.y = cvt_pk_bf16(x[0][2], x[0][3]); w.z = cvt_pk_bf16(x[1][0], x[1][1]); w.w = cvt_pk_bf16(x[1][2], x[1][3]);
                      *(u32x4*)(op + bj * HALF) = w; }
                    if (xg) { u32x4 w; w.x = cvt_pk_bf16(h[0][0], h[0][1]); w.y = cvt_pk_bf16(h[0][2], h[0][3]); w.z = cvt_pk_bf16(h[1][0], h[1][1]); w.w = cvt_pk_bf16(h[1][2], h[1][3]);
                        *(u32x4*)(xg + (size_t)row * DM + col0 + bj * HALF) = w; } }
                s = quad_row_sum(s);
                if (fq == 0) ssq[(size_t)row * 16 + u.pn * 4 + wc] = s; }
    }
};
template <int MF> struct EpiConvIn {
    static constexpr bool PERM = true;
    bf16_t* Bb; bf16_t* Z; const float* ssq; const float* sw;
    __device__ __forceinline__ void operator()(const f32x4 (&acc)[2][2][MF][2], const Unit& u, int wr, int wc, int fr, int fq) const {
        const int row0 = u.pm * (64 * MF) + wr * (16 * MF) + fr;
        const int swc = u.pn * BM + wc * 32 + 8 * fq;
        f32x4 sv[2][2]; int curg = -1;
        if (u.pn < 4) {
            const int col0 = u.pn * BM + wc * 32 + 8 * fq;
#pragma unroll
            for (int ai = 0; ai < 2; ++ai)
#pragma unroll
                for (int m = 0; m < MF; ++m) { const int row = row0 + ai * (32 * MF) + m * 16; bf16_t* rowp = Bb + (size_t)row * DM + col0;
                    const float rs = row_rstd1(ssq, row, fq); const int grp = grp_of_row(row);
                    if (grp != curg) { curg = grp; const float* swp = sw + grp * NSW + swc;
#pragma unroll
                        for (int bj = 0; bj < 2; ++bj) { sv[bj][0] = *(const f32x4*)(swp + bj * HALF); sv[bj][1] = *(const f32x4*)(swp + bj * HALF + 4); } }
#pragma unroll
                    for (int bj = 0; bj < 2; ++bj) { const f32x4 v0 = acc[ai][bj][m][0] * rs + sv[bj][0], v1 = acc[ai][bj][m][1] * rs + sv[bj][1];
                        u32x4 w; w.x = cvt_pk_bf16(v0[0], v0[1]); w.y = cvt_pk_bf16(v0[2], v0[3]); w.z = cvt_pk_bf16(v1[0], v1[1]); w.w = cvt_pk_bf16(v1[2], v1[3]);
                        *(u32x4*)(rowp + bj * HALF) = w; } }
        } else {
            const int col0 = (u.pn - 4) * HALF + wc * 32 + 8 * fq;
#pragma unroll
            for (int ai = 0; ai < 2; ++ai)
#pragma unroll
                for (int m = 0; m < MF; ++m) { const int row = row0 + ai * (32 * MF) + m * 16; bf16_t* rowp = Z + (size_t)row * DM + col0;
                    const float rs = row_rstd1(ssq, row, fq); const int grp = grp_of_row(row);
                    if (grp != curg) { curg = grp; const float* swp = sw + grp * NSW + swc;
#pragma unroll
                        for (int bj = 0; bj < 2; ++bj) { sv[bj][0] = *(const f32x4*)(swp + bj * HALF); sv[bj][1] = *(const f32x4*)(swp + bj * HALF + 4); } }
                    const f32x4 v0 = (acc[ai][0][m][0] * rs + sv[0][0]) * (acc[ai][1][m][0] * rs + sv[1][0]);
                    const f32x4 v1 = (acc[ai][0][m][1] * rs + sv[0][1]) * (acc[ai][1][m][1] * rs + sv[1][1]);
                    u32x4 w; w.x = cvt_pk_bf16(v0[0], v0[1]); w.y = cvt_pk_bf16(v0[2], v0[3]); w.z = cvt_pk_bf16(v1[0], v1[1]); w.w = cvt_pk_bf16(v1[2], v1[3]);
                    *(u32x4*)rowp = w; }
        }
    }
};
template <int MF> struct EpiSwiglu {
    static constexpr bool PERM = true;
    bf16_t* ACT; const float* ssq; const float* sw;
    __device__ __forceinline__ void operator()(const f32x4 (&acc)[2][2][MF][2], const Unit& u, int wr, int wc, int fr, int fq) const {
        const int row0 = u.pm * (64 * MF) + wr * (16 * MF) + fr, col0 = u.pn * HALF + wc * 32 + 8 * fq;
        const int swc = u.pn * BM + wc * 32 + 8 * fq;
        f32x4 sv[2][2], svn[2]; int curg = -1;
#pragma unroll
        for (int ai = 0; ai < 2; ++ai)
#pragma unroll
            for (int m = 0; m < MF; ++m) { const int row = row0 + ai * (32 * MF) + m * 16; bf16_t* rowp = ACT + (size_t)row * DFF + col0;
                const float rs = row_rstd1(ssq, row, fq); const int grp = grp_of_row(row);
                if (grp != curg) { curg = grp; const float* swp = sw + grp * NSW + swc;
#pragma unroll
                    for (int bj = 0; bj < 2; ++bj) { sv[bj][0] = *(const f32x4*)(swp + bj * HALF); sv[bj][1] = *(const f32x4*)(swp + bj * HALF + 4); }
                    svn[0] = sv[0][0] * -1.4426950408889634f; svn[1] = sv[0][1] * -1.4426950408889634f; }
                const f32x4 sg0 = sv[0][0], sg1 = sv[0][1];
                const f32x4 g0 = acc[ai][0][m][0] * rs + sg0, g1 = acc[ai][0][m][1] * rs + sg1;
                const float rsn = rs * -1.4426950408889634f;
                f32x4 e0 = acc[ai][0][m][0] * rsn + svn[0], e1 = acc[ai][0][m][1] * rsn + svn[1];
                const f32x4 u0 = acc[ai][1][m][0] * rs + sv[1][0], u1 = acc[ai][1][m][1] * rs + sv[1][1];
#pragma unroll
                for (int j = 0; j < 4; ++j) { e0[j] = __builtin_amdgcn_exp2f(e0[j]); e1[j] = __builtin_amdgcn_exp2f(e1[j]); }
                e0 = e0 + 1.0f; e1 = e1 + 1.0f;
#pragma unroll
                for (int j = 0; j < 4; ++j) { e0[j] = __builtin_amdgcn_rcpf(e0[j]); e1[j] = __builtin_amdgcn_rcpf(e1[j]); }
                const f32x4 v0 = (g0 * u0) * e0, v1 = (g1 * u1) * e1;
                u32x4 w; w.x = cvt_pk_bf16(v0[0], v0[1]); w.y = cvt_pk_bf16(v0[2], v0[3]); w.z = cvt_pk_bf16(v1[0], v1[1]); w.w = cvt_pk_bf16(v1[2], v1[3]);
                *(u32x4*)rowp = w; }
    }
};
}

namespace att {
constexpr int D = 128, NW = 8, QBLK = 32, KVBLK = 64;
constexpr float SCALE = 0.088388347648318440f;
constexpr float THR = 8.f;
constexpr int LDQ = 1024, LDK = 128, LDO = 1024;
constexpr size_t SHM_V = KVBLK * D * 2, SHM_K = KVBLK * D * 2, SHM_ATTN = 2 * SHM_V + 2 * SHM_K + NW * 64 * 4;
#define KSWZ(row, colB) ((row) * 256 + ((colB) ^ (((row) & 7) << 4)))
#define SBAR() __builtin_amdgcn_sched_barrier(0)
__device__ __forceinline__ int crow(int r, int hi) { return (r & 3) + 8 * (r >> 2) + 4 * hi; }
__device__ __forceinline__ unsigned cvtpk(float lo, float hi) { unsigned r; asm volatile("v_cvt_pk_bf16_f32 %0, %1, %2" : "=v"(r) : "v"(lo), "v"(hi)); return r; }

__device__ __forceinline__ void partialSM(f32x16& p0, f32x16& p1, float& m_reg, float& mn, float& alpha) {
  constexpr float C = SCALE * 1.4426950408889634f;
  float pmax = p0[0];
#pragma unroll
  for (int r = 1; r < 16; ++r) pmax = fmaxf(pmax, p0[r]);
#pragma unroll
  for (int r = 0; r < 16; ++r) pmax = fmaxf(pmax, p1[r]);
  { auto rr = __builtin_amdgcn_permlane32_swap(__float_as_uint(pmax), __float_as_uint(pmax), false, false);
    pmax = fmaxf(__uint_as_float(rr[0]), __uint_as_float(rr[1])); }
  if (__builtin_expect(__all(pmax - m_reg <= THR / SCALE), 1)) { mn = m_reg; alpha = 1.f; }
  else { mn = fmaxf(m_reg, pmax); alpha = __builtin_amdgcn_exp2f((m_reg - mn) * C); m_reg = mn; }
  float mnC = -mn * C;
#pragma unroll
  for (int r = 0; r < 16; ++r) p0[r] = fmaf(p0[r], C, mnC);
#pragma unroll
  for (int r = 0; r < 16; ++r) p1[r] = fmaf(p1[r], C, mnC);
#pragma unroll
  for (int r = 0; r < 16; ++r) p0[r] = __builtin_amdgcn_exp2f(p0[r]);
}
__device__ __forceinline__ void finishSM(f32x16& p0, f32x16& p1, float alpha, float& l_reg, bf16x8& pa0, bf16x8& pa1, bf16x8& pa2, bf16x8& pa3) {
#pragma unroll
  for (int r = 0; r < 16; ++r) p1[r] = __builtin_amdgcn_exp2f(p1[r]);
  float ps = 0;
#pragma unroll
  for (int r = 0; r < 16; ++r) ps += p0[r];
#pragma unroll
  for (int r = 0; r < 16; ++r) ps += p1[r];
  { auto rr = __builtin_amdgcn_permlane32_swap(__float_as_uint(ps), __float_as_uint(ps), false, false);
    ps = __uint_as_float(rr[0]) + __uint_as_float(rr[1]); }
  l_reg = l_reg * alpha + ps;
#define PK4(P, BASE, OUT) do { unsigned a0 = cvtpk(P[BASE + 0], P[BASE + 1]), a1 = cvtpk(P[BASE + 2], P[BASE + 3]);   \
    unsigned b0 = cvtpk(P[BASE + 4], P[BASE + 5]), b1 = cvtpk(P[BASE + 6], P[BASE + 7]);                              \
    auto r0 = __builtin_amdgcn_permlane32_swap(a0, b0, false, false); auto r1 = __builtin_amdgcn_permlane32_swap(a1, b1, false, false); \
    u32x4 w = {r0[0], r1[0], r0[1], r1[1]}; OUT = *reinterpret_cast<bf16x8*>(&w); } while (0)
  PK4(p0, 0, pa0); PK4(p0, 8, pa1); PK4(p1, 0, pa2); PK4(p1, 8, pa3);
#undef PK4
}
__device__ __forceinline__ void qkt(f32x16& p0, f32x16& p1, const bf16_t* Ks, const bf16x8* qr, int r32, int hi) {
  p0 = f32x16{}; p1 = f32x16{};
#pragma unroll
  for (int d0 = 0; d0 < 8; ++d0) { int cb = (d0 * 16 + hi * 8) * 2;
    bf16x8 b0 = *reinterpret_cast<const bf16x8*>((const char*)Ks + KSWZ(r32, cb));
    bf16x8 b1 = *reinterpret_cast<const bf16x8*>((const char*)Ks + KSWZ(32 + r32, cb));
    p0 = __builtin_amdgcn_mfma_f32_32x32x16_bf16(b0, qr[d0], p0, 0, 0, 0);
    p1 = __builtin_amdgcn_mfma_f32_32x32x16_bf16(b1, qr[d0], p1, 0, 0, 0); }
}
__device__ __forceinline__ int v_st(int k, int c) { const int kk = (k & ~0xC) | ((k & 4) << 1) | ((k & 8) >> 1); return ((kk >> 3) * 4 + (c >> 5)) * 512 + ((kk & 7) * 32 + (c & 31)) * 2; }
__device__ __forceinline__ int v_rd_base(int lane) { return ((lane & 3) << 3) | (((lane >> 2) & 3) << 6) | (((lane >> 4) & 1) << 5) | (((lane >> 5) & 1) << 8); }
constexpr int v_rd_off(int d0, int ks, int half) { return d0 * 512 + ks * 4096 + half * 2048; }
template <int OFF> __device__ __forceinline__ s16x4 tr_read(int vb) {
  s16x4 r; asm volatile("ds_read_b64_tr_b16 %0, %1 offset:%2" : "=&v"(r) : "v"(vb), "i"(OFF) : "memory"); return r;
}
template <int D0> __device__ __forceinline__ void pv_one(f32x16& od, int vb, bf16x8 pa0, bf16x8 pa1, bf16x8 pa2, bf16x8 pa3) {
  const s16x4 l0 = tr_read<v_rd_off(D0, 0, 0)>(vb), h0 = tr_read<v_rd_off(D0, 0, 1)>(vb), l1 = tr_read<v_rd_off(D0, 1, 0)>(vb), h1 = tr_read<v_rd_off(D0, 1, 1)>(vb);
  const s16x4 l2 = tr_read<v_rd_off(D0, 2, 0)>(vb), h2 = tr_read<v_rd_off(D0, 2, 1)>(vb), l3 = tr_read<v_rd_off(D0, 3, 0)>(vb), h3 = tr_read<v_rd_off(D0, 3, 1)>(vb);
  asm volatile("s_waitcnt lgkmcnt(0)" ::: "memory"); SBAR();
#define PK(L, H) (bf16x8){L[0], L[1], L[2], L[3], H[0], H[1], H[2], H[3]}
  od = __builtin_amdgcn_mfma_f32_32x32x16_bf16(pa0, PK(l0, h0), od, 0, 0, 0);
  od = __builtin_amdgcn_mfma_f32_32x32x16_bf16(pa1, PK(l1, h1), od, 0, 0, 0);
  od = __builtin_amdgcn_mfma_f32_32x32x16_bf16(pa2, PK(l2, h2), od, 0, 0, 0);
  od = __builtin_amdgcn_mfma_f32_32x32x16_bf16(pa3, PK(l3, h3), od, 0, 0, 0);
#undef PK
}
__device__ __forceinline__ void pv_d0(f32x16* o, int vb, bf16x8 pa0, bf16x8 pa1, bf16x8 pa2, bf16x8 pa3) {
  pv_one<0>(o[0], vb, pa0, pa1, pa2, pa3); pv_one<1>(o[1], vb, pa0, pa1, pa2, pa3); pv_one<2>(o[2], vb, pa0, pa1, pa2, pa3); pv_one<3>(o[3], vb, pa0, pa1, pa2, pa3);
}

__device__ __forceinline__ void attn_dense_body(const bf16_t* __restrict__ Qb, const bf16_t* __restrict__ Kh, const bf16_t* __restrict__ Vh,
                                                bf16_t* __restrict__ Ob, int seq, char* lds) {
  const int tid = tid_opaque(), wid = tid >> 6, lane = tid & 63, r32 = lane & 31, hi = lane >> 5;
  bf16_t* V_lds = (bf16_t*)lds; bf16_t* K_lds = (bf16_t*)(lds + 2 * SHM_V);
  float* ws = (float*)(lds + 2 * SHM_V + 2 * SHM_K) + wid * 64; float* li_l = ws; float* al_l = ws + 32;
  float m_reg = -1e30f, l_reg = 0; f32x16 o[4] = {}; bf16x8 qr[8];
  const bf16_t* Qw = Qb + (long)(wid * QBLK + r32) * LDQ + hi * 8;
#pragma unroll
  for (int d0 = 0; d0 < 8; ++d0) qr[d0] = *reinterpret_cast<const bf16x8*>(Qw + d0 * 16);
  const int sr = tid >> 4, sc = (tid & 15) * 8, vst0 = v_st(sr, sc), vst1 = v_st(32 + sr, sc);
  const int vb0 = (int)(uintptr_t)V_lds + v_rd_base(lane);
  struct { bf16x8 vs0, vs1, ks0, ks1; } sr_[2];
#define SLOAD(i, k0) do { sr_[i].vs0 = *reinterpret_cast<const bf16x8*>(&Vh[(long)((k0) + sr) * LDK + sc]); sr_[i].vs1 = *reinterpret_cast<const bf16x8*>(&Vh[(long)((k0) + 32 + sr) * LDK + sc]); \
    sr_[i].ks0 = *reinterpret_cast<const bf16x8*>(&Kh[(long)((k0) + sr) * LDK + sc]); sr_[i].ks1 = *reinterpret_cast<const bf16x8*>(&Kh[(long)((k0) + 32 + sr) * LDK + sc]); } while (0)
#define SWRITE(b, i) do { *(bf16x8*)((char*)V_lds + (b) * SHM_V + vst0) = sr_[i].vs0;          \
    *(bf16x8*)((char*)V_lds + (b) * SHM_V + vst1) = sr_[i].vs1; int kc = sc * 2;               \
    *(bf16x8*)((char*)K_lds + (b) * SHM_K + KSWZ(sr, kc)) = sr_[i].ks0;                       \
    *(bf16x8*)((char*)K_lds + (b) * SHM_K + KSWZ(32 + sr, kc)) = sr_[i].ks1; } while (0)
#define SWAIT() asm volatile("s_waitcnt vmcnt(4)" ::: "memory")
#define RESC(a) do { if (__any((a) < 1.f)) { if (hi == 0) al_l[r32] = (a); asm volatile("s_waitcnt lgkmcnt(0)" ::: "memory"); \
    _Pragma("unroll") for (int d = 0; d < 4; ++d) _Pragma("unroll") for (int r = 0; r < 16; ++r) o[d][r] *= al_l[crow(r, hi)]; } } while (0)
  f32x16 pA0, pA1, pB0, pB1; float mnA, mnB, alA, alB; bf16x8 pa0, pa1, pa2, pa3; const int NT = seq / KVBLK;
  constexpr int SE = 0, SO = 1;
  SLOAD(SE, 0); asm volatile("s_waitcnt vmcnt(0)" ::: "memory"); SWRITE(0, SE); __syncthreads();
  qkt(pA0, pA1, K_lds, qr, r32, hi); partialSM(pA0, pA1, m_reg, mnA, alA);
  SLOAD(SO, KVBLK); if (2 < NT) SLOAD(SE, 2 * KVBLK);
  SWAIT(); SWRITE(1, SO); __syncthreads();
  for (int j = 1; j + 1 < NT; j += 2) {
    SBAR(); qkt(pB0, pB1, (bf16_t*)((char*)K_lds + SHM_K), qr, r32, hi);
    finishSM(pA0, pA1, alA, l_reg, pa0, pa1, pa2, pa3); SBAR();
    SLOAD(SO, (j + 2) * KVBLK); SBAR();
    pv_d0(o, vb0, pa0, pa1, pa2, pa3); partialSM(pB0, pB1, m_reg, mnB, alB);
    __syncthreads(); SWAIT(); SWRITE(0, SE);
    RESC(alB); __syncthreads();
    SBAR(); qkt(pA0, pA1, K_lds, qr, r32, hi);
    finishSM(pB0, pB1, alB, l_reg, pa0, pa1, pa2, pa3); SBAR();
    if (j + 3 < NT) SLOAD(SE, (j + 3) * KVBLK); SBAR();
    pv_d0(o, vb0 + (int)SHM_V, pa0, pa1, pa2, pa3); partialSM(pA0, pA1, m_reg, mnA, alA);
    __syncthreads(); SWAIT(); SWRITE(1, SO);
    RESC(alA); __syncthreads();
  }
  SBAR(); qkt(pB0, pB1, (bf16_t*)((char*)K_lds + SHM_K), qr, r32, hi);
  finishSM(pA0, pA1, alA, l_reg, pa0, pa1, pa2, pa3); SBAR();
  pv_d0(o, vb0, pa0, pa1, pa2, pa3); partialSM(pB0, pB1, m_reg, mnB, alB);
  __syncthreads(); RESC(alB);
  finishSM(pB0, pB1, alB, l_reg, pa0, pa1, pa2, pa3); SBAR();
  pv_d0(o, vb0 + (int)SHM_V, pa0, pa1, pa2, pa3);
  if (hi == 0) li_l[r32] = l_reg; asm volatile("s_waitcnt lgkmcnt(0)" ::: "memory");
  float rli[16];
#pragma unroll
  for (int r = 0; r < 16; ++r) rli[r] = __builtin_amdgcn_rcpf(li_l[crow(r, hi)]);
  bf16_t* Ow = Ob + (long)(wid * QBLK) * LDO;
#pragma unroll
  for (int r = 0; r < 16; ++r) { int orow = crow(r, hi);
#pragma unroll
    for (int d0 = 0; d0 < 4; ++d0) Ow[(long)orow * LDO + d0 * 32 + r32] = (bf16_t)(cvtpk(o[d0][r] * rli[r], 0.f) & 0xffffu); }
  __syncthreads();
#undef SLOAD
#undef SWRITE
#undef SWAIT
#undef RESC
}
}

__device__ __forceinline__ int src_col(int mode, int nd) {
    if (mode == 1) { if (nd < 1024) return nd; const int q = nd - 1024, j = q >> 8, r = q & 255; return r < 128 ? 1024 + 128 * j + r : 2048 + 128 * j + (r - 128); }
    if (mode == 2) { const int j = nd >> 8, r = nd & 255; return r < 128 ? 128 * j + r : DFF + 128 * j + (r - 128); }
    return nd;
}
struct CvtRegs { f32x4 v[4]; };
__device__ __forceinline__ void cvt_load(const float* __restrict__ W, int ldw, int mode, int nkt, int u, int tid, CvtRegs& rg) {
    const int kt = u % nkt, ntile = u / nkt, r = tid >> 3, c16 = (tid & 7) * 16;
    const float* src = W + (size_t)(kt * 64 + r) * ldw + src_col(mode, ntile * 128) + c16;
#pragma unroll
    for (int i = 0; i < 4; ++i) rg.v[i] = *(const f32x4*)(src + 4 * i);
}
__device__ __forceinline__ void cvt_matrix(const float* __restrict__ W, int K, int N, bf16_t* __restrict__ Bt, int mode, int& uoff, float* tile, int wk, int nwk) {
    const int tid = tid_opaque(), nkt = K / 64, nu = nkt * (N / 128);
    const int first = (wk - (uoff % nwk) + nwk) % nwk;
    uoff += nu;
    if (first >= nu) return;
    CvtRegs cur, nxt; cvt_load(W, N, mode, nkt, first, tid, cur);
    for (int u = first; u < nu; u += nwk) {
        const int r = tid >> 3, c16 = (tid & 7) * 16;
        float* tp = tile + r * 129 + c16;
#pragma unroll
        for (int i = 0; i < 4; ++i) { tp[4 * i + 0] = cur.v[i][0]; tp[4 * i + 1] = cur.v[i][1]; tp[4 * i + 2] = cur.v[i][2]; tp[4 * i + 3] = cur.v[i][3]; }
        __syncthreads();
        if (u + nwk < nu) cvt_load(W, N, mode, nkt, u + nwk, tid, nxt);
        const int kt = u % nkt, ntile = u / nkt, n = tid >> 2, kc = (tid & 3) * 16;
        const float* rp = tile + kc * 129 + n;
        u32x4 w0, w1;
        w0.x = cvt_pk_bf16(rp[0 * 129], rp[1 * 129]); w0.y = cvt_pk_bf16(rp[2 * 129], rp[3 * 129]); w0.z = cvt_pk_bf16(rp[4 * 129], rp[5 * 129]); w0.w = cvt_pk_bf16(rp[6 * 129], rp[7 * 129]);
        w1.x = cvt_pk_bf16(rp[8 * 129], rp[9 * 129]); w1.y = cvt_pk_bf16(rp[10 * 129], rp[11 * 129]); w1.z = cvt_pk_bf16(rp[12 * 129], rp[13 * 129]); w1.w = cvt_pk_bf16(rp[14 * 129], rp[15 * 129]);
        bf16_t* dst = Bt + (size_t)(ntile * 128 + n) * K + kt * 64 + kc;
        *(u32x4*)dst = w0; *(u32x4*)(dst + 8) = w1;
        __syncthreads();
        cur = nxt;
    }
}

__device__ __forceinline__ void adaln_units(const float* c, const float* c_ctx, const float* ada_w, const float* ada_b, float* MOD, float* lds_f, int& uoff, int l0, int wk, int G) {
    const int tid = tid_opaque();
    float* sv = lds_f;
    float* red = lds_f + 3 * 1024;
    for (int i = tid; i < 3 * 1024; i += NTHREADS) { const int g = i >> 10, k = i & 1023; const float v = g == 0 ? c_ctx[k] : c[(g - 1) * 1024 + k]; sv[i] = silu_f(v); }
    __syncthreads();
    const int nu = 192;
    int first = (wk - (uoff % G) + G) % G;
    const int cq = tid & 7, ks = tid >> 3;
    for (int u = first; u < nu; u += G) {
        const int l = l0, cc = u * 32;
        const float* wp = ada_w + (size_t)l * 1024 * 6144 + cc + cq * 4;
        f32x4 a0 = {0, 0, 0, 0}, a1 = a0, a2 = a0;
#pragma unroll 8
        for (int it = 0; it < 16; ++it) { const int k = ks + 64 * it; const f32x4 w = *(const f32x4*)(wp + (size_t)k * 6144);
            a0 += sv[k] * w; a1 += sv[1024 + k] * w; a2 += sv[2048 + k] * w; }
        float* rp = red + ks * 96 + cq * 4;
#pragma unroll
        for (int j = 0; j < 4; ++j) { rp[j] = a0[j]; rp[32 + j] = a1[j]; rp[64 + j] = a2[j]; }
        __syncthreads();
        if (tid < 96) { float s = 0; for (int q = 0; q < 64; ++q) s += red[q * 96 + tid]; const int g = tid >> 5, n = cc + (tid & 31);
            MOD[((size_t)l * 3 + g) * 6144 + n] = s + ada_b[l * 6144 + n]; }
        __syncthreads();
    }
    uoff += nu;
}

__device__ __forceinline__ void unpack8(const u32x4 w, float* f) { f[0] = bflo(w.x); f[1] = bfhi(w.x); f[2] = bflo(w.y); f[3] = bfhi(w.y); f[4] = bflo(w.z); f[5] = bfhi(w.z); f[6] = bflo(w.w); f[7] = bfhi(w.w); }
__device__ __forceinline__ u32x4 pack8(const float* f) { u32x4 w; w.x = cvt_pk_bf16(f[0], f[1]); w.y = cvt_pk_bf16(f[2], f[3]); w.z = cvt_pk_bf16(f[4], f[5]); w.w = cvt_pk_bf16(f[6], f[7]); return w; }
__device__ __forceinline__ void norm0_phase(const float* __restrict__ xp, const float* __restrict__ xs, const float* __restrict__ nw, const float* __restrict__ scale, bf16_t* __restrict__ XG, float* __restrict__ SSQ, bf16_t* __restrict__ XB) {
    const int tidq = tid_opaque(); const int lane = tidq & 63, wid = tidq >> 6;
    f32x4 wv[4];
#pragma unroll
    for (int j = 0; j < 4; ++j) wv[j] = *(const f32x4*)(nw + j * 256 + lane * 4);
    const int stride = gridDim.x * 8;
    for (int row = blockIdx.x * 8 + wid; row < MT; row += 2 * stride) {
        const int rowb = row + stride < MT ? row + stride : row;
        const float* xa = row < NP ? xp + (size_t)row * DM : xs + (size_t)(row - NP) * DM;
        const float* xb = rowb < NP ? xp + (size_t)rowb * DM : xs + (size_t)(rowb - NP) * DM;
        f32x4 va[4], vb[4];
#pragma unroll
        for (int j = 0; j < 4; ++j) { va[j] = *(const f32x4*)(xa + j * 256 + lane * 4); vb[j] = *(const f32x4*)(xb + j * 256 + lane * 4); }
        const float* sca = scale + (row < NP ? 0 : (row < NP + SEQS ? 1 : 2)) * 6144; const float* scb = scale + (rowb < NP ? 0 : (rowb < NP + SEQS ? 1 : 2)) * 6144;
        float sa = 0, sb = 0;
#pragma unroll
        for (int j = 0; j < 4; ++j) {
            sa += (va[j][0] * va[j][0] + va[j][1] * va[j][1]) + (va[j][2] * va[j][2] + va[j][3] * va[j][3]);
            sb += (vb[j][0] * vb[j][0] + vb[j][1] * vb[j][1]) + (vb[j][2] * vb[j][2] + vb[j][3] * vb[j][3]);
            const f32x4 ha = va[j] * wv[j] * (1.0f + *(const f32x4*)(sca + j * 256 + lane * 4)), hb = vb[j] * wv[j] * (1.0f + *(const f32x4*)(scb + j * 256 + lane * 4));
            u32x2 oa, ob; oa.x = cvt_pk_bf16(ha[0], ha[1]); oa.y = cvt_pk_bf16(ha[2], ha[3]); ob.x = cvt_pk_bf16(hb[0], hb[1]); ob.y = cvt_pk_bf16(hb[2], hb[3]);
            *(u32x2*)(XG + (size_t)row * DM + j * 256 + lane * 4) = oa; *(u32x2*)(XG + (size_t)rowb * DM + j * 256 + lane * 4) = ob;
            u32x2 xa, xb; xa.x = cvt_pk_bf16(va[j][0], va[j][1]); xa.y = cvt_pk_bf16(va[j][2], va[j][3]); xb.x = cvt_pk_bf16(vb[j][0], vb[j][1]); xb.y = cvt_pk_bf16(vb[j][2], vb[j][3]);
            *(u32x2*)(XB + (size_t)row * DM + j * 256 + lane * 4) = xa; *(u32x2*)(XB + (size_t)rowb * DM + j * 256 + lane * 4) = xb; }
        sa = wave_sum(sa); sb = wave_sum(sb);
        if (lane < 16) { SSQ[(size_t)row * 16 + lane] = lane == 0 ? sa : 0.f; SSQ[(size_t)rowb * 16 + lane] = lane == 0 ? sb : 0.f; }
    }
}
__device__ __forceinline__ void sw_rows(const bf16_t* __restrict__ Bt, int N, const float* __restrict__ shift, float* __restrict__ SWo, int wave0, int nwaves) {
    const int lane = tid_opaque() & 63;
    float sh[3][16];
#pragma unroll
    for (int g = 0; g < 3; ++g)
#pragma unroll
        for (int h = 0; h < 2; ++h)
#pragma unroll
            for (int j4 = 0; j4 < 2; ++j4) { const f32x4 t = *(const f32x4*)(shift + g * 6144 + h * 512 + lane * 8 + j4 * 4); sh[g][h * 8 + j4 * 4 + 0] = t[0]; sh[g][h * 8 + j4 * 4 + 1] = t[1]; sh[g][h * 8 + j4 * 4 + 2] = t[2]; sh[g][h * 8 + j4 * 4 + 3] = t[3]; }
    for (int n = wave0; n < N; n += 2 * nwaves) {
        const int n2 = n + nwaves < N ? n + nwaves : n;
        const bf16_t* rp = Bt + (size_t)n * 1024 + lane * 8; const bf16_t* rq = Bt + (size_t)n2 * 1024 + lane * 8;
        const u32x4 a0 = *(const u32x4*)rp, a1 = *(const u32x4*)(rp + 512), b0 = *(const u32x4*)rq, b1 = *(const u32x4*)(rq + 512);
        float w[16], v[16]; unpack8(a0, w); unpack8(a1, w + 8); unpack8(b0, v); unpack8(b1, v + 8);
        float d0 = 0, d1 = 0, d2 = 0, e0 = 0, e1 = 0, e2 = 0;
#pragma unroll
        for (int j = 0; j < 16; ++j) { d0 += sh[0][j] * w[j]; d1 += sh[1][j] * w[j]; d2 += sh[2][j] * w[j]; e0 += sh[0][j] * v[j]; e1 += sh[1][j] * v[j]; e2 += sh[2][j] * v[j]; }
#pragma unroll
        for (int o = 32; o >= 1; o >>= 1) { d0 += __shfl_xor(d0, o); d1 += __shfl_xor(d1, o); d2 += __shfl_xor(d2, o); e0 += __shfl_xor(e0, o); e1 += __shfl_xor(e1, o); e2 += __shfl_xor(e2, o); }
        if (lane == 0) { SWo[n] = d0; SWo[NSW + n] = d1; SWo[2 * NSW + n] = d2; SWo[n2] = e0; SWo[NSW + n2] = e1; SWo[2 * NSW + n2] = e2; }
    }
}
__device__ __forceinline__ void final_norm_phase(const bf16_t* __restrict__ X, const float* __restrict__ SSQ, const float* __restrict__ w, float* __restrict__ out) {
    const int tidq = tid_opaque(); const int lane = tidq & 63, wid = tidq >> 6;
    f32x4 wv[4];
#pragma unroll
    for (int j = 0; j < 4; ++j) wv[j] = *(const f32x4*)(w + j * 256 + lane * 4);
    const int stride = gridDim.x * 8;
    for (int row = blockIdx.x * 8 + wid; row < MT; row += 2 * stride) {
        const int rowb = row + stride < MT ? row + stride : row;
        f32x4 va[4], vb[4];
#pragma unroll
        for (int j = 0; j < 4; ++j) { const u32x2 pa = *(const u32x2*)(X + (size_t)row * DM + j * 256 + lane * 4), pb = *(const u32x2*)(X + (size_t)rowb * DM + j * 256 + lane * 4);
            va[j] = (f32x4){bflo(pa.x), bfhi(pa.x), bflo(pa.y), bfhi(pa.y)}; vb[j] = (f32x4){bflo(pb.x), bfhi(pb.x), bflo(pb.y), bfhi(pb.y)}; }
        float sa = SSQ[(size_t)row * 16 + (lane & 15)], sb = SSQ[(size_t)rowb * 16 + (lane & 15)];
#pragma unroll
        for (int o = 8; o >= 1; o >>= 1) { sa += __shfl_xor(sa, o); sb += __shfl_xor(sb, o); }
        const float ra = 1.0f / sqrtf(sa * (1.0f / 1024.0f) + 1e-6f), rb = 1.0f / sqrtf(sb * (1.0f / 1024.0f) + 1e-6f);
#pragma unroll
        for (int j = 0; j < 4; ++j) { *(f32x4*)(out + (size_t)row * DM + j * 256 + lane * 4) = va[j] * ra * wv[j]; *(f32x4*)(out + (size_t)rowb * DM + j * 256 + lane * 4) = vb[j] * rb * wv[j]; }
    }
}

__device__ __forceinline__ void conv_item_load(const bf16_t* __restrict__ Bb, const bf16_t* __restrict__ Z, long i, u32x4& z0, u32x4& z1, u32x4& z2, u32x4& b) {
    const int row = (int)(i >> 7), c = (int)(i & 127) * 8;
    int t, T; if (row < NP) { t = row & (SEQP - 1); T = SEQP; } else { t = (row - NP) & (SEQS - 1); T = SEQS; }
    const bf16_t* zp = Z + (size_t)row * DM + c;
    const u32x4 zero = {0u, 0u, 0u, 0u};
    z1 = *(const u32x4*)zp; z0 = t > 0 ? *(const u32x4*)(zp - DM) : zero; z2 = t < T - 1 ? *(const u32x4*)(zp + DM) : zero;
    b = *(const u32x4*)(Bb + (size_t)row * DM + c);
}
__device__ __forceinline__ void conv_item_store(const float* __restrict__ cw, bf16_t* __restrict__ A2, long i, const u32x4& z0, const u32x4& z1, const u32x4& z2, const u32x4& b) {
    const int row = (int)(i >> 7), c = (int)(i & 127) * 8;
    float f0[8], f1[8], f2[8], fb[8], o[8];
    unpack8(z0, f0); unpack8(z1, f1); unpack8(z2, f2); unpack8(b, fb);
#pragma unroll
    for (int j = 0; j < 8; ++j) o[j] = fb[j] * (f0[j] * cw[c + j] + f1[j] * cw[1024 + c + j] + f2[j] * cw[2048 + c + j]);
    *(u32x4*)(A2 + (size_t)row * DM + c) = pack8(o);
}
__device__ __forceinline__ void conv_phase(const bf16_t* __restrict__ Bb, const bf16_t* __restrict__ Z, const float* __restrict__ cw, bf16_t* __restrict__ A2) {
    const long total = (long)MT * 128, stride = (long)gridDim.x * NTHREADS;
    for (long i = (long)blockIdx.x * NTHREADS + tid_opaque(); i < total; i += 2 * stride) {
        const long i2 = i + stride < total ? i + stride : i;
        u32x4 a0, a1, a2, ab, c0, c1, c2, cb;
        conv_item_load(Bb, Z, i, a0, a1, a2, ab); conv_item_load(Bb, Z, i2, c0, c1, c2, cb);
        conv_item_store(cw, A2, i, a0, a1, a2, ab); conv_item_store(cw, A2, i2, c0, c1, c2, cb);
    }
}

template <int HW> __device__ __forceinline__ void pool_item(const bf16_t* __restrict__ hp, const float* rl, int t, int T, bf16_t* __restrict__ dp) {
    u32x4 v[2 * HW]; float wgt[2 * HW];
    int cnt = 0;
#pragma unroll
    for (int q = 0; q < 2 * HW; ++q) { const int d = q - HW; const bool ok = (t + d >= 0) && (t + d < T); v[q] = *(const u32x4*)(hp + (long)(ok ? d : 0) * DM); wgt[q] = ok ? rl[d] : 0.f; cnt += ok ? 1 : 0; }
    float s[8], f[8];
#pragma unroll
    for (int j = 0; j < 8; ++j) s[j] = 0.f;
#pragma unroll
    for (int q = 0; q < 2 * HW; ++q) { unpack8(v[q], f);
#pragma unroll
        for (int j = 0; j < 8; ++j) s[j] += f[j] * wgt[q]; }
    unpack8(v[HW], f);
    const float inv = 1.0f / (float)cnt, rt = rl[0];
#pragma unroll
    for (int j = 0; j < 8; ++j) s[j] = s[j] * inv - f[j] * rt;
    *(u32x4*)dp = pack8(s);
}
__device__ __forceinline__ void pool_phase(const bf16_t* __restrict__ XG, const float* __restrict__ SSQ, bf16_t* __restrict__ DIFF, float* lds_f) {
    const int tid = tid_opaque(), wid = tid >> 6, lane = tid & 63, g = wid & 3;
    for (int unit = blockIdx.x; unit < MT / 16; unit += gridDim.x) {
        const int r0 = unit * 16;
        if (tid < 32) { int r = r0 - 8 + tid; r = r < 0 ? 0 : (r > MT - 1 ? MT - 1 : r);
            const f32x4 p0 = *(const f32x4*)(SSQ + (size_t)r * 16), p1 = *(const f32x4*)(SSQ + (size_t)r * 16 + 4), p2 = *(const f32x4*)(SSQ + (size_t)r * 16 + 8), p3 = *(const f32x4*)(SSQ + (size_t)r * 16 + 12);
            const float s = (((p0[0] + p0[1]) + (p0[2] + p0[3])) + ((p1[0] + p1[1]) + (p1[2] + p1[3]))) + (((p2[0] + p2[1]) + (p2[2] + p2[3])) + ((p3[0] + p3[1]) + (p3[2] + p3[3])));
            lds_f[tid] = __builtin_amdgcn_rsqf(s * (1.0f / 1024.0f) + 1e-6f); }
        __syncthreads();
#pragma unroll 1
        for (int pass = 0; pass < 4; ++pass) {
            const int lr = (wid >> 2) * 2 + (lane >> 5) + 4 * pass, row = r0 + lr, c = g * 256 + (lane & 31) * 8;
            int t, T; if (row < NP) { t = row & (SEQP - 1); T = SEQP; } else { t = (row - NP) & (SEQS - 1); T = SEQS; }
            const bf16_t* hp = XG + (size_t)row * DM + c; bf16_t* dp = DIFF + (size_t)row * DM + c; const float* rl = lds_f + lr + 8;
            if (g == 0) pool_item<1>(hp, rl, t, T, dp); else if (g == 1) pool_item<2>(hp, rl, t, T, dp); else if (g == 2) pool_item<4>(hp, rl, t, T, dp); else pool_item<8>(hp, rl, t, T, dp);
        }
        __syncthreads();
    }
}

__device__ __forceinline__ void qkprep_phase(const bf16_t* __restrict__ QKV, const float* __restrict__ qnw, const float* __restrict__ knw, const float* __restrict__ cache_k, const float* __restrict__ cache_v,
                                             bf16_t* __restrict__ Q, bf16_t* __restrict__ KP, bf16_t* __restrict__ VP, bf16_t* __restrict__ KS, bf16_t* __restrict__ VS, float* __restrict__ newk, float* __restrict__ newv) {
    const int tidq = tid_opaque(); const int lane = tidq & 63, wid = tidq >> 6;
    const int half = lane >> 5, i = lane & 31;
    const int d1 = half * 64 + i, d2 = d1 + 32;
    const float qw1 = qnw[d1], qw2 = qnw[d2], kw1 = knw[d1], kw2 = knw[d2];
    const float inv_freq = __builtin_amdgcn_exp2f(-(float)(2 * i) * (13.287712379549449f / 64.0f));
    for (int row = blockIdx.x * 8 + wid; row < MT; row += gridDim.x * 8) {
        const bf16_t* qp = QKV + (size_t)row * NQKV;
        float x1[10], x2[10], vv[2][2];
#pragma unroll
        for (int h = 0; h < 10; ++h) { x1[h] = bf2f(qp[h * 128 + d1]); x2[h] = bf2f(qp[h * 128 + d2]); }
#pragma unroll
        for (int h = 0; h < 2; ++h) { const unsigned t2 = *(const unsigned*)(qp + 1280 + h * 128 + lane * 2); vv[h][0] = bflo(t2); vv[h][1] = bfhi(t2); }
        float cs = 1.f, sn = 0.f; int b, t;
        const bool smp = row >= NP;
        if (smp) { b = (row - NP) >> 12; t = (row - NP) & (SEQS - 1); const float pos = (float)(half == 0 ? (t >> 6) : (t & 63)); const float ang = pos * inv_freq;
            const float nrev = rintf(ang * 0.15915494309189535f); float rr = fmaf(nrev, -6.28318548202514648f, ang); rr = fmaf(nrev, 1.74845553146951715e-07f, rr); sn = __sinf(rr); cs = __cosf(rr); }
        else { b = row >> 8; t = row & (SEQP - 1); }
        float ss[10];
#pragma unroll
        for (int h = 0; h < 10; ++h) ss[h] = x1[h] * x1[h] + x2[h] * x2[h];
#pragma unroll
        for (int o = 32; o >= 1; o >>= 1) {
#pragma unroll
            for (int h = 0; h < 10; ++h) ss[h] += __shfl_xor(ss[h], o); }
#pragma unroll
        for (int h = 0; h < 10; ++h) {
            const float rstd = 1.0f / sqrtf(ss[h] * (1.0f / 128.0f) + 1e-6f);
            const float a1 = x1[h] * rstd * (h < 8 ? qw1 : kw1), a2 = x2[h] * rstd * (h < 8 ? qw2 : kw2);
            if (!smp && h >= 8) { const size_t o = (((size_t)b * 2 + (h - 8)) * SEQP + t) * 128; newk[o + d1] = a1; newk[o + d2] = a2; }
            const float y1 = a1 * cs - a2 * sn, y2 = a2 * cs + a1 * sn;
            const bf16_t o1 = (bf16_t)(cvt_pk_bf16(y1, 0.f) & 0xffffu), o2 = (bf16_t)(cvt_pk_bf16(y2, 0.f) & 0xffffu);
            if (h < 8) { bf16_t* dst = Q + (size_t)row * DM + h * 128; dst[d1] = o1; dst[d2] = o2; }
            else { bf16_t* dst = smp ? KS + (((size_t)b * 2 + (h - 8)) * SKV_S + PAST + t) * 128 : KP + (((size_t)b * 2 + (h - 8)) * SEQP + t) * 128; dst[d1] = o1; dst[d2] = o2; }
        }
#pragma unroll
        for (int h = 0; h < 2; ++h) {
            if (!smp) { const size_t o = (((size_t)b * 2 + h) * SEQP + t) * 128 + lane * 2; *(float2*)(newv + o) = make_float2(vv[h][0], vv[h][1]); }
            bf16_t* dst = smp ? VS + (((size_t)b * 2 + h) * SKV_S + PAST + t) * 128 : VP + (((size_t)b * 2 + h) * SEQP + t) * 128;
            *(unsigned*)(dst + lane * 2) = cvt_pk_bf16(vv[h][0], vv[h][1]);
        }
    }
    const int ncr = 2 * 2 * PAST;
    for (int r = blockIdx.x * 8 + wid; r < 2 * ncr; r += gridDim.x * 8) {
        const bool isv = r >= ncr; const int rr = isv ? r - ncr : r; const int bh = rr >> 8, p = rr & 255;
        const float* src = (isv ? cache_v : cache_k) + ((size_t)bh * PAST + p) * 128 + lane * 2;
        bf16_t* dst = (isv ? VS : KS) + ((size_t)bh * SKV_S + p) * 128 + lane * 2;
        *(unsigned*)dst = cvt_pk_bf16(src[0], src[1]);
    }
}

__device__ __forceinline__ void attn_phase(const bf16_t* Q, const bf16_t* KP, const bf16_t* VP, const bf16_t* KS, const bf16_t* VS, bf16_t* O, char* lds) {
    for (int u = blockIdx.x; u < 384; u += gridDim.x) {
        if (u < 256) { const int b = u >> 7, h = (u >> 4) & 7, qb = u & 15, kvh = h >> 2;
            const size_t row0 = (size_t)NP + (size_t)b * SEQS + qb * 256;
            const size_t ko = ((size_t)b * 2 + kvh) * SKV_S * 128;
            att::attn_dense_body(Q + row0 * DM + h * 128, KS + ko, VS + ko, O + row0 * DM + h * 128, SKV_S, lds);
        } else { const int v = u - 256, b = v >> 3, h = v & 7, kvh = h >> 2;
            const size_t row0 = (size_t)b * SEQP;
            const size_t ko = ((size_t)b * 2 + kvh) * SEQP * 128;
            att::attn_dense_body(Q + row0 * DM + h * 128, KP + ko, VP + ko, O + row0 * DM + h * 128, SEQP, lds);
        }
    }
}

#define XB_TMO      128
#define XB_XCNT(j)  (256  + 64 * (j))
#define XB_XSUB(j)  (1280 + 64 * (j))
#define XB_XGEN(j)  (2304 + 64 * (j))
#define XB_TOP      3328
#define XB_TOPGEN   3392
#define XCD_BAR_WORDS 3456
#define XB_SPIN_CAP (1u << 18)

__device__ __forceinline__ unsigned xb_ld(unsigned* p)              { return __hip_atomic_load(p, __ATOMIC_RELAXED, __HIP_MEMORY_SCOPE_AGENT); }
__device__ __forceinline__ unsigned xb_add(unsigned* p, unsigned v) { return __hip_atomic_fetch_add(p, v, __ATOMIC_RELAXED, __HIP_MEMORY_SCOPE_AGENT); }
__device__ __forceinline__ unsigned xb_xcc_id() { return (unsigned)__builtin_amdgcn_s_getreg((3 << 11) | 20) & 0xFu; }
#define XB_SPIN(cond, bar) do { unsigned _sp = 0; while (cond) { __builtin_amdgcn_s_sleep(1); \
    if ((++_sp & 255u) == 0u) { if (xb_ld(&(bar)[XB_TMO])) break; if (_sp > XB_SPIN_CAP) { atomicAdd(&(bar)[XB_TMO], 1u); break; } } } } while (0)

struct XcdBarrier {
    unsigned* bar; unsigned x;
    volatile LAS unsigned* st;
};

__device__ __forceinline__ XcdBarrier xcd_barrier_post(unsigned* bar, volatile LAS unsigned* st) {
    XcdBarrier b; b.bar = bar; b.x = xb_xcc_id(); b.st = st;
    if (threadIdx.x == 0) (void)xb_add(&bar[XB_XCNT(b.x)], 1u);
    return b;
}
__device__ __forceinline__ void xcd_barrier_complete(unsigned* bar, unsigned x, unsigned& nloc, unsigned& nx) {
    const unsigned G = gridDim.x * gridDim.y * gridDim.z;
    unsigned sum, cnt, mine, sp = 0u;
    for (;;) {
        sum = 0u; cnt = 0u; mine = 0u;
#pragma unroll
        for (unsigned j = 0; j < 16; ++j) { const unsigned c = xb_ld(&bar[XB_XCNT(j)]); sum += c; cnt += (c > 0u) ? 1u : 0u; mine = (j == x) ? c : mine; }
        if (sum == G) break;
        __builtin_amdgcn_s_sleep(1);
        if ((++sp & 255u) == 0u) { if (xb_ld(&bar[XB_TMO])) break; if (sp > XB_SPIN_CAP) { atomicAdd(&bar[XB_TMO], 1u); break; } }
    }
    nloc = mine > 0u ? mine : 1u; nx = cnt > 0u ? cnt : 1u;
}

__device__ __forceinline__ void xcd_barrier(const XcdBarrier& b) {
    asm volatile("s_waitcnt vmcnt(0)" ::: "memory");
    __syncthreads();
    if (threadIdx.x == 0) {
        unsigned* bar = b.bar;
        __builtin_amdgcn_s_waitcnt(0);
        unsigned nloc = b.st[0], nx = b.st[1];
        if (nloc == 0u) { xcd_barrier_complete(bar, b.x, nloc, nx); b.st[0] = nloc; b.st[1] = nx; }
        const unsigned old = xb_add(&bar[XB_XSUB(b.x)], 1u);
        const unsigned gen = old / nloc;
        if (old + 1u == (gen + 1u) * nloc) {
            __builtin_amdgcn_fence(__ATOMIC_RELEASE, "agent");
            asm volatile("s_waitcnt vmcnt(0)" ::: "memory");
            const unsigned og = xb_add(&bar[XB_TOP], 1u);
            const unsigned tg = og / nx;
            if (og + 1u == (tg + 1u) * nx) xb_add(&bar[XB_TOPGEN], 1u);
            else XB_SPIN(xb_ld(&bar[XB_TOPGEN]) == tg, bar);
            __builtin_amdgcn_fence(__ATOMIC_ACQUIRE, "agent");
            xb_add(&bar[XB_XGEN(b.x)], 1u);
            asm volatile("s_waitcnt vmcnt(0)" ::: "memory");
        } else {
            XB_SPIN(xb_ld(&bar[XB_XGEN(b.x)]) == gen, bar);
            __builtin_amdgcn_fence(__ATOMIC_ACQUIRE, "agent");
            asm volatile("s_waitcnt vmcnt(0)" ::: "memory");
        }
    }
    __syncthreads();
}


constexpr int NPH = 2 + 8 * 4 + 1;

typedef const __attribute__((address_space(4))) Params* KPtr;
__device__ __forceinline__ KPtr kargs() { KPtr q = (KPtr)__builtin_amdgcn_kernarg_segment_ptr(); asm volatile("" : "+s"(q)); return q; }
#define WSP(T, off) ((T*)(q->ws + (off)))

__global__ void __launch_bounds__(NTHREADS, 2) fwd_megakernel(Params p) {
    extern __shared__ __attribute__((aligned(16))) unsigned char lds_raw[];
    LAS unsigned char* lds = (LAS unsigned char*)lds_raw;
    cg::grid_group grid = cg::this_grid();
    const int ph_lo = p.ph_lo, ph_hi = p.ph_hi;
    int ph = 0; bool need_sync = false;
    if (ph_lo < 0) grid.sync();
    volatile LAS unsigned* bst = (volatile LAS unsigned*)(lds + 131072 + 2048);
    if (threadIdx.x < 4) bst[threadIdx.x] = 0u;
    __syncthreads();
    XcdBarrier bar; bar.bar = (unsigned*)(p.ws + WS_BAR); bar.x = 0; bar.st = bst;
    if (ph_hi - ph_lo > 1) bar = xcd_barrier_post((unsigned*)(p.ws + WS_BAR), bst);
    if (threadIdx.x == 0) { bst[3] = blockIdx.x; if (ph_hi - ph_lo > 1) bst[2] = xb_add(&((unsigned*)(p.ws + WS_BAR))[3460 + 64 * bar.x], 1u); }
    __syncthreads();
#define PHASE_BEGIN_R(R) if (ph >= ph_lo && ph < ph_hi) { _Pragma("unroll 1") for (int rep_ = 0; rep_ < (R); ++rep_) { if (need_sync) xcd_barrier(bar); need_sync = true; KPtr q = kargs();
#define PHASE_BEGIN PHASE_BEGIN_R(1)
#define PHASE_END } } ++ph;

    PHASE_BEGIN_R(REP_PREP)
    {
        int uoff = 0; float* lf = (float*)lds_raw;
        adaln_units(q->in[4], q->in[5], q->in[8], q->in[9], WSP(float, WS_MOD), lf, uoff, 0, blockIdx.x, gridDim.x);
        cvt_matrix(q->in[10], 1024, 3072, WSP(bf16_t, WS_CIN), 1, uoff, lf, blockIdx.x, gridDim.x);
        cvt_matrix(q->in[12], 1024, 1024, WSP(bf16_t, WS_COUT), 0, uoff, lf, blockIdx.x, gridDim.x);
        cvt_matrix(q->in[19], 1024, 5632, WSP(bf16_t, WS_FIN), 2, uoff, lf, blockIdx.x, gridDim.x);
        cvt_matrix(q->in[20], 2816, 1024, WSP(bf16_t, WS_FOUT), 0, uoff, lf, blockIdx.x, gridDim.x);
    }
    PHASE_END
    PHASE_BEGIN_R(REP_NORM)
    {
        if (threadIdx.x == 0 && ph_hi - ph_lo > 1) {
            unsigned* bw = (unsigned*)(q->ws + WS_BAR); const unsigned per = gridDim.x >> 3; bool ok = (gridDim.x & 7u) == 0u && bar.x < 8u;
            for (unsigned jx = 0; jx < 8; ++jx) ok = ok && (xb_ld(&bw[3460 + 64 * jx]) == per);
            if (ok) bst[3] = bst[2] * 8u + bar.x;
        }
        const float* MOD = WSP(float, WS_MOD); float* SW = WSP(float, WS_SW);
        norm0_phase(q->in[0], q->in[1], q->in[6], MOD + 1 * 1024, WSP(bf16_t, WS_H), WSP(float, WS_SSQ), WSP(bf16_t, WS_X));
        const int w0 = blockIdx.x * 8 + (tid_opaque() >> 6), nw = gridDim.x * 8;
        sw_rows(WSP(bf16_t, WS_CIN), 3072, MOD + 0 * 1024, SW + 0, w0, nw);
        sw_rows(WSP(bf16_t, WS_FIN), 5632, MOD + 3 * 1024, SW + 7680, w0, nw);
    }
    PHASE_END

#pragma unroll 1
    for (int hl = 0; hl < 8; ++hl) {
        const int layer = hl >> 1, part = hl & 1, kind = layer % 3, j = layer / 3;
        if (part == 1) {
            PHASE_BEGIN_R(REP_FIN)
            pg8::Gemm g{WSP(bf16_t, WS_H), WSP(bf16_t, WS_FIN) + (size_t)layer * 5632 * 1024, MT, 5632, 1024, 1024, 0}; pg8::StaticOrder S; S.init(g.M, g.N, gridDim.x, (int)__builtin_amdgcn_readfirstlane(bst[3]), 64 * MF_FIN);
            pg8::gemm_phase<MF_FIN>(lds, g, S, pg8::EpiSwiglu<MF_FIN>{WSP(bf16_t, WS_ACT), WSP(float, WS_SSQ), WSP(float, WS_SW) + 7680 + layer * 5632});
            {
                const int nlast = (MT / (64 * MF_FIN)) * 22 % (int)gridDim.x;
                const int vc = (int)__builtin_amdgcn_readfirstlane(bst[3]);
                if (layer < 3 && nlast > 0 && vc >= nlast) {
                    KPtr q2 = kargs(); int uoff = 0; float* lf = (float*)lds_raw; const int wk = vc - nlast, nwk = gridDim.x - nlast, ln = layer + 1;
                    adaln_units(q2->in[4], q2->in[5], q2->in[8], q2->in[9], (float*)(q2->ws + WS_MOD), lf, uoff, ln, wk, nwk);
                    if (ln == 1) {
#pragma unroll 1
                        for (int gq = 0; gq < 4; ++gq) cvt_matrix(q2->in[13] + (size_t)gq * 65536, 256, 256, (bf16_t*)(q2->ws + WS_POOL) + (size_t)gq * 65536, 0, uoff, lf, wk, nwk);
                    } else if (ln == 2) {
                        cvt_matrix(q2->in[15], 1024, 1536, (bf16_t*)(q2->ws + WS_QKVW), 0, uoff, lf, wk, nwk);
                        cvt_matrix(q2->in[18], 1024, 1024, (bf16_t*)(q2->ws + WS_AOUT), 0, uoff, lf, wk, nwk);
                    } else {
                        cvt_matrix(q2->in[10] + (size_t)1024 * 3072, 1024, 3072, (bf16_t*)(q2->ws + WS_CIN) + (size_t)3072 * 1024, 1, uoff, lf, wk, nwk);
                        cvt_matrix(q2->in[12] + (size_t)1024 * 1024, 1024, 1024, (bf16_t*)(q2->ws + WS_COUT) + (size_t)1024 * 1024, 0, uoff, lf, wk, nwk);
                    }
                    cvt_matrix(q2->in[19] + (size_t)ln * 1024 * 5632, 1024, 5632, (bf16_t*)(q2->ws + WS_FIN) + (size_t)ln * 5632 * 1024, 2, uoff, lf, wk, nwk);
                    cvt_matrix(q2->in[20] + (size_t)ln * 2816 * 1024, 2816, 1024, (bf16_t*)(q2->ws + WS_FOUT) + (size_t)ln * 1024 * 2816, 0, uoff, lf, wk, nwk);
                }
            }
            PHASE_END
        } else if (kind == 0) {
            PHASE_BEGIN_R(REP_CIN)
            pg8::Gemm g{WSP(bf16_t, WS_H), WSP(bf16_t, WS_CIN) + (size_t)j * 3072 * 1024, MT, 3072, 1024, 1024, 0}; pg8::StaticOrder S; S.init(g.M, g.N, gridDim.x, (int)__builtin_amdgcn_readfirstlane(bst[3]), 64 * MF_CIN);
            pg8::gemm_phase<MF_CIN>(lds, g, S, pg8::EpiConvIn<MF_CIN>{WSP(bf16_t, WS_BB), WSP(bf16_t, WS_Z), WSP(float, WS_SSQ), WSP(float, WS_SW) + j * 3072});
            PHASE_END
        } else if (kind == 1) {
            PHASE_BEGIN_R(REP_EW)
            pool_phase(WSP(bf16_t, WS_H), WSP(float, WS_SSQ), WSP(bf16_t, WS_A2), (float*)lds_raw);
            PHASE_END
        } else {
            PHASE_BEGIN
            pg8::Gemm g{WSP(bf16_t, WS_H), WSP(bf16_t, WS_QKVW), MT, NQKV, 1024, 1024, 0}; pg8::StaticOrder S; S.init(g.M, g.N, gridDim.x, (int)__builtin_amdgcn_readfirstlane(bst[3]), 64 * MF_QKV);
            pg8::gemm_phase<MF_QKV>(lds, g, S, pg8::EpiBf16N<MF_QKV>{WSP(bf16_t, WS_QKV), NQKV, WSP(float, WS_SSQ), WSP(float, WS_SW) + 6144});
            PHASE_END
        }
        if (part == 0 && kind == 0) {
            PHASE_BEGIN_R(REP_EW)
            conv_phase(WSP(bf16_t, WS_BB), WSP(bf16_t, WS_Z), q->in[11] + (size_t)j * 3 * 1024, WSP(bf16_t, WS_A2));
            PHASE_END
        } else if (part == 0 && kind == 2) {
            PHASE_BEGIN_R(REP_EW)
            float* new_k = q->out + (size_t)MT * DM; float* new_v = new_k + 16 * 2 * 256 * 128;
            qkprep_phase(WSP(bf16_t, WS_QKV), q->in[16] + j * 128, q->in[17] + j * 128, q->in[2], q->in[3], WSP(bf16_t, WS_Q), WSP(bf16_t, WS_KP), WSP(bf16_t, WS_VP), WSP(bf16_t, WS_KS), WSP(bf16_t, WS_VS), new_k, new_v);
            PHASE_END
        } else { ++ph; }
        if (part == 0 && kind == 2) {
            PHASE_BEGIN_R(REP_ATT)
            attn_phase(WSP(bf16_t, WS_Q), WSP(bf16_t, WS_KP), WSP(bf16_t, WS_VP), WSP(bf16_t, WS_KS), WSP(bf16_t, WS_VS), WSP(bf16_t, WS_A2), (char*)lds_raw);
            PHASE_END
        } else { ++ph; }
        PHASE_BEGIN_R(part ? REP_FOUT : REP_MIXOUT)
        {
            const float* MOD = WSP(float, WS_MOD);
            const float* modl = MOD + (size_t)layer * 3 * 6144;
            pg8::Gemm g; const float* cs = nullptr;
            if (part == 1) g = pg8::Gemm{WSP(bf16_t, WS_ACT), WSP(bf16_t, WS_FOUT) + (size_t)layer * 1024 * 2816, MT, 1024, DFF, DFF, 0};
            else if (kind == 0) g = pg8::Gemm{WSP(bf16_t, WS_A2), WSP(bf16_t, WS_COUT) + (size_t)j * 1024 * 1024, MT, 1024, 1024, 1024, 0};
            else if (kind == 1) { g = pg8::Gemm{WSP(bf16_t, WS_A2), WSP(bf16_t, WS_POOL), MT, 1024, 256, 1024, 256}; cs = q->in[14] + j * 1024; }
            else g = pg8::Gemm{WSP(bf16_t, WS_A2), WSP(bf16_t, WS_AOUT), MT, 1024, 1024, 1024, 0};
            pg8::StaticOrder S; S.init(g.M, g.N, gridDim.x, (int)__builtin_amdgcn_readfirstlane(bst[3]), 64 * MF_RES);
            const float* nw = part == 0 ? q->in[7] + layer * 1024 : q->in[6] + (layer + 1) * 1024;
            const float* nsc = part == 0 ? modl + 4 * 1024 : modl + 3 * 6144 + 1 * 1024;
            bf16_t* xg = hl == 7 ? nullptr : WSP(bf16_t, WS_H);
            bf16_t* xo = rep_ + 1 < (part ? REP_FOUT : REP_MIXOUT) ? WSP(bf16_t, WS_X2) : WSP(bf16_t, WS_X);
            pg8::gemm_phase<MF_RES>(lds, g, S, pg8::EpiResid<MF_RES>{WSP(bf16_t, WS_X), xo, modl + (part ? 5 : 2) * 1024, cs, xg, WSP(float, WS_SSQ), nw, nsc});
            if (part == 1 && layer < 3) {
                const int ln = layer + 1; float* SW = WSP(float, WS_SW); const float* modn = MOD + (size_t)ln * 3 * 6144;
                const int w0 = blockIdx.x * 8 + (tid_opaque() >> 6), nwv = gridDim.x * 8;
                if (ln == 2) sw_rows(WSP(bf16_t, WS_QKVW), 1536, modn, SW + 6144, w0, nwv);
                else if (ln == 3) sw_rows(WSP(bf16_t, WS_CIN) + (size_t)3072 * 1024, 3072, modn, SW + 3072, w0, nwv);
                sw_rows(WSP(bf16_t, WS_FIN) + (size_t)ln * 5632 * 1024, 5632, modn + 3 * 1024, SW + 7680 + ln * 5632, w0, nwv);
            }
        }
        PHASE_END
    }
    PHASE_BEGIN_R(REP_NORM)
    final_norm_phase(WSP(bf16_t, WS_X), WSP(float, WS_SSQ), q->in[21], q->out);
    PHASE_END
#ifdef EXTRA_SYNCS
    if (ph_hi - ph_lo > 1) { for (int i_ = 0; i_ < EXTRA_SYNCS; ++i_) xcd_barrier(bar); }
#endif
#undef PHASE_BEGIN
#undef PHASE_END
}

extern "C" void kernel_launch(void* const* d_in, const int* in_sizes, int n_in, void* d_out, int out_size, void* d_ws, size_t ws_size, hipStream_t stream) {
    static int grid = 0;
    if (grid == 0) {
        if (n_in != 22 || ws_size < WS_END) { fprintf(stderr, "kernel_launch: unexpected n_in %d / ws %zu (need %zu)\n", n_in, ws_size, (size_t)WS_END); grid = -1; return; }
        int dev = 0, cus = 0, per_cu = 0;
        hipGetDevice(&dev);
        hipDeviceGetAttribute(&cus, hipDeviceAttributeMultiprocessorCount, dev);
        if (hipFuncSetAttribute((const void*)fwd_megakernel, hipFuncAttributeMaxDynamicSharedMemorySize, LDS_BYTES) != hipSuccess) { fprintf(stderr, "kernel_launch: hipFuncSetAttribute failed\n"); grid = -1; return; }
        if (hipOccupancyMaxActiveBlocksPerMultiprocessor(&per_cu, (const void*)fwd_megakernel, NTHREADS, LDS_BYTES) != hipSuccess || per_cu < 1) { fprintf(stderr, "kernel_launch: occupancy query gave %d\n", per_cu); per_cu = 1; }
        (void)hipGetLastError();
        grid = cus * per_cu;
        fprintf(stderr, "kernel_launch: grid %d (cus %d x %d)\n", grid, cus, per_cu);
    }
    if (grid < 0) return;
    Params p{};
    for (int i = 0; i < 22; ++i) p.in[i] = (const float*)d_in[i];
    p.out = (float*)d_out; p.ws = (unsigned char*)d_ws;
#if MK_MULTI
    for (int ph = 0; ph < NPH; ++ph) {
        p.ph_lo = ph; p.ph_hi = ph + 1;
        hipLaunchKernelGGL(fwd_megakernel, dim3(grid), dim3(NTHREADS), LDS_BYTES, stream, p);
    }
#else
    p.ph_lo = 0; p.ph_hi = NPH;
    (void)hipMemsetAsync((char*)d_ws + WS_BAR, 0, 16384, stream);
    void* args[] = {&p};
    hipError_t e = hipLaunchCooperativeKernel((const void*)fwd_megakernel, dim3(grid), dim3(NTHREADS), args, LDS_BYTES, stream);
    if (e != hipSuccess) fprintf(stderr, "kernel_launch: cooperative launch failed: %s (grid %d)\n", hipGetErrorString(e), grid);
#endif
}
```

```cpp
#include <hip/hip_runtime.h>
#include <hip/hip_cooperative_groups.h>
#include <cstdio>
#include <cstdint>
namespace cg = cooperative_groups;

#ifndef MK_MULTI
#define MK_MULTI 0
#endif

#ifndef REP_PREP
#define REP_PREP 1
#endif
#ifndef REP_NORM
#define REP_NORM 1
#endif
#ifndef REP_FIN
#define REP_FIN 1
#endif
#ifndef REP_FOUT
#define REP_FOUT 1
#endif
#ifndef REP_CIN
#define REP_CIN 1
#endif
#ifndef REP_ATT
#define REP_ATT 1
#endif
#ifndef REP_EW
#define REP_EW 1
#endif
#ifndef REP_MIXOUT
#define REP_MIXOUT 1
#endif
#ifndef MF_FIN
#define MF_FIN 4
#endif
#ifndef MF_CIN
#define MF_CIN 3
#endif
#ifndef MF_QKV
#define MF_QKV 3
#endif
#ifndef MF_RES
#define MF_RES 3
#endif
#define LAS __attribute__((address_space(3)))
typedef unsigned short bf16_t;
typedef short bf16x8 __attribute__((ext_vector_type(8)));
typedef short s16x4 __attribute__((ext_vector_type(4)));
typedef float f32x4 __attribute__((ext_vector_type(4)));
typedef float f32x16 __attribute__((ext_vector_type(16)));
typedef unsigned u32x4 __attribute__((ext_vector_type(4)));
typedef unsigned u32x2 __attribute__((ext_vector_type(2)));

constexpr int DM = 1024, NP = 4096  , NS = 8192  , MT = NP + NS;
constexpr int SEQP = 256, SEQS = 4096, PAST = 256, SKV_S = PAST + SEQS;
constexpr int DFF = 2816, NMOD = 6, NQKV = 1536;
constexpr int NTHREADS = 512;
constexpr int NSW = 2 * 3072 + 1536 + 4 * 5632;
constexpr int LDS_BYTES = 132 * 1024;

constexpr size_t AL(size_t x) { return (x + 255) / 256 * 256; }
constexpr size_t WS_MOD   = 0;
constexpr size_t WS_CIN   = AL(WS_MOD + 4ull * 3 * 6 * 1024 * 4);
constexpr size_t WS_COUT  = AL(WS_CIN + 2ull * 3072 * 1024 * 2);
constexpr size_t WS_POOL  = AL(WS_COUT + 2ull * 1024 * 1024 * 2);
constexpr size_t WS_QKVW  = AL(WS_POOL + 4ull * 256 * 256 * 2);
constexpr size_t WS_AOUT  = AL(WS_QKVW + 1536ull * 1024 * 2);
constexpr size_t WS_FIN   = AL(WS_AOUT + 1024ull * 1024 * 2);
constexpr size_t WS_FOUT  = AL(WS_FIN + 4ull * 5632 * 1024 * 2);
constexpr size_t WS_X     = AL(WS_FOUT + 4ull * 1024 * 2816 * 2);
constexpr size_t WS_H     = AL(WS_X + (size_t)MT * 1024 * 4);
constexpr size_t WS_A2    = AL(WS_H + (size_t)MT * 1024 * 2);
constexpr size_t WS_BB    = AL(WS_A2 + (size_t)MT * 1024 * 2);
constexpr size_t WS_Z     = AL(WS_BB + (size_t)MT * 1024 * 2);
constexpr size_t WS_ACT   = AL(WS_Z + (size_t)MT * 1024 * 2);
constexpr size_t WS_QKV   = WS_BB;
constexpr size_t WS_Q     = WS_H;
constexpr size_t WS_KP    = AL(WS_ACT + (size_t)MT * 2816 * 2);
constexpr size_t WS_VP    = AL(WS_KP + 16ull * 2 * 256 * 128 * 2);
constexpr size_t WS_KS    = AL(WS_VP + 16ull * 2 * 256 * 128 * 2);
constexpr size_t WS_VS    = AL(WS_KS + 2ull * 2 * SKV_S * 128 * 2);
constexpr size_t WS_SSQ   = AL(WS_VS + 2ull * 2 * SKV_S * 128 * 2);
constexpr size_t WS_SW    = AL(WS_SSQ + (size_t)MT * 16 * 4);
constexpr size_t WS_BAR   = AL(WS_SW + 3ull * 30208 * 4);
constexpr size_t WS_X2    = AL(WS_BAR + 16384);
constexpr size_t WS_END   = AL(WS_X2 + (size_t)MT * 1024 * 4);

struct Params {
    const float* in[22];
    float* out;
    unsigned char* ws;
    int ph_lo, ph_hi;
};

__device__ __forceinline__ unsigned cvt_pk_bf16(float lo, float hi) { unsigned r; asm volatile("v_cvt_pk_bf16_f32 %0, %1, %2" : "=v"(r) : "v"(lo), "v"(hi)); return r; }
__device__ __forceinline__ float bf2f(unsigned short b) { return __uint_as_float(((unsigned)b) << 16); }
__device__ __forceinline__ float bflo(unsigned w) { return __uint_as_float(w << 16); }
__device__ __forceinline__ float bfhi(unsigned w) { return __uint_as_float(w & 0xffff0000u); }
__device__ __forceinline__ float silu_f(float x) { return x * __builtin_amdgcn_rcpf(1.0f + __builtin_amdgcn_exp2f(-1.4426950408889634f * x)); }
__device__ __forceinline__ int tid_opaque() { int t = threadIdx.x; asm volatile("" : "+v"(t)); return t; }
__device__ __forceinline__ float quad_row_sum(float s) {
    { auto r = __builtin_amdgcn_permlane16_swap(__float_as_uint(s), __float_as_uint(s), false, false); s = __uint_as_float(r[0]) + __uint_as_float(r[1]); }
    { auto r = __builtin_amdgcn_permlane32_swap(__float_as_uint(s), __float_as_uint(s), false, false); s = __uint_as_float(r[0]) + __uint_as_float(r[1]); }
    return s;
}
__device__ __forceinline__ float wave_sum(float v) {
#pragma unroll
    for (int o = 32; o >= 1; o >>= 1) v += __shfl_xor(v, o);
    return v;
}

namespace pg8 {
constexpr int BM = 256, BK = 64, HALF = 128, HTB = HALF * BK * 2, STAGE_BYTES = 8 * HTB, NXCD = 8, WGM = 8;
__host__ __device__ __forceinline__ int lds_byte(int r, int c) { const int st = (r >> 4) * 2 + (c >> 5), rr = r & 15, cc = c & 31, ob = rr * 64 + cc * 2; return st * 1024 + (ob ^ (((ob >> 9) & 1) << 5)); }
__host__ __device__ __forceinline__ void stage_rc(int b, int& R, int& C) { const int st = b / 1024, sb = b % 1024, swz = sb ^ (((sb >> 9) & 1) << 5); R = (st >> 1) * 16 + swz / 64; C = (st & 1) * 32 + (swz % 64) / 2; }
__host__ __device__ __forceinline__ int perm32(int rho) { const int n = rho >> 4, i = rho & 15; return 8 * (i >> 2) + 4 * n + (i & 3); }

struct Unit { int pm, pn; };
struct Gemm { const bf16_t* A; const bf16_t* Bt; int M, N, K, lda, a_pn_off; };

struct StaticOrder {
    int nM, nN, nwg, G, c, wgm;
    __device__ void init(int M, int N, int G_, int c_, int tile_rows) { nM = M / tile_rows; nN = N / BM; nwg = nM * nN; G = G_; c = c_; wgm = (nM % 8 == 0) ? nM / 8 : WGM; }
    __device__ bool next(int i, Unit& u) const {
        const long L = (long)i * G + c; if (L >= nwg) return false;
        int wgid = (int)L; { const int q = nwg / NXCD, r = nwg % NXCD, xcd = wgid % NXCD, off = wgid / NXCD; wgid = (xcd < r ? xcd * (q + 1) : r * (q + 1) + (xcd - r) * q) + off; }
        const int nig = wgm * nN, gid = wgid / nig, fm = gid * wgm, gsz = (nM - fm) < wgm ? (nM - fm) : wgm;
        u.pm = fm + ((wgid % nig) % gsz); u.pn = (wgid % nig) / gsz; return true;
    }
};

template <int MF, class Epi>
__device__ __forceinline__ void gemm_phase(LAS unsigned char* lds, const Gemm g, const StaticOrder& S, const Epi& E) {
    const int tid = tid_opaque(), wid = __builtin_amdgcn_readfirstlane(tid >> 6), lane = tid & 63, wr = wid >> 2, wc = wid & 3, fr = lane & 15, fq = lane >> 4;
    const int K = g.K, nt = K / BK, lda = g.lda;
    unsigned voffA[2], voffB[2];
#pragma unroll
    for (int i = 0; i < 2; ++i) { int R, C; stage_rc(tid * 16 + i * 8192, R, C); const int Rb = Epi::PERM ? ((R & ~31) + perm32(R & 31)) : R;
        voffA[i] = (unsigned)(R * lda + C) * 2u; voffB[i] = (unsigned)(Rb * K + C) * 2u; }
    const size_t kstep = (size_t)(BK * 2);
    const size_t hstepA = (size_t)(32 * MF) * lda * 2, hstepB = (size_t)HALF * K * 2;
    const size_t tstepA = 2 * hstepA, tstepB = 2 * hstepB;
    const size_t pnoffA = (size_t)g.a_pn_off * 2;
    const unsigned ldsw = (unsigned)wid * 1024u;
    const int aoff = lds_byte(wr * 16 * MF + fr, fq * 8), boff = lds_byte(wc * 32 + fr, fq * 8);
#define PG8_SA(b, h) (((b) * 2 + (h)) * HTB)
#define PG8_SB(b, h) ((4 + (b) * 2 + (h)) * HTB)
#define PG8_STAGE(bufoff, gbase, voff) do { _Pragma("unroll") for (int _i = 0; _i < 2; ++_i) \
        __builtin_amdgcn_global_load_lds((const unsigned*)((const char*)(gbase) + (voff)[_i]), (LAS unsigned*)(lds + (bufoff) + ldsw + _i * 8192), 16, 0, 0); } while (0)
#define PG8_LDA(dst, b, h) do { _Pragma("unroll") for (int m = 0; m < MF; ++m) _Pragma("unroll") for (int k = 0; k < 2; ++k) dst[m][k] = *(const LAS bf16x8*)(lds + PG8_SA(b, h) + aoff + m * 2048 + k * 1024); } while (0)
#define PG8_LDB(dst, b, h) do { _Pragma("unroll") for (int n = 0; n < 2; ++n) _Pragma("unroll") for (int k = 0; k < 2; ++k) dst[n][k] = *(const LAS bf16x8*)(lds + PG8_SB(b, h) + boff + n * 2048 + k * 1024); } while (0)
#define PG8_MMA(ai, bj, At, Bt) do { __builtin_amdgcn_s_setprio(1); _Pragma("unroll") for (int m = 0; m < MF; ++m) _Pragma("unroll") for (int n = 0; n < 2; ++n) _Pragma("unroll") for (int k = 0; k < 2; ++k) \
        acc[ai][bj][m][n] = __builtin_amdgcn_mfma_f32_16x16x32_bf16(Bt[n][k], At[m][k], acc[ai][bj][m][n], 0, 0, 0); __builtin_amdgcn_s_setprio(0); } while (0)
#define PG8_WAIT_V(n) asm volatile("s_waitcnt vmcnt(" #n ")" ::: "memory")
#define PG8_WAIT_L(n) asm volatile("s_waitcnt lgkmcnt(" #n ")" ::: "memory")
#define PG8_BAR __builtin_amdgcn_s_barrier()
#define PG8_SCHED __builtin_amdgcn_sched_barrier(0)
    Unit cur, nxt; int ui = 0;
    if (!S.next(0, cur)) return;
    f32x4 acc[2][2][MF][2];
#pragma unroll
    for (int a = 0; a < 2; ++a)
#pragma unroll
        for (int b = 0; b < 2; ++b)
#pragma unroll
            for (int m = 0; m < MF; ++m)
#pragma unroll
                for (int n = 0; n < 2; ++n) acc[a][b][m][n] = (f32x4){0.f, 0.f, 0.f, 0.f};
    bf16x8 At[MF][2], B0[2][2], B1[2][2];
    const char* cA = (const char*)g.A + (size_t)cur.pm * tstepA + (size_t)cur.pn * pnoffA; const char* cB = (const char*)g.Bt + (size_t)cur.pn * tstepB;
    PG8_STAGE(PG8_SB(0, 0), cB, voffB); PG8_STAGE(PG8_SA(0, 0), cA, voffA); PG8_STAGE(PG8_SB(0, 1), cB + hstepB, voffB); PG8_STAGE(PG8_SA(0, 1), cA + hstepA, voffA);
    if (wr == 1) PG8_BAR;
    PG8_WAIT_V(4); PG8_BAR;
    PG8_STAGE(PG8_SB(1, 0), cB + kstep, voffB); PG8_STAGE(PG8_SA(1, 0), cA + kstep, voffA); PG8_STAGE(PG8_SB(1, 1), cB + hstepB + kstep, voffB);
    PG8_WAIT_V(6); PG8_BAR;
    for (;;) {
        const bool has_next = S.next(ui + 1, nxt);
        const char* nA = has_next ? (const char*)g.A + (size_t)nxt.pm * tstepA + (size_t)nxt.pn * pnoffA : cA; const char* nB = has_next ? (const char*)g.Bt + (size_t)nxt.pn * tstepB : cB;
        for (int t = 0; t < nt; t += 2) {
            const bool last = (t == nt - 2);
            const char* a1 = cA + (size_t)(t + 1) * kstep;
            const char* a2 = last ? nA : cA + (size_t)(t + 2) * kstep; const char* b2 = last ? nB : cB + (size_t)(t + 2) * kstep;
            const char* a3 = a2 + kstep; const char* b3 = b2 + kstep;
            PG8_LDB(B0, 0, 0); PG8_SCHED; PG8_LDA(At, 0, 0); PG8_STAGE(PG8_SA(1, 1), a1 + hstepA, voffA);
            PG8_WAIT_L(8); PG8_BAR; PG8_WAIT_L(0); PG8_MMA(0, 0, At, B0); PG8_BAR; PG8_SCHED;
            PG8_LDB(B1, 0, 1); PG8_STAGE(PG8_SB(0, 0), b2, voffB);
            PG8_BAR; PG8_WAIT_L(0); PG8_MMA(0, 1, At, B1); PG8_BAR;
            PG8_LDA(At, 0, 1); PG8_STAGE(PG8_SA(0, 0), a2, voffA);
            PG8_BAR; PG8_WAIT_L(0); PG8_MMA(1, 0, At, B0); PG8_BAR; PG8_SCHED;
            PG8_STAGE(PG8_SB(0, 1), b2 + hstepB, voffB);
            PG8_WAIT_V(6); PG8_BAR; PG8_MMA(1, 1, At, B1); PG8_BAR;
            PG8_LDB(B0, 1, 0); PG8_SCHED; PG8_LDA(At, 1, 0); PG8_STAGE(PG8_SA(0, 1), a2 + hstepA, voffA);
            PG8_WAIT_L(8); PG8_BAR; PG8_WAIT_L(0); PG8_MMA(0, 0, At, B0); PG8_BAR; PG8_SCHED;
            PG8_LDB(B1, 1, 1); PG8_STAGE(PG8_SB(1, 0), b3, voffB);
            PG8_BAR; PG8_WAIT_L(0); PG8_MMA(0, 1, At, B1); PG8_BAR;
            PG8_LDA(At, 1, 1); PG8_STAGE(PG8_SA(1, 0), a3, voffA);
            PG8_BAR; PG8_WAIT_L(0); PG8_MMA(1, 0, At, B0); PG8_BAR; PG8_SCHED;
            PG8_STAGE(PG8_SB(1, 1), b3 + hstepB, voffB);
            PG8_WAIT_V(6); PG8_BAR; PG8_MMA(1, 1, At, B1); PG8_BAR;
        }
        E(acc, cur, wr, wc, fr, fq);
        if (!has_next) break;
#pragma unroll
        for (int a = 0; a < 2; ++a)
#pragma unroll
            for (int b = 0; b < 2; ++b)
#pragma unroll
                for (int m = 0; m < MF; ++m)
#pragma unroll
                    for (int n = 0; n < 2; ++n) acc[a][b][m][n] = (f32x4){0.f, 0.f, 0.f, 0.f};
        cur = nxt; cA = nA; cB = nB; ++ui;
    }
    PG8_WAIT_V(0);
    if (wr == 0) PG8_BAR;
    PG8_BAR;
#undef PG8_SA
#undef PG8_SB
#undef PG8_STAGE
#undef PG8_LDA
#undef PG8_LDB
#undef PG8_MMA
#undef PG8_WAIT_V
#undef PG8_WAIT_L
#undef PG8_BAR
#undef PG8_SCHED
}

__device__ __forceinline__ int grp_of_row(int row) { return row < NP ? 0 : (row < NP + SEQS ? 1 : 2); }
__device__ __forceinline__ float row_rstd1(const float* ssq, int row, int fq) {
    const f32x4 p = *(const f32x4*)(ssq + (size_t)row * 16 + fq * 4);
    float s = (p[0] + p[1]) + (p[2] + p[3]);
    s = quad_row_sum(s);
    return __builtin_amdgcn_rsqf(s * (1.0f / 1024.0f) + 1e-6f);
}

template <int MF> __device__ __forceinline__ void rows_rstd(const float* ssq, int row0, int fq, float (&rs)[2][MF]) {
    f32x4 p[2][MF];
#pragma unroll
    for (int ai = 0; ai < 2; ++ai)
#pragma unroll
        for (int m = 0; m < MF; ++m) p[ai][m] = *(const f32x4*)(ssq + (size_t)(row0 + ai * (32 * MF) + m * 16) * 16 + fq * 4);
#pragma unroll
    for (int ai = 0; ai < 2; ++ai)
#pragma unroll
        for (int m = 0; m < MF; ++m) { float t = (p[ai][m][0] + p[ai][m][1]) + (p[ai][m][2] + p[ai][m][3]); t = quad_row_sum(t); rs[ai][m] = __builtin_amdgcn_rsqf(t * (1.0f / 1024.0f) + 1e-6f); }
}
template <int MF> struct EpiBf16N {
    static constexpr bool PERM = true;
    bf16_t* C; int ldc; const float* ssq; const float* sw;
    __device__ __forceinline__ void operator()(const f32x4 (&acc)[2][2][MF][2], const Unit& u, int wr, int wc, int fr, int fq) const {
        const int row0 = u.pm * (64 * MF) + wr * (16 * MF) + fr, col0 = u.pn * BM + wc * 32 + 8 * fq;
        f32x4 sv[2][2]; int curg = -1;
        float rsv[2][MF]; rows_rstd<MF>(ssq, row0, fq, rsv);
#pragma unroll
        for (int ai = 0; ai < 2; ++ai)
#pragma unroll
            for (int m = 0; m < MF; ++m) { const int row = row0 + ai * (32 * MF) + m * 16; bf16_t* rowp = C + (size_t)row * ldc + col0;
                const float rs = rsv[ai][m]; const int grp = grp_of_row(row);
                if (grp != curg) { curg = grp; const float* swp = sw + grp * NSW + col0;
#pragma unroll
                    for (int bj = 0; bj < 2; ++bj) { sv[bj][0] = *(const f32x4*)(swp + bj * HALF); sv[bj][1] = *(const f32x4*)(swp + bj * HALF + 4); } }
#pragma unroll
                for (int bj = 0; bj < 2; ++bj) { const f32x4 v0 = acc[ai][bj][m][0] * rs + sv[bj][0], v1 = acc[ai][bj][m][1] * rs + sv[bj][1];
                    u32x4 w; w.x = cvt_pk_bf16(v0[0], v0[1]); w.y = cvt_pk_bf16(v0[2], v0[3]); w.z = cvt_pk_bf16(v1[0], v1[1]); w.w = cvt_pk_bf16(v1[2], v1[3]);
                    *(u32x4*)(rowp + bj * HALF) = w; } }
    }
};
template <int MF> struct EpiResid {
    static constexpr bool PERM = true;
    const bf16_t* base; bf16_t* out; const float* gate; const float* cscale;
    bf16_t* xg; float* ssq; const float* nw; const float* nscale;
    __device__ __forceinline__ void operator()(const f32x4 (&acc)[2][2][MF][2], const Unit& u, int wr, int wc, int fr, int fq) const {
        const int row0 = u.pm * (64 * MF) + wr * (16 * MF) + fr, col0 = u.pn * BM + wc * 32 + 8 * fq;
        f32x4 gvh[2][2], gnh[2][2]; int curg = -1;
        u32x4 xb[2][MF][2];
#pragma unroll
        for (int ai = 0; ai < 2; ++ai)
#pragma unroll
            for (int m = 0; m < MF; ++m)
#pragma unroll
                for (int bj = 0; bj < 2; ++bj) xb[ai][m][bj] = *(const u32x4*)(base + (size_t)(row0 + ai * (32 * MF) + m * 16) * DM + col0 + bj * HALF);
        asm volatile("" ::: "memory");
#pragma unroll
        for (int ai = 0; ai < 2; ++ai)
#pragma unroll
            for (int m = 0; m < MF; ++m) { const int row = row0 + ai * (32 * MF) + m * 16; const int grp = grp_of_row(row);
                bf16_t* op = out + (size_t)row * DM + col0;
                if (grp != curg) { curg = grp;
                    const float* gp = gate + grp * (NMOD * DM) + col0; const float* np_ = nscale + grp * (NMOD * DM) + col0;
#pragma unroll
                    for (int bj = 0; bj < 2; ++bj)
#pragma unroll
                        for (int n = 0; n < 2; ++n) { gvh[bj][n] = *(const f32x4*)(gp + bj * HALF + n * 4); if (cscale) gvh[bj][n] *= *(const f32x4*)(cscale + col0 + bj * HALF + n * 4);
                            gnh[bj][n] = xg ? *(const f32x4*)(nw + col0 + bj * HALF + n * 4) * (1.0f + *(const f32x4*)(np_ + bj * HALF + n * 4)) : (f32x4){0.f, 0.f, 0.f, 0.f}; } }
                float s = 0.f;
#pragma unroll
                for (int bj = 0; bj < 2; ++bj) { f32x4 h[2], x[2];
                    const u32x4 bw = xb[ai][m][bj];
                    const f32x4 b0 = {bflo(bw.x), bfhi(bw.x), bflo(bw.y), bfhi(bw.y)}, b1 = {bflo(bw.z), bfhi(bw.z), bflo(bw.w), bfhi(bw.w)};
#pragma unroll
                    for (int n = 0; n < 2; ++n) {
                        x[n] = (n == 0 ? b0 : b1) + gvh[bj][n] * acc[ai][bj][m][n];
                        s += (x[n][0] * x[n][0] + x[n][1] * x[n][1]) + (x[n][2] * x[n][2] + x[n][3] * x[n][3]);
                        if (xg) h[n] = x[n] * gnh[bj][n]; }
                    { u32x4 w; w.x = cvt_pk_bf16(x[0][0], x[0][1]); w.y = cvt_pk_bf16(x[0][2], x[0][3]); w.z = cvt_pk_bf16(x[1][0], x[1][1]); w.w = cvt_pk_bf16(x[1][2], x[1][3]);
                      *(u32x4*)(op + bj * HALF) = w; }
                    if (xg) { u32x4 w; w.x = cvt_pk_bf16(h[0][0], h[0][1]); w.y = cvt_pk_bf16(h[0][2], h[0][3]); w.z = cvt_pk_bf16(h[1][0], h[1][1]); w.w = cvt_pk_bf16(h[1][2], h[1][3]);
                        *(u32x4*)(xg + (size_t)row * DM + col0 + bj * HALF) = w; } }
                s = quad_row_sum(s);
                if (fq == 0) ssq[(size_t)row * 16 + u.pn * 4 + wc] = s; }
    }
};
template <int MF> struct EpiConvIn {
    static constexpr bool PERM = true;
    bf16_t* Bb; bf16_t* Z; const float* ssq; const float* sw;
    __device__ __forceinline__ void operator()(const f32x4 (&acc)[2][2][MF][2], const Unit& u, int wr, int wc, int fr, int fq) const {
        const int row0 = u.pm * (64 * MF) + wr * (16 * MF) + fr;
        const int swc = u.pn * BM + wc * 32 + 8 * fq;
        f32x4 sv[2][2]; int curg = -1;
        float rsv[2][MF]; rows_rstd<MF>(ssq, row0, fq, rsv);
        if (u.pn < 4) {
            const int col0 = u.pn * BM + wc * 32 + 8 * fq;
#pragma unroll
            for (int ai = 0; ai < 2; ++ai)
#pragma unroll
                for (int m = 0; m < MF; ++m) { const int row = row0 + ai * (32 * MF) + m * 16; bf16_t* rowp = Bb + (size_t)row * DM + col0;
                    const float rs = rsv[ai][m]; const int grp = grp_of_row(row);
                    if (grp != curg) { curg = grp; const float* swp = sw + grp * NSW + swc;
#pragma unroll
                        for (int bj = 0; bj < 2; ++bj) { sv[bj][0] = *(const f32x4*)(swp + bj * HALF); sv[bj][1] = *(const f32x4*)(swp + bj * HALF + 4); } }
#pragma unroll
                    for (int bj = 0; bj < 2; ++bj) { const f32x4 v0 = acc[ai][bj][m][0] * rs + sv[bj][0], v1 = acc[ai][bj][m][1] * rs + sv[bj][1];
                        u32x4 w; w.x = cvt_pk_bf16(v0[0], v0[1]); w.y = cvt_pk_bf16(v0[2], v0[3]); w.z = cvt_pk_bf16(v1[0], v1[1]); w.w = cvt_pk_bf16(v1[2], v1[3]);
                        *(u32x4*)(rowp + bj * HALF) = w; } }
        } else {
            const int col0 = (u.pn - 4) * HALF + wc * 32 + 8 * fq;
#pragma unroll
            for (int ai = 0; ai < 2; ++ai)
#pragma unroll
                for (int m = 0; m < MF; ++m) { const int row = row0 + ai * (32 * MF) + m * 16; bf16_t* rowp = Z + (size_t)row * DM + col0;
                    const float rs = rsv[ai][m]; const int grp = grp_of_row(row);
                    if (grp != curg) { curg = grp; const float* swp = sw + grp * NSW + swc;
#pragma unroll
                        for (int bj = 0; bj < 2; ++bj) { sv[bj][0] = *(const f32x4*)(swp + bj * HALF); sv[bj][1] = *(const f32x4*)(swp + bj * HALF + 4); } }
                    const f32x4 v0 = (acc[ai][0][m][0] * rs + sv[0][0]) * (acc[ai][1][m][0] * rs + sv[1][0]);
                    const f32x4 v1 = (acc[ai][0][m][1] * rs + sv[0][1]) * (acc[ai][1][m][1] * rs + sv[1][1]);
                    u32x4 w; w.x = cvt_pk_bf16(v0[0], v0[1]); w.y = cvt_pk_bf16(v0[2], v0[3]); w.z = cvt_pk_bf16(v1[0], v1[1]); w.w = cvt_pk_bf16(v1[2], v1[3]);
                    *(u32x4*)rowp = w; }
        }
    }
};
template <int MF> struct EpiSwiglu {
    static constexpr bool PERM = true;
    bf16_t* ACT; const float* ssq; const float* sw;
    __device__ __forceinline__ void operator()(const f32x4 (&acc)[2][2][MF][2], const Unit& u, int wr, int wc, int fr, int fq) const {
        const int row0 = u.pm * (64 * MF) + wr * (16 * MF) + fr, col0 = u.pn * HALF + wc * 32 + 8 * fq;
        const int swc = u.pn * BM + wc * 32 + 8 * fq;
        f32x4 sv[2][2], svn[2]; int curg = -1;
        float rsv[2][MF]; rows_rstd<MF>(ssq, row0, fq, rsv);
#pragma unroll
        for (int ai = 0; ai < 2; ++ai)
#pragma unroll
            for (int m = 0; m < MF; ++m) { const int row = row0 + ai * (32 * MF) + m * 16; bf16_t* rowp = ACT + (size_t)row * DFF + col0;
                const float rs = rsv[ai][m]; const int grp = grp_of_row(row);
                if (grp != curg) { curg = grp; const float* swp = sw + grp * NSW + swc;
#pragma unroll
                    for (int bj = 0; bj < 2; ++bj) { sv[bj][0] = *(const f32x4*)(swp + bj * HALF); sv[bj][1] = *(const f32x4*)(swp + bj * HALF + 4); }
                    svn[0] = sv[0][0] * -1.4426950408889634f; svn[1] = sv[0][1] * -1.4426950408889634f; }
                const f32x4 sg0 = sv[0][0], sg1 = sv[0][1];
                const f32x4 g0 = acc[ai][0][m][0] * rs + sg0, g1 = acc[ai][0][m][1] * rs + sg1;
                const float rsn = rs * -1.4426950408889634f;
                f32x4 e0 = acc[ai][0][m][0] * rsn + svn[0], e1 = acc[ai][0][m][1] * rsn + svn[1];
                const f32x4 u0 = acc[ai][1][m][0] * rs + sv[1][0], u1 = acc[ai][1][m][1] * rs + sv[1][1];
#pragma unroll
                for (int j = 0; j < 4; ++j) { e0[j] = __builtin_amdgcn_exp2f(e0[j]); e1[j] = __builtin_amdgcn_exp2f(e1[j]); }
                e0 = e0 + 1.0f; e1 = e1 + 1.0f;
#pragma unroll
                for (int j = 0; j < 4; ++j) { e0[j] = __builtin_amdgcn_rcpf(e0[j]); e1[j] = __builtin_amdgcn_rcpf(e1[j]); }
                const f32x4 v0 = (g0 * u0) * e0, v1 = (g1 * u1) * e1;
                u32x4 w; w.x = cvt_pk_bf16(v0[0], v0[1]); w.y = cvt_pk_bf16(v0[2], v0[3]); w.z = cvt_pk_bf16(v1[0], v1[1]); w.w = cvt_pk_bf16(v1[2], v1[3]);
                *(u32x4*)rowp = w; }
    }
};
}

namespace att {
constexpr int D = 128, NW = 8, QBLK = 32, KVBLK = 64;
constexpr float SCALE = 0.088388347648318440f;
constexpr float THR = 8.f;
constexpr int LDQ = 1024, LDK = 128, LDO = 1024;
constexpr size_t SHM_V = KVBLK * D * 2, SHM_K = KVBLK * D * 2, SHM_ATTN = 2 * SHM_V + 2 * SHM_K + NW * 64 * 4;
#define KSWZ(row, colB) ((row) * 256 + ((colB) ^ (((row) & 7) << 4)))
#define SBAR() __builtin_amdgcn_sched_barrier(0)
__device__ __forceinline__ int crow(int r, int hi) { return (r & 3) + 8 * (r >> 2) + 4 * hi; }
__device__ __forceinline__ unsigned cvtpk(float lo, float hi) { unsigned r; asm volatile("v_cvt_pk_bf16_f32 %0, %1, %2" : "=v"(r) : "v"(lo), "v"(hi)); return r; }

__device__ __forceinline__ void partialSM(f32x16& p0, f32x16& p1, float& m_reg, float& mn, float& alpha) {
  constexpr float C = SCALE * 1.4426950408889634f;
  float pmax = p0[0];
#pragma unroll
  for (int r = 1; r < 16; ++r) pmax = fmaxf(pmax, p0[r]);
#pragma unroll
  for (int r = 0; r < 16; ++r) pmax = fmaxf(pmax, p1[r]);
  { auto rr = __builtin_amdgcn_permlane32_swap(__float_as_uint(pmax), __float_as_uint(pmax), false, false);
    pmax = fmaxf(__uint_as_float(rr[0]), __uint_as_float(rr[1])); }
  if (__builtin_expect(__all(pmax - m_reg <= THR / SCALE), 1)) { mn = m_reg; alpha = 1.f; }
  else { mn = fmaxf(m_reg, pmax); alpha = __builtin_amdgcn_exp2f((m_reg - mn) * C); m_reg = mn; }
  float mnC = -mn * C;
#pragma unroll
  for (int r = 0; r < 16; ++r) p0[r] = fmaf(p0[r], C, mnC);
#pragma unroll
  for (int r = 0; r < 16; ++r) p1[r] = fmaf(p1[r], C, mnC);
#pragma unroll
  for (int r = 0; r < 16; ++r) p0[r] = __builtin_amdgcn_exp2f(p0[r]);
}
__device__ __forceinline__ void finishSM(f32x16& p0, f32x16& p1, float alpha, float& l_reg, bf16x8& pa0, bf16x8& pa1, bf16x8& pa2, bf16x8& pa3) {
#pragma unroll
  for (int r = 0; r < 16; ++r) p1[r] = __builtin_amdgcn_exp2f(p1[r]);
  float ps = 0;
#pragma unroll
  for (int r = 0; r < 16; ++r) ps += p0[r];
#pragma unroll
  for (int r = 0; r < 16; ++r) ps += p1[r];
  { auto rr = __builtin_amdgcn_permlane32_swap(__float_as_uint(ps), __float_as_uint(ps), false, false);
    ps = __uint_as_float(rr[0]) + __uint_as_float(rr[1]); }
  l_reg = l_reg * alpha + ps;
#define PK4(P, BASE, OUT) do { unsigned a0 = cvtpk(P[BASE + 0], P[BASE + 1]), a1 = cvtpk(P[BASE + 2], P[BASE + 3]);   \
    unsigned b0 = cvtpk(P[BASE + 4], P[BASE + 5]), b1 = cvtpk(P[BASE + 6], P[BASE + 7]);                              \
    auto r0 = __builtin_amdgcn_permlane32_swap(a0, b0, false, false); auto r1 = __builtin_amdgcn_permlane32_swap(a1, b1, false, false); \
    u32x4 w = {r0[0], r1[0], r0[1], r1[1]}; OUT = *reinterpret_cast<bf16x8*>(&w); } while (0)
  PK4(p0, 0, pa0); PK4(p0, 8, pa1); PK4(p1, 0, pa2); PK4(p1, 8, pa3);
#undef PK4
}
__device__ __forceinline__ void qkt(f32x16& p0, f32x16& p1, const bf16_t* Ks, const bf16x8* qr, int r32, int hi) {
  p0 = f32x16{}; p1 = f32x16{};
#pragma unroll
  for (int d0 = 0; d0 < 8; ++d0) { int cb = (d0 * 16 + hi * 8) * 2;
    bf16x8 b0 = *reinterpret_cast<const bf16x8*>((const char*)Ks + KSWZ(r32, cb));
    bf16x8 b1 = *reinterpret_cast<const bf16x8*>((const char*)Ks + KSWZ(32 + r32, cb));
    p0 = __builtin_amdgcn_mfma_f32_32x32x16_bf16(b0, qr[d0], p0, 0, 0, 0);
    p1 = __builtin_amdgcn_mfma_f32_32x32x16_bf16(b1, qr[d0], p1, 0, 0, 0); }
}
__device__ __forceinline__ int v_st(int k, int c) { const int kk = (k & ~0xC) | ((k & 4) << 1) | ((k & 8) >> 1); return ((kk >> 3) * 4 + (c >> 5)) * 512 + ((kk & 7) * 32 + (c & 31)) * 2; }
__device__ __forceinline__ int v_rd_base(int lane) { return ((lane & 3) << 3) | (((lane >> 2) & 3) << 6) | (((lane >> 4) & 1) << 5) | (((lane >> 5) & 1) << 8); }
constexpr int v_rd_off(int d0, int ks, int half) { return d0 * 512 + ks * 4096 + half * 2048; }
template <int OFF> __device__ __forceinline__ s16x4 tr_read(int vb) {
  s16x4 r; asm volatile("ds_read_b64_tr_b16 %0, %1 offset:%2" : "=&v"(r) : "v"(vb), "i"(OFF) : "memory"); return r;
}
template <int D0> __device__ __forceinline__ void pv_one(f32x16& od, int vb, bf16x8 pa0, bf16x8 pa1, bf16x8 pa2, bf16x8 pa3) {
  const s16x4 l0 = tr_read<v_rd_off(D0, 0, 0)>(vb), h0 = tr_read<v_rd_off(D0, 0, 1)>(vb), l1 = tr_read<v_rd_off(D0, 1, 0)>(vb), h1 = tr_read<v_rd_off(D0, 1, 1)>(vb);
  const s16x4 l2 = tr_read<v_rd_off(D0, 2, 0)>(vb), h2 = tr_read<v_rd_off(D0, 2, 1)>(vb), l3 = tr_read<v_rd_off(D0, 3, 0)>(vb), h3 = tr_read<v_rd_off(D0, 3, 1)>(vb);
  asm volatile("s_waitcnt lgkmcnt(0)" ::: "memory"); SBAR();
#define PK(L, H) (bf16x8){L[0], L[1], L[2], L[3], H[0], H[1], H[2], H[3]}
  od = __builtin_amdgcn_mfma_f32_32x32x16_bf16(pa0, PK(l0, h0), od, 0, 0, 0);
  od = __builtin_amdgcn_mfma_f32_32x32x16_bf16(pa1, PK(l1, h1), od, 0, 0, 0);
  od = __builtin_amdgcn_mfma_f32_32x32x16_bf16(pa2, PK(l2, h2), od, 0, 0, 0);
  od = __builtin_amdgcn_mfma_f32_32x32x16_bf16(pa3, PK(l3, h3), od, 0, 0, 0);
#undef PK
}
__device__ __forceinline__ void pv_d0(f32x16* o, int vb, bf16x8 pa0, bf16x8 pa1, bf16x8 pa2, bf16x8 pa3) {
  pv_one<0>(o[0], vb, pa0, pa1, pa2, pa3); pv_one<1>(o[1], vb, pa0, pa1, pa2, pa3); pv_one<2>(o[2], vb, pa0, pa1, pa2, pa3); pv_one<3>(o[3], vb, pa0, pa1, pa2, pa3);
}

__device__ __forceinline__ void attn_dense_body(const bf16_t* __restrict__ Qb, const bf16_t* __restrict__ Kh, const bf16_t* __restrict__ Vh,
                                                bf16_t* __restrict__ Ob, int seq, char* lds) {
  const int tid = tid_opaque(), wid = tid >> 6, lane = tid & 63, r32 = lane & 31, hi = lane >> 5;
  bf16_t* V_lds = (bf16_t*)lds; bf16_t* K_lds = (bf16_t*)(lds + 2 * SHM_V);
  float* ws = (float*)(lds + 2 * SHM_V + 2 * SHM_K) + wid * 64; float* li_l = ws; float* al_l = ws + 32;
  float m_reg = -1e30f, l_reg = 0; f32x16 o[4] = {}; bf16x8 qr[8];
  const bf16_t* Qw = Qb + (long)(wid * QBLK + r32) * LDQ + hi * 8;
#pragma unroll
  for (int d0 = 0; d0 < 8; ++d0) qr[d0] = *reinterpret_cast<const bf16x8*>(Qw + d0 * 16);
  const int sr = tid >> 4, sc = (tid & 15) * 8, vst0 = v_st(sr, sc), vst1 = v_st(32 + sr, sc);
  const int vb0 = (int)(uintptr_t)V_lds + v_rd_base(lane);
  struct { bf16x8 vs0, vs1, ks0, ks1; } sr_[2];
#define SLOAD(i, k0) do { sr_[i].vs0 = *reinterpret_cast<const bf16x8*>(&Vh[(long)((k0) + sr) * LDK + sc]); sr_[i].vs1 = *reinterpret_cast<const bf16x8*>(&Vh[(long)((k0) + 32 + sr) * LDK + sc]); \
    sr_[i].ks0 = *reinterpret_cast<const bf16x8*>(&Kh[(long)((k0) + sr) * LDK + sc]); sr_[i].ks1 = *reinterpret_cast<const bf16x8*>(&Kh[(long)((k0) + 32 + sr) * LDK + sc]); } while (0)
#define SWRITE(b, i) do { *(bf16x8*)((char*)V_lds + (b) * SHM_V + vst0) = sr_[i].vs0;          \
    *(bf16x8*)((char*)V_lds + (b) * SHM_V + vst1) = sr_[i].vs1; int kc = sc * 2;               \
    *(bf16x8*)((char*)K_lds + (b) * SHM_K + KSWZ(sr, kc)) = sr_[i].ks0;                       \
    *(bf16x8*)((char*)K_lds + (b) * SHM_K + KSWZ(32 + sr, kc)) = sr_[i].ks1; } while (0)
#define SWAIT() asm volatile("s_waitcnt vmcnt(4)" ::: "memory")
#define RESC(a) do { if (__any((a) < 1.f)) { if (hi == 0) al_l[r32] = (a); asm volatile("s_waitcnt lgkmcnt(0)" ::: "memory"); \
    _Pragma("unroll") for (int d = 0; d < 4; ++d) _Pragma("unroll") for (int r = 0; r < 16; ++r) o[d][r] *= al_l[crow(r, hi)]; } } while (0)
  f32x16 pA0, pA1, pB0, pB1; float mnA, mnB, alA, alB; bf16x8 pa0, pa1, pa2, pa3; const int NT = seq / KVBLK;
  constexpr int SE = 0, SO = 1;
  SLOAD(SE, 0); asm volatile("s_waitcnt vmcnt(0)" ::: "memory"); SWRITE(0, SE); __syncthreads();
  qkt(pA0, pA1, K_lds, qr, r32, hi); partialSM(pA0, pA1, m_reg, mnA, alA);
  SLOAD(SO, KVBLK); if (2 < NT) SLOAD(SE, 2 * KVBLK);
  SWAIT(); SWRITE(1, SO); __syncthreads();
  for (int j = 1; j + 1 < NT; j += 2) {
    SBAR(); qkt(pB0, pB1, (bf16_t*)((char*)K_lds + SHM_K), qr, r32, hi);
    finishSM(pA0, pA1, alA, l_reg, pa0, pa1, pa2, pa3); SBAR();
    SLOAD(SO, (j + 2) * KVBLK); SBAR();
    pv_d0(o, vb0, pa0, pa1, pa2, pa3); partialSM(pB0, pB1, m_reg, mnB, alB);
    __syncthreads(); SWAIT(); SWRITE(0, SE);
    RESC(alB); __syncthreads();
    SBAR(); qkt(pA0, pA1, K_lds, qr, r32, hi);
    finishSM(pB0, pB1, alB, l_reg, pa0, pa1, pa2, pa3); SBAR();
    if (j + 3 < NT) SLOAD(SE, (j + 3) * KVBLK); SBAR();
    pv_d0(o, vb0 + (int)SHM_V, pa0, pa1, pa2, pa3); partialSM(pA0, pA1, m_reg, mnA, alA);
    __syncthreads(); SWAIT(); SWRITE(1, SO);
    RESC(alA); __syncthreads();
  }
  SBAR(); qkt(pB0, pB1, (bf16_t*)((char*)K_lds + SHM_K), qr, r32, hi);
  finishSM(pA0, pA1, alA, l_reg, pa0, pa1, pa2, pa3); SBAR();
  pv_d0(o, vb0, pa0, pa1, pa2, pa3); partialSM(pB0, pB1, m_reg, mnB, alB);
  __syncthreads(); RESC(alB);
  finishSM(pB0, pB1, alB, l_reg, pa0, pa1, pa2, pa3); SBAR();
  pv_d0(o, vb0 + (int)SHM_V, pa0, pa1, pa2, pa3);
  if (hi == 0) li_l[r32] = l_reg; asm volatile("s_waitcnt lgkmcnt(0)" ::: "memory");
  float rli[16];
#pragma unroll
  for (int r = 0; r < 16; ++r) rli[r] = __builtin_amdgcn_rcpf(li_l[crow(r, hi)]);
  bf16_t* Ow = Ob + (long)(wid * QBLK) * LDO;
#pragma unroll
  for (int r = 0; r < 16; ++r) { int orow = crow(r, hi);
#pragma unroll
    for (int d0 = 0; d0 < 4; ++d0) Ow[(long)orow * LDO + d0 * 32 + r32] = (bf16_t)(cvtpk(o[d0][r] * rli[r], 0.f) & 0xffffu); }
  __syncthreads();
#undef SLOAD
#undef SWRITE
#undef SWAIT
#undef RESC
}
}

__device__ __forceinline__ int src_col(int mode, int nd) {
    if (mode == 1) { if (nd < 1024) return nd; const int q = nd - 1024, j = q >> 8, r = q & 255; return r < 128 ? 1024 + 128 * j + r : 2048 + 128 * j + (r - 128); }
    if (mode == 2) { const int j = nd >> 8, r = nd & 255; return r < 128 ? 128 * j + r : DFF + 128 * j + (r - 128); }
    return nd;
}
struct CvtRegs { f32x4 v[4]; };
__device__ __forceinline__ void cvt_load(const float* __restrict__ W, int ldw, int mode, int nkt, int u, int tid, CvtRegs& rg) {
    const int kt = u % nkt, ntile = u / nkt, r = tid >> 3, c16 = (tid & 7) * 16;
    const float* src = W + (size_t)(kt * 64 + r) * ldw + src_col(mode, ntile * 128) + c16;
#pragma unroll
    for (int i = 0; i < 4; ++i) rg.v[i] = *(const f32x4*)(src + 4 * i);
}
__device__ __forceinline__ void cvt_matrix(const float* __restrict__ W, int K, int N, bf16_t* __restrict__ Bt, int mode, int& uoff, float* tile, int wk, int nwk) {
    const int tid = tid_opaque(), nkt = K / 64, nu = nkt * (N / 128);
    const int first = (wk - (uoff % nwk) + nwk) % nwk;
    uoff += nu;
    if (first >= nu) return;
    CvtRegs cur, nxt; cvt_load(W, N, mode, nkt, first, tid, cur);
    for (int u = first; u < nu; u += nwk) {
        const int r = tid >> 3, c16 = (tid & 7) * 16;
        float* tp = tile + r * 129 + c16;
#pragma unroll
        for (int i = 0; i < 4; ++i) { tp[4 * i + 0] = cur.v[i][0]; tp[4 * i + 1] = cur.v[i][1]; tp[4 * i + 2] = cur.v[i][2]; tp[4 * i + 3] = cur.v[i][3]; }
        __syncthreads();
        if (u + nwk < nu) cvt_load(W, N, mode, nkt, u + nwk, tid, nxt);
        const int kt = u % nkt, ntile = u / nkt, n = tid >> 2, kc = (tid & 3) * 16;
        const float* rp = tile + kc * 129 + n;
        u32x4 w0, w1;
        w0.x = cvt_pk_bf16(rp[0 * 129], rp[1 * 129]); w0.y = cvt_pk_bf16(rp[2 * 129], rp[3 * 129]); w0.z = cvt_pk_bf16(rp[4 * 129], rp[5 * 129]); w0.w = cvt_pk_bf16(rp[6 * 129], rp[7 * 129]);
        w1.x = cvt_pk_bf16(rp[8 * 129], rp[9 * 129]); w1.y = cvt_pk_bf16(rp[10 * 129], rp[11 * 129]); w1.z = cvt_pk_bf16(rp[12 * 129], rp[13 * 129]); w1.w = cvt_pk_bf16(rp[14 * 129], rp[15 * 129]);
        bf16_t* dst = Bt + (size_t)(ntile * 128 + n) * K + kt * 64 + kc;
        *(u32x4*)dst = w0; *(u32x4*)(dst + 8) = w1;
        __syncthreads();
        cur = nxt;
    }
}

__device__ __forceinline__ void adaln_units(const float* c, const float* c_ctx, const float* ada_w, const float* ada_b, float* MOD, float* lds_f, int& uoff, int l0, int wk, int G) {
    const int tid = tid_opaque();
    float* sv = lds_f;
    float* red = lds_f + 3 * 1024;
    for (int i = tid; i < 3 * 1024; i += NTHREADS) { const int g = i >> 10, k = i & 1023; const float v = g == 0 ? c_ctx[k] : c[(g - 1) * 1024 + k]; sv[i] = silu_f(v); }
    __syncthreads();
    const int nu = 192;
    int first = (wk - (uoff % G) + G) % G;
    const int cq = tid & 7, ks = tid >> 3;
    for (int u = first; u < nu; u += G) {
        const int l = l0, cc = u * 32;
        const float* wp = ada_w + (size_t)l * 1024 * 6144 + cc + cq * 4;
        f32x4 a0 = {0, 0, 0, 0}, a1 = a0, a2 = a0;
#pragma unroll 8
        for (int it = 0; it < 16; ++it) { const int k = ks + 64 * it; const f32x4 w = *(const f32x4*)(wp + (size_t)k * 6144);
            a0 += sv[k] * w; a1 += sv[1024 + k] * w; a2 += sv[2048 + k] * w; }
        float* rp = red + ks * 96 + cq * 4;
#pragma unroll
        for (int j = 0; j < 4; ++j) { rp[j] = a0[j]; rp[32 + j] = a1[j]; rp[64 + j] = a2[j]; }
        __syncthreads();
        if (tid < 96) { float s = 0; for (int q = 0; q < 64; ++q) s += red[q * 96 + tid]; const int g = tid >> 5, n = cc + (tid & 31);
            MOD[((size_t)l * 3 + g) * 6144 + n] = s + ada_b[l * 6144 + n]; }
        __syncthreads();
    }
    uoff += nu;
}

__device__ __forceinline__ void unpack8(const u32x4 w, float* f) { f[0] = bflo(w.x); f[1] = bfhi(w.x); f[2] = bflo(w.y); f[3] = bfhi(w.y); f[4] = bflo(w.z); f[5] = bfhi(w.z); f[6] = bflo(w.w); f[7] = bfhi(w.w); }
__device__ __forceinline__ u32x4 pack8(const float* f) { u32x4 w; w.x = cvt_pk_bf16(f[0], f[1]); w.y = cvt_pk_bf16(f[2], f[3]); w.z = cvt_pk_bf16(f[4], f[5]); w.w = cvt_pk_bf16(f[6], f[7]); return w; }
__device__ __forceinline__ void norm0_phase(const float* __restrict__ xp, const float* __restrict__ xs, const float* __restrict__ nw, const float* __restrict__ scale, bf16_t* __restrict__ XG, float* __restrict__ SSQ, bf16_t* __restrict__ XB) {
    const int tidq = tid_opaque(); const int lane = tidq & 63, wid = tidq >> 6;
    f32x4 wv[4];
#pragma unroll
    for (int j = 0; j < 4; ++j) wv[j] = *(const f32x4*)(nw + j * 256 + lane * 4);
    const int stride = gridDim.x * 8;
    for (int row = blockIdx.x * 8 + wid; row < MT; row += 2 * stride) {
        const int rowb = row + stride < MT ? row + stride : row;
        const float* xa = row < NP ? xp + (size_t)row * DM : xs + (size_t)(row - NP) * DM;
        const float* xb = rowb < NP ? xp + (size_t)rowb * DM : xs + (size_t)(rowb - NP) * DM;
        f32x4 va[4], vb[4];
#pragma unroll
        for (int j = 0; j < 4; ++j) { va[j] = *(const f32x4*)(xa + j * 256 + lane * 4); vb[j] = *(const f32x4*)(xb + j * 256 + lane * 4); }
        const float* sca = scale + (row < NP ? 0 : (row < NP + SEQS ? 1 : 2)) * 6144; const float* scb = scale + (rowb < NP ? 0 : (rowb < NP + SEQS ? 1 : 2)) * 6144;
        float sa = 0, sb = 0;
#pragma unroll
        for (int j = 0; j < 4; ++j) {
            sa += (va[j][0] * va[j][0] + va[j][1] * va[j][1]) + (va[j][2] * va[j][2] + va[j][3] * va[j][3]);
            sb += (vb[j][0] * vb[j][0] + vb[j][1] * vb[j][1]) + (vb[j][2] * vb[j][2] + vb[j][3] * vb[j][3]);
            const f32x4 ha = va[j] * wv[j] * (1.0f + *(const f32x4*)(sca + j * 256 + lane * 4)), hb = vb[j] * wv[j] * (1.0f + *(const f32x4*)(scb + j * 256 + lane * 4));
            u32x2 oa, ob; oa.x = cvt_pk_bf16(ha[0], ha[1]); oa.y = cvt_pk_bf16(ha[2], ha[3]); ob.x = cvt_pk_bf16(hb[0], hb[1]); ob.y = cvt_pk_bf16(hb[2], hb[3]);
            *(u32x2*)(XG + (size_t)row * DM + j * 256 + lane * 4) = oa; *(u32x2*)(XG + (size_t)rowb * DM + j * 256 + lane * 4) = ob;
            u32x2 xa, xb; xa.x = cvt_pk_bf16(va[j][0], va[j][1]); xa.y = cvt_pk_bf16(va[j][2], va[j][3]); xb.x = cvt_pk_bf16(vb[j][0], vb[j][1]); xb.y = cvt_pk_bf16(vb[j][2], vb[j][3]);
            *(u32x2*)(XB + (size_t)row * DM + j * 256 + lane * 4) = xa; *(u32x2*)(XB + (size_t)rowb * DM + j * 256 + lane * 4) = xb; }
        sa = wave_sum(sa); sb = wave_sum(sb);
        if (lane < 16) { SSQ[(size_t)row * 16 + lane] = lane == 0 ? sa : 0.f; SSQ[(size_t)rowb * 16 + lane] = lane == 0 ? sb : 0.f; }
    }
}
__device__ __forceinline__ void sw_rows(const bf16_t* __restrict__ Bt, int N, const float* __restrict__ shift, float* __restrict__ SWo, int wave0, int nwaves) {
    const int lane = tid_opaque() & 63;
    float sh[3][16];
#pragma unroll
    for (int g = 0; g < 3; ++g)
#pragma unroll
        for (int h = 0; h < 2; ++h)
#pragma unroll
            for (int j4 = 0; j4 < 2; ++j4) { const f32x4 t = *(const f32x4*)(shift + g * 6144 + h * 512 + lane * 8 + j4 * 4); sh[g][h * 8 + j4 * 4 + 0] = t[0]; sh[g][h * 8 + j4 * 4 + 1] = t[1]; sh[g][h * 8 + j4 * 4 + 2] = t[2]; sh[g][h * 8 + j4 * 4 + 3] = t[3]; }
    for (int n = wave0; n < N; n += 2 * nwaves) {
        const int n2 = n + nwaves < N ? n + nwaves : n;
        const bf16_t* rp = Bt + (size_t)n * 1024 + lane * 8; const bf16_t* rq = Bt + (size_t)n2 * 1024 + lane * 8;
        const u32x4 a0 = *(const u32x4*)rp, a1 = *(const u32x4*)(rp + 512), b0 = *(const u32x4*)rq, b1 = *(const u32x4*)(rq + 512);
        float w[16], v[16]; unpack8(a0, w); unpack8(a1, w + 8); unpack8(b0, v); unpack8(b1, v + 8);
        float d0 = 0, d1 = 0, d2 = 0, e0 = 0, e1 = 0, e2 = 0;
#pragma unroll
        for (int j = 0; j < 16; ++j) { d0 += sh[0][j] * w[j]; d1 += sh[1][j] * w[j]; d2 += sh[2][j] * w[j]; e0 += sh[0][j] * v[j]; e1 += sh[1][j] * v[j]; e2 += sh[2][j] * v[j]; }
#pragma unroll
        for (int o = 32; o >= 1; o >>= 1) { d0 += __shfl_xor(d0, o); d1 += __shfl_xor(d1, o); d2 += __shfl_xor(d2, o); e0 += __shfl_xor(e0, o); e1 += __shfl_xor(e1, o); e2 += __shfl_xor(e2, o); }
        if (lane == 0) { SWo[n] = d0; SWo[NSW + n] = d1; SWo[2 * NSW + n] = d2; SWo[n2] = e0; SWo[NSW + n2] = e1; SWo[2 * NSW + n2] = e2; }
    }
}
__device__ __forceinline__ void final_norm_phase(const bf16_t* __restrict__ X, const float* __restrict__ SSQ, const float* __restrict__ w, float* __restrict__ out) {
    const int tidq = tid_opaque(); const int lane = tidq & 63, wid = tidq >> 6;
    f32x4 wv[4];
#pragma unroll
    for (int j = 0; j < 4; ++j) wv[j] = *(const f32x4*)(w + j * 256 + lane * 4);
    const int stride = gridDim.x * 8;
    for (int row = blockIdx.x * 8 + wid; row < MT; row += 2 * stride) {
        const int rowb = row + stride < MT ? row + stride : row;
        f32x4 va[4], vb[4];
#pragma unroll
        for (int j = 0; j < 4; ++j) { const u32x2 pa = *(const u32x2*)(X + (size_t)row * DM + j * 256 + lane * 4), pb = *(const u32x2*)(X + (size_t)rowb * DM + j * 256 + lane * 4);
            va[j] = (f32x4){bflo(pa.x), bfhi(pa.x), bflo(pa.y), bfhi(pa.y)}; vb[j] = (f32x4){bflo(pb.x), bfhi(pb.x), bflo(pb.y), bfhi(pb.y)}; }
        float sa = SSQ[(size_t)row * 16 + (lane & 15)], sb = SSQ[(size_t)rowb * 16 + (lane & 15)];
#pragma unroll
        for (int o = 8; o >= 1; o >>= 1) { sa += __shfl_xor(sa, o); sb += __shfl_xor(sb, o); }
        const float ra = 1.0f / sqrtf(sa * (1.0f / 1024.0f) + 1e-6f), rb = 1.0f / sqrtf(sb * (1.0f / 1024.0f) + 1e-6f);
#pragma unroll
        for (int j = 0; j < 4; ++j) { *(f32x4*)(out + (size_t)row * DM + j * 256 + lane * 4) = va[j] * ra * wv[j]; *(f32x4*)(out + (size_t)rowb * DM + j * 256 + lane * 4) = vb[j] * rb * wv[j]; }
    }
}

__device__ __forceinline__ void conv_item_load(const bf16_t* __restrict__ Bb, const bf16_t* __restrict__ Z, long i, u32x4& z0, u32x4& z1, u32x4& z2, u32x4& b) {
    const int row = (int)(i >> 7), c = (int)(i & 127) * 8;
    int t, T; if (row < NP) { t = row & (SEQP - 1); T = SEQP; } else { t = (row - NP) & (SEQS - 1); T = SEQS; }
    const bf16_t* zp = Z + (size_t)row * DM + c;
    const u32x4 zero = {0u, 0u, 0u, 0u};
    z1 = *(const u32x4*)zp; z0 = t > 0 ? *(const u32x4*)(zp - DM) : zero; z2 = t < T - 1 ? *(const u32x4*)(zp + DM) : zero;
    b = *(const u32x4*)(Bb + (size_t)row * DM + c);
}
__device__ __forceinline__ void conv_item_store(const float* __restrict__ cw, bf16_t* __restrict__ A2, long i, const u32x4& z0, const u32x4& z1, const u32x4& z2, const u32x4& b) {
    const int row = (int)(i >> 7), c = (int)(i & 127) * 8;
    float f0[8], f1[8], f2[8], fb[8], o[8];
    unpack8(z0, f0); unpack8(z1, f1); unpack8(z2, f2); unpack8(b, fb);
#pragma unroll
    for (int j = 0; j < 8; ++j) o[j] = fb[j] * (f0[j] * cw[c + j] + f1[j] * cw[1024 + c + j] + f2[j] * cw[2048 + c + j]);
    *(u32x4*)(A2 + (size_t)row * DM + c) = pack8(o);
}
__device__ __forceinline__ void conv_phase(const bf16_t* __restrict__ Bb, const bf16_t* __restrict__ Z, const float* __restrict__ cw, bf16_t* __restrict__ A2) {
    const long total = (long)MT * 128, stride = (long)gridDim.x * NTHREADS;
    for (long i = (long)blockIdx.x * NTHREADS + tid_opaque(); i < total; i += 2 * stride) {
        const long i2 = i + stride < total ? i + stride : i;
        u32x4 a0, a1, a2, ab, c0, c1, c2, cb;
        conv_item_load(Bb, Z, i, a0, a1, a2, ab); conv_item_load(Bb, Z, i2, c0, c1, c2, cb);
        conv_item_store(cw, A2, i, a0, a1, a2, ab); conv_item_store(cw, A2, i2, c0, c1, c2, cb);
    }
}

template <int HW> __device__ __forceinline__ void pool_item(const bf16_t* __restrict__ hp, const float* rl, int t, int T, bf16_t* __restrict__ dp) {
    u32x4 v[2 * HW]; float wgt[2 * HW];
    int cnt = 0;
#pragma unroll
    for (int q = 0; q < 2 * HW; ++q) { const int d = q - HW; const bool ok = (t + d >= 0) && (t + d < T); v[q] = *(const u32x4*)(hp + (long)(ok ? d : 0) * DM); wgt[q] = ok ? rl[d] : 0.f; cnt += ok ? 1 : 0; }
    float s[8], f[8];
#pragma unroll
    for (int j = 0; j < 8; ++j) s[j] = 0.f;
#pragma unroll
    for (int q = 0; q < 2 * HW; ++q) { unpack8(v[q], f);
#pragma unroll
        for (int j = 0; j < 8; ++j) s[j] += f[j] * wgt[q]; }
    unpack8(v[HW], f);
    const float inv = 1.0f / (float)cnt, rt = rl[0];
#pragma unroll
    for (int j = 0; j < 8; ++j) s[j] = s[j] * inv - f[j] * rt;
    *(u32x4*)dp = pack8(s);
}
__device__ __forceinline__ void pool_phase(const bf16_t* __restrict__ XG, const float* __restrict__ SSQ, bf16_t* __restrict__ DIFF, float* lds_f) {
    const int tid = tid_opaque(), wid = tid >> 6, lane = tid & 63, g = wid & 3;
    for (int unit = blockIdx.x; unit < MT / 16; unit += gridDim.x) {
        const int r0 = unit * 16;
        if (tid < 32) { int r = r0 - 8 + tid; r = r < 0 ? 0 : (r > MT - 1 ? MT - 1 : r);
            const f32x4 p0 = *(const f32x4*)(SSQ + (size_t)r * 16), p1 = *(const f32x4*)(SSQ + (size_t)r * 16 + 4), p2 = *(const f32x4*)(SSQ + (size_t)r * 16 + 8), p3 = *(const f32x4*)(SSQ + (size_t)r * 16 + 12);
            const float s = (((p0[0] + p0[1]) + (p0[2] + p0[3])) + ((p1[0] + p1[1]) + (p1[2] + p1[3]))) + (((p2[0] + p2[1]) + (p2[2] + p2[3])) + ((p3[0] + p3[1]) + (p3[2] + p3[3])));
            lds_f[tid] = __builtin_amdgcn_rsqf(s * (1.0f / 1024.0f) + 1e-6f); }
        __syncthreads();
#pragma unroll 1
        for (int pass = 0; pass < 4; ++pass) {
            const int lr = (wid >> 2) * 2 + (lane >> 5) + 4 * pass, row = r0 + lr, c = g * 256 + (lane & 31) * 8;
            int t, T; if (row < NP) { t = row & (SEQP - 1); T = SEQP; } else { t = (row - NP) & (SEQS - 1); T = SEQS; }
            const bf16_t* hp = XG + (size_t)row * DM + c; bf16_t* dp = DIFF + (size_t)row * DM + c; const float* rl = lds_f + lr + 8;
            if (g == 0) pool_item<1>(hp, rl, t, T, dp); else if (g == 1) pool_item<2>(hp, rl, t, T, dp); else if (g == 2) pool_item<4>(hp, rl, t, T, dp); else pool_item<8>(hp, rl, t, T, dp);
        }
        __syncthreads();
    }
}

__device__ __forceinline__ void qkprep_phase(const bf16_t* __restrict__ QKV, const float* __restrict__ qnw, const float* __restrict__ knw, const float* __restrict__ cache_k, const float* __restrict__ cache_v,
                                             bf16_t* __restrict__ Q, bf16_t* __restrict__ KP, bf16_t* __restrict__ VP, bf16_t* __restrict__ KS, bf16_t* __restrict__ VS, float* __restrict__ newk, float* __restrict__ newv) {
    const int tidq = tid_opaque(); const int lane = tidq & 63, wid = tidq >> 6;
    const int half = lane >> 5, i = lane & 31;
    const int d1 = half * 64 + i, d2 = d1 + 32;
    const float qw1 = qnw[d1], qw2 = qnw[d2], kw1 = knw[d1], kw2 = knw[d2];
    const float inv_freq = __builtin_amdgcn_exp2f(-(float)(2 * i) * (13.287712379549449f / 64.0f));
    for (int row = blockIdx.x * 8 + wid; row < MT; row += gridDim.x * 8) {
        const bf16_t* qp = QKV + (size_t)row * NQKV;
        float x1[10], x2[10], vv[2][2];
#pragma unroll
        for (int h = 0; h < 10; ++h) { x1[h] = bf2f(qp[h * 128 + d1]); x2[h] = bf2f(qp[h * 128 + d2]); }
#pragma unroll
        for (int h = 0; h < 2; ++h) { const unsigned t2 = *(const unsigned*)(qp + 1280 + h * 128 + lane * 2); vv[h][0] = bflo(t2); vv[h][1] = bfhi(t2); }
        float cs = 1.f, sn = 0.f; int b, t;
        const bool smp = row >= NP;
        if (smp) { b = (row - NP) >> 12; t = (row - NP) & (SEQS - 1); const float pos = (float)(half == 0 ? (t >> 6) : (t & 63)); const float ang = pos * inv_freq;
            const float nrev = rintf(ang * 0.15915494309189535f); float rr = fmaf(nrev, -6.28318548202514648f, ang); rr = fmaf(nrev, 1.74845553146951715e-07f, rr); sn = __sinf(rr); cs = __cosf(rr); }
        else { b = row >> 8; t = row & (SEQP - 1); }
        float ss[10];
#pragma unroll
        for (int h = 0; h < 10; ++h) ss[h] = x1[h] * x1[h] + x2[h] * x2[h];
#pragma unroll
        for (int o = 32; o >= 1; o >>= 1) {
#pragma unroll
            for (int h = 0; h < 10; ++h) ss[h] += __shfl_xor(ss[h], o); }
#pragma unroll
        for (int h = 0; h < 10; ++h) {
            const float rstd = 1.0f / sqrtf(ss[h] * (1.0f / 128.0f) + 1e-6f);
            const float a1 = x1[h] * rstd * (h < 8 ? qw1 : kw1), a2 = x2[h] * rstd * (h < 8 ? qw2 : kw2);
            if (!smp && h >= 8) { const size_t o = (((size_t)b * 2 + (h - 8)) * SEQP + t) * 128; newk[o + d1] = a1; newk[o + d2] = a2; }
            const float y1 = a1 * cs - a2 * sn, y2 = a2 * cs + a1 * sn;
            const bf16_t o1 = (bf16_t)(cvt_pk_bf16(y1, 0.f) & 0xffffu), o2 = (bf16_t)(cvt_pk_bf16(y2, 0.f) & 0xffffu);
            if (h < 8) { bf16_t* dst = Q + (size_t)row * DM + h * 128; dst[d1] = o1; dst[d2] = o2; }
            else { bf16_t* dst = smp ? KS + (((size_t)b * 2 + (h - 8)) * SKV_S + PAST + t) * 128 : KP + (((size_t)b * 2 + (h - 8)) * SEQP + t) * 128; dst[d1] = o1; dst[d2] = o2; }
        }
#pragma unroll
        for (int h = 0; h < 2; ++h) {
            if (!smp) { const size_t o = (((size_t)b * 2 + h) * SEQP + t) * 128 + lane * 2; *(float2*)(newv + o) = make_float2(vv[h][0], vv[h][1]); }
            bf16_t* dst = smp ? VS + (((size_t)b * 2 + h) * SKV_S + PAST + t) * 128 : VP + (((size_t)b * 2 + h) * SEQP + t) * 128;
            *(unsigned*)(dst + lane * 2) = cvt_pk_bf16(vv[h][0], vv[h][1]);
        }
    }
    const int ncr = 2 * 2 * PAST;
    for (int r = blockIdx.x * 8 + wid; r < 2 * ncr; r += gridDim.x * 8) {
        const bool isv = r >= ncr; const int rr = isv ? r - ncr : r; const int bh = rr >> 8, p = rr & 255;
        const float* src = (isv ? cache_v : cache_k) + ((size_t)bh * PAST + p) * 128 + lane * 2;
        bf16_t* dst = (isv ? VS : KS) + ((size_t)bh * SKV_S + p) * 128 + lane * 2;
        *(unsigned*)dst = cvt_pk_bf16(src[0], src[1]);
    }
}

__device__ __forceinline__ void attn_phase(const bf16_t* Q, const bf16_t* KP, const bf16_t* VP, const bf16_t* KS, const bf16_t* VS, bf16_t* O, char* lds) {
    for (int u = blockIdx.x; u < 384; u += gridDim.x) {
        if (u < 256) { const int b = u >> 7, h = (u >> 4) & 7, qb = u & 15, kvh = h >> 2;
            const size_t row0 = (size_t)NP + (size_t)b * SEQS + qb * 256;
            const size_t ko = ((size_t)b * 2 + kvh) * SKV_S * 128;
            att::attn_dense_body(Q + row0 * DM + h * 128, KS + ko, VS + ko, O + row0 * DM + h * 128, SKV_S, lds);
        } else { const int v = u - 256, b = v >> 3, h = v & 7, kvh = h >> 2;
            const size_t row0 = (size_t)b * SEQP;
            const size_t ko = ((size_t)b * 2 + kvh) * SEQP * 128;
            att::attn_dense_body(Q + row0 * DM + h * 128, KP + ko, VP + ko, O + row0 * DM + h * 128, SEQP, lds);
        }
    }
}

#define XB_TMO      128
#define XB_XCNT(j)  (256  + 64 * (j))
#define XB_XSUB(j)  (1280 + 64 * (j))
#define XB_XGEN(j)  (2304 + 64 * (j))
#define XB_TOP      3328
#define XB_TOPGEN   3392
#define XCD_BAR_WORDS 3456
#define XB_SPIN_CAP (1u << 18)

__device__ __forceinline__ unsigned xb_ld(unsigned* p)              { return __hip_atomic_load(p, __ATOMIC_RELAXED, __HIP_MEMORY_SCOPE_AGENT); }
__device__ __forceinline__ unsigned xb_add(unsigned* p, unsigned v) { return __hip_atomic_fetch_add(p, v, __ATOMIC_RELAXED, __HIP_MEMORY_SCOPE_AGENT); }
__device__ __forceinline__ unsigned xb_xcc_id() { return (unsigned)__builtin_amdgcn_s_getreg((3 << 11) | 20) & 0xFu; }
#define XB_SPIN(cond, bar) do { unsigned _sp = 0; while (cond) { __builtin_amdgcn_s_sleep(1); \
    if ((++_sp & 255u) == 0u) { if (xb_ld(&(bar)[XB_TMO])) break; if (_sp > XB_SPIN_CAP) { atomicAdd(&(bar)[XB_TMO], 1u); break; } } } } while (0)

struct XcdBarrier {
    unsigned* bar; unsigned x;
    volatile LAS unsigned* st;
};

__device__ __forceinline__ XcdBarrier xcd_barrier_post(unsigned* bar, volatile LAS unsigned* st) {
    XcdBarrier b; b.bar = bar; b.x = xb_xcc_id(); b.st = st;
    if (threadIdx.x == 0) (void)xb_add(&bar[XB_XCNT(b.x)], 1u);
    return b;
}
__device__ __forceinline__ void xcd_barrier_complete(unsigned* bar, unsigned x, unsigned& nloc, unsigned& nx) {
    const unsigned G = gridDim.x * gridDim.y * gridDim.z;
    unsigned sum, cnt, mine, sp = 0u;
    for (;;) {
        sum = 0u; cnt = 0u; mine = 0u;
#pragma unroll
        for (unsigned j = 0; j < 16; ++j) { const unsigned c = xb_ld(&bar[XB_XCNT(j)]); sum += c; cnt += (c > 0u) ? 1u : 0u; mine = (j == x) ? c : mine; }
        if (sum == G) break;
        __builtin_amdgcn_s_sleep(1);
        if ((++sp & 255u) == 0u) { if (xb_ld(&bar[XB_TMO])) break; if (sp > XB_SPIN_CAP) { atomicAdd(&bar[XB_TMO], 1u); break; } }
    }
    nloc = mine > 0u ? mine : 1u; nx = cnt > 0u ? cnt : 1u;
}

__device__ __forceinline__ void xcd_barrier(const XcdBarrier& b) {
    asm volatile("s_waitcnt vmcnt(0)" ::: "memory");
    __syncthreads();
    if (threadIdx.x == 0) {
        unsigned* bar = b.bar;
        __builtin_amdgcn_s_waitcnt(0);
        unsigned nloc = b.st[0], nx = b.st[1];
        if (nloc == 0u) { xcd_barrier_complete(bar, b.x, nloc, nx); b.st[0] = nloc; b.st[1] = nx; }
        const unsigned old = xb_add(&bar[XB_XSUB(b.x)], 1u);
        const unsigned gen = old / nloc;
        if (old + 1u == (gen + 1u) * nloc) {
            __builtin_amdgcn_fence(__ATOMIC_RELEASE, "agent");
            asm volatile("s_waitcnt vmcnt(0)" ::: "memory");
            const unsigned og = xb_add(&bar[XB_TOP], 1u);
            const unsigned tg = og / nx;
            if (og + 1u == (tg + 1u) * nx) xb_add(&bar[XB_TOPGEN], 1u);
            else XB_SPIN(xb_ld(&bar[XB_TOPGEN]) == tg, bar);
            __builtin_amdgcn_fence(__ATOMIC_ACQUIRE, "agent");
            xb_add(&bar[XB_XGEN(b.x)], 1u);
            asm volatile("s_waitcnt vmcnt(0)" ::: "memory");
        } else {
            XB_SPIN(xb_ld(&bar[XB_XGEN(b.x)]) == gen, bar);
            __builtin_amdgcn_fence(__ATOMIC_ACQUIRE, "agent");
            asm volatile("s_waitcnt vmcnt(0)" ::: "memory");
        }
    }
    __syncthreads();
}


constexpr int NPH = 2 + 8 * 4 + 1;

typedef const __attribute__((address_space(4))) Params* KPtr;
__device__ __forceinline__ KPtr kargs() { KPtr q = (KPtr)__builtin_amdgcn_kernarg_segment_ptr(); asm volatile("" : "+s"(q)); return q; }
#define WSP(T, off) ((T*)(q->ws + (off)))

__global__ void __launch_bounds__(NTHREADS, 2) fwd_megakernel(Params p) {
    extern __shared__ __attribute__((aligned(16))) unsigned char lds_raw[];
    LAS unsigned char* lds = (LAS unsigned char*)lds_raw;
    cg::grid_group grid = cg::this_grid();
    const int ph_lo = p.ph_lo, ph_hi = p.ph_hi;
    int ph = 0; bool need_sync = false;
    if (ph_lo < 0) grid.sync();
    volatile LAS unsigned* bst = (volatile LAS unsigned*)(lds + 131072 + 2048);
    if (threadIdx.x < 4) bst[threadIdx.x] = 0u;
    __syncthreads();
    XcdBarrier bar; bar.bar = (unsigned*)(p.ws + WS_BAR); bar.x = 0; bar.st = bst;
    if (ph_hi - ph_lo > 1) bar = xcd_barrier_post((unsigned*)(p.ws + WS_BAR), bst);
    if (threadIdx.x == 0) { bst[3] = blockIdx.x; if (ph_hi - ph_lo > 1) bst[2] = xb_add(&((unsigned*)(p.ws + WS_BAR))[3460 + 64 * bar.x], 1u); }
    __syncthreads();
#define PHASE_BEGIN_R(R) if (ph >= ph_lo && ph < ph_hi) { _Pragma("unroll 1") for (int rep_ = 0; rep_ < (R); ++rep_) { if (need_sync) xcd_barrier(bar); need_sync = true; KPtr q = kargs();
#define PHASE_BEGIN PHASE_BEGIN_R(1)
#define PHASE_END } } ++ph;

    PHASE_BEGIN_R(REP_PREP)
    {
        int uoff = 0; float* lf = (float*)lds_raw;
        adaln_units(q->in[4], q->in[5], q->in[8], q->in[9], WSP(float, WS_MOD), lf, uoff, 0, blockIdx.x, gridDim.x);
        cvt_matrix(q->in[10], 1024, 3072, WSP(bf16_t, WS_CIN), 1, uoff, lf, blockIdx.x, gridDim.x);
        cvt_matrix(q->in[12], 1024, 1024, WSP(bf16_t, WS_COUT), 0, uoff, lf, blockIdx.x, gridDim.x);
        cvt_matrix(q->in[19], 1024, 5632, WSP(bf16_t, WS_FIN), 2, uoff, lf, blockIdx.x, gridDim.x);
        cvt_matrix(q->in[20], 2816, 1024, WSP(bf16_t, WS_FOUT), 0, uoff, lf, blockIdx.x, gridDim.x);
    }
    PHASE_END
    PHASE_BEGIN_R(REP_NORM)
    {
        if (threadIdx.x == 0 && ph_hi - ph_lo > 1) {
            unsigned* bw = (unsigned*)(q->ws + WS_BAR); const unsigned per = gridDim.x >> 3; bool ok = (gridDim.x & 7u) == 0u && bar.x < 8u;
            for (unsigned jx = 0; jx < 8; ++jx) ok = ok && (xb_ld(&bw[3460 + 64 * jx]) == per);
            if (ok) bst[3] = bst[2] * 8u + bar.x;
        }
        const float* MOD = WSP(float, WS_MOD); float* SW = WSP(float, WS_SW);
        norm0_phase(q->in[0], q->in[1], q->in[6], MOD + 1 * 1024, WSP(bf16_t, WS_H), WSP(float, WS_SSQ), WSP(bf16_t, WS_X));
        const int w0 = blockIdx.x * 8 + (tid_opaque() >> 6), nw = gridDim.x * 8;
        sw_rows(WSP(bf16_t, WS_CIN), 3072, MOD + 0 * 1024, SW + 0, w0, nw);
        sw_rows(WSP(bf16_t, WS_FIN), 5632, MOD + 3 * 1024, SW + 7680, w0, nw);
    }
    PHASE_END

#pragma unroll 1
    for (int hl = 0; hl < 8; ++hl) {
        const int layer = hl >> 1, part = hl & 1, kind = layer % 3, j = layer / 3;
        if (part == 1) {
            PHASE_BEGIN_R(REP_FIN)
            pg8::Gemm g{WSP(bf16_t, WS_H), WSP(bf16_t, WS_FIN) + (size_t)layer * 5632 * 1024, MT, 5632, 1024, 1024, 0}; pg8::StaticOrder S; S.init(g.M, g.N, gridDim.x, (int)__builtin_amdgcn_readfirstlane(bst[3]), 64 * MF_FIN);
            pg8::gemm_phase<MF_FIN>(lds, g, S, pg8::EpiSwiglu<MF_FIN>{WSP(bf16_t, WS_ACT), WSP(float, WS_SSQ), WSP(float, WS_SW) + 7680 + layer * 5632});
            {
                const int nlast = (MT / (64 * MF_FIN)) * 22 % (int)gridDim.x;
                const int vc = (int)__builtin_amdgcn_readfirstlane(bst[3]);
                if (layer < 3 && nlast > 0 && vc >= nlast) {
                    KPtr q2 = kargs(); int uoff = 0; float* lf = (float*)lds_raw; const int wk = vc - nlast, nwk = gridDim.x - nlast, ln = layer + 1;
                    adaln_units(q2->in[4], q2->in[5], q2->in[8], q2->in[9], (float*)(q2->ws + WS_MOD), lf, uoff, ln, wk, nwk);
                    if (ln == 1) {
#pragma unroll 1
                        for (int gq = 0; gq < 4; ++gq) cvt_matrix(q2->in[13] + (size_t)gq * 65536, 256, 256, (bf16_t*)(q2->ws + WS_POOL) + (size_t)gq * 65536, 0, uoff, lf, wk, nwk);
                    } else if (ln == 2) {
                        cvt_matrix(q2->in[15], 1024, 1536, (bf16_t*)(q2->ws + WS_QKVW), 0, uoff, lf, wk, nwk);
                        cvt_matrix(q2->in[18], 1024, 1024, (bf16_t*)(q2->ws + WS_AOUT), 0, uoff, lf, wk, nwk);
                    } else {
                        cvt_matrix(q2->in[10] + (size_t)1024 * 3072, 1024, 3072, (bf16_t*)(q2->ws + WS_CIN) + (size_t)3072 * 1024, 1, uoff, lf, wk, nwk);
                        cvt_matrix(q2->in[12] + (size_t)1024 * 1024, 1024, 1024, (bf16_t*)(q2->ws + WS_COUT) + (size_t)1024 * 1024, 0, uoff, lf, wk, nwk);
                    }
                    cvt_matrix(q2->in[19] + (size_t)ln * 1024 * 5632, 1024, 5632, (bf16_t*)(q2->ws + WS_FIN) + (size_t)ln * 5632 * 1024, 2, uoff, lf, wk, nwk);
                    cvt_matrix(q2->in[20] + (size_t)ln * 2816 * 1024, 2816, 1024, (bf16_t*)(q2->ws + WS_FOUT) + (size_t)ln * 1024 * 2816, 0, uoff, lf, wk, nwk);
                }
            }
            PHASE_END
        } else if (kind == 0) {
            PHASE_BEGIN_R(REP_CIN)
            pg8::Gemm g{WSP(bf16_t, WS_H), WSP(bf16_t, WS_CIN) + (size_t)j * 3072 * 1024, MT, 3072, 1024, 1024, 0}; pg8::StaticOrder S; S.init(g.M, g.N, gridDim.x, (int)__builtin_amdgcn_readfirstlane(bst[3]), 64 * MF_CIN);
            pg8::gemm_phase<MF_CIN>(lds, g, S, pg8::EpiConvIn<MF_CIN>{WSP(bf16_t, WS_BB), WSP(bf16_t, WS_Z), WSP(float, WS_SSQ), WSP(float, WS_SW) + j * 3072});
            PHASE_END
        } else if (kind == 1) {
            PHASE_BEGIN_R(REP_EW)
            pool_phase(WSP(bf16_t, WS_H), WSP(float, WS_SSQ), WSP(bf16_t, WS_A2), (float*)lds_raw);
            PHASE_END
        } else {
            PHASE_BEGIN
            pg8::Gemm g{WSP(bf16_t, WS_H), WSP(bf16_t, WS_QKVW), MT, NQKV, 1024, 1024, 0}; pg8::StaticOrder S; S.init(g.M, g.N, gridDim.x, (int)__builtin_amdgcn_readfirstlane(bst[3]), 64 * MF_QKV);
            pg8::gemm_phase<MF_QKV>(lds, g, S, pg8::EpiBf16N<MF_QKV>{WSP(bf16_t, WS_QKV), NQKV, WSP(float, WS_SSQ), WSP(float, WS_SW) + 6144});
            PHASE_END
        }
        if (part == 0 && kind == 0) {
            PHASE_BEGIN_R(REP_EW)
            conv_phase(WSP(bf16_t, WS_BB), WSP(bf16_t, WS_Z), q->in[11] + (size_t)j * 3 * 1024, WSP(bf16_t, WS_A2));
            PHASE_END
        } else if (part == 0 && kind == 2) {
            PHASE_BEGIN_R(REP_EW)
            float* new_k = q->out + (size_t)MT * DM; float* new_v = new_k + 16 * 2 * 256 * 128;
            qkprep_phase(WSP(bf16_t, WS_QKV), q->in[16] + j * 128, q->in[17] + j * 128, q->in[2], q->in[3], WSP(bf16_t, WS_Q), WSP(bf16_t, WS_KP), WSP(bf16_t, WS_VP), WSP(bf16_t, WS_KS), WSP(bf16_t, WS_VS), new_k, new_v);
            PHASE_END
        } else { ++ph; }
        if (part == 0 && kind == 2) {
            PHASE_BEGIN_R(REP_ATT)
            attn_phase(WSP(bf16_t, WS_Q), WSP(bf16_t, WS_KP), WSP(bf16_t, WS_VP), WSP(bf16_t, WS_KS), WSP(bf16_t, WS_VS), WSP(bf16_t, WS_A2), (char*)lds_raw);
            PHASE_END
        } else { ++ph; }
        PHASE_BEGIN_R(part ? REP_FOUT : REP_MIXOUT)
        {
            const float* MOD = WSP(float, WS_MOD);
            const float* modl = MOD + (size_t)layer * 3 * 6144;
            pg8::Gemm g; const float* cs = nullptr;
            if (part == 1) g = pg8::Gemm{WSP(bf16_t, WS_ACT), WSP(bf16_t, WS_FOUT) + (size_t)layer * 1024 * 2816, MT, 1024, DFF, DFF, 0};
            else if (kind == 0) g = pg8::Gemm{WSP(bf16_t, WS_A2), WSP(bf16_t, WS_COUT) + (size_t)j * 1024 * 1024, MT, 1024, 1024, 1024, 0};
            else if (kind == 1) { g = pg8::Gemm{WSP(bf16_t, WS_A2), WSP(bf16_t, WS_POOL), MT, 1024, 256, 1024, 256}; cs = q->in[14] + j * 1024; }
            else g = pg8::Gemm{WSP(bf16_t, WS_A2), WSP(bf16_t, WS_AOUT), MT, 1024, 1024, 1024, 0};
            pg8::StaticOrder S; S.init(g.M, g.N, gridDim.x, (int)__builtin_amdgcn_readfirstlane(bst[3]), 64 * MF_RES);
            const float* nw = part == 0 ? q->in[7] + layer * 1024 : q->in[6] + (layer + 1) * 1024;
            const float* nsc = part == 0 ? modl + 4 * 1024 : modl + 3 * 6144 + 1 * 1024;
            bf16_t* xg = hl == 7 ? nullptr : WSP(bf16_t, WS_H);
            bf16_t* xo = rep_ + 1 < (part ? REP_FOUT : REP_MIXOUT) ? WSP(bf16_t, WS_X2) : WSP(bf16_t, WS_X);
            pg8::gemm_phase<MF_RES>(lds, g, S, pg8::EpiResid<MF_RES>{WSP(bf16_t, WS_X), xo, modl + (part ? 5 : 2) * 1024, cs, xg, WSP(float, WS_SSQ), nw, nsc});
            if (part == 1 && layer < 3) {
                const int ln = layer + 1; float* SW = WSP(float, WS_SW); const float* modn = MOD + (size_t)ln * 3 * 6144;
                const int w0 = blockIdx.x * 8 + (tid_opaque() >> 6), nwv = gridDim.x * 8;
                if (ln == 2) sw_rows(WSP(bf16_t, WS_QKVW), 1536, modn, SW + 6144, w0, nwv);
                else if (ln == 3) sw_rows(WSP(bf16_t, WS_CIN) + (size_t)3072 * 1024, 3072, modn, SW + 3072, w0, nwv);
                sw_rows(WSP(bf16_t, WS_FIN) + (size_t)ln * 5632 * 1024, 5632, modn + 3 * 1024, SW + 7680 + ln * 5632, w0, nwv);
            }
        }
        PHASE_END
    }
    PHASE_BEGIN_R(REP_NORM)
    final_norm_phase(WSP(bf16_t, WS_X), WSP(float, WS_SSQ), q->in[21], q->out);
    PHASE_END
#ifdef EXTRA_SYNCS
    if (ph_hi - ph_lo > 1) { for (int i_ = 0; i_ < EXTRA_SYNCS; ++i_) xcd_barrier(bar); }
#endif
#undef PHASE_BEGIN
#undef PHASE_END
}

extern "C" void kernel_launch(void* const* d_in, const int* in_sizes, int n_in, void* d_out, int out_size, void* d_ws, size_t ws_size, hipStream_t stream) {
    static int grid = 0;
    if (grid == 0) {
        if (n_in != 22 || ws_size < WS_END) { fprintf(stderr, "kernel_launch: unexpected n_in %d / ws %zu (need %zu)\n", n_in, ws_size, (size_t)WS_END); grid = -1; return; }
        int dev = 0, cus = 0, per_cu = 0;
        hipGetDevice(&dev);
        hipDeviceGetAttribute(&cus, hipDeviceAttributeMultiprocessorCount, dev);
        if (hipFuncSetAttribute((const void*)fwd_megakernel, hipFuncAttributeMaxDynamicSharedMemorySize, LDS_BYTES) != hipSuccess) { fprintf(stderr, "kernel_launch: hipFuncSetAttribute failed\n"); grid = -1; return; }
        if (hipOccupancyMaxActiveBlocksPerMultiprocessor(&per_cu, (const void*)fwd_megakernel, NTHREADS, LDS_BYTES) != hipSuccess || per_cu < 1) { fprintf(stderr, "kernel_launch: occupancy query gave %d\n", per_cu); per_cu = 1; }
        (void)hipGetLastError();
        grid = cus * per_cu;
        fprintf(stderr, "kernel_launch: grid %d (cus %d x %d)\n", grid, cus, per_cu);
    }
    if (grid < 0) return;
    Params p{};
    for (int i = 0; i < 22; ++i) p.in[i] = (const float*)d_in[i];
    p.out = (float*)d_out; p.ws = (unsigned char*)d_ws;
#if MK_MULTI
    for (int ph = 0; ph < NPH; ++ph) {
        p.ph_lo = ph; p.ph_hi = ph + 1;
        hipLaunchKernelGGL(fwd_megakernel, dim3(grid), dim3(NTHREADS), LDS_BYTES, stream, p);
    }
#else
    p.ph_lo = 0; p.ph_hi = NPH;
    (void)hipMemsetAsync((char*)d_ws + WS_BAR, 0, 16384, stream);
    void* args[] = {&p};
    hipError_t e = hipLaunchCooperativeKernel((const void*)fwd_megakernel, dim3(grid), dim3(NTHREADS), args, LDS_BYTES, stream);
    if (e != hipSuccess) fprintf(stderr, "kernel_launch: cooperative launch failed: %s (grid %d)\n", hipGetErrorString(e), grid);
#endif
}
```

```cpp
#include <hip/hip_runtime.h>
#include <hip/hip_cooperative_groups.h>
#include <cstdio>
#include <cstdint>
namespace cg = cooperative_groups;

#ifndef MK_MULTI
#define MK_MULTI 0
#endif

#ifndef REP_PREP
#define REP_PREP 1
#endif
#ifndef REP_NORM
#define REP_NORM 1
#endif
#ifndef REP_FIN
#define REP_FIN 1
#endif
#ifndef REP_FOUT
#define REP_FOUT 1
#endif
#ifndef REP_CIN
#define REP_CIN 1
#endif
#ifndef REP_ATT
#define REP_ATT 1
#endif
#ifndef REP_EW
#define REP_EW 1
#endif
#ifndef REP_MIXOUT
#define REP_MIXOUT 1
#endif
#ifndef MF_FIN
#define MF_FIN 4
#endif
#ifndef MF_CIN
#define MF_CIN 3
#endif
#ifndef MF_QKV
#define MF_QKV 3
#endif
#ifndef MF_RES
#define MF_RES 3
#endif
#define LAS __attribute__((address_space(3)))
typedef unsigned short bf16_t;
typedef short bf16x8 __attribute__((ext_vector_type(8)));
typedef short s16x4 __attribute__((ext_vector_type(4)));
typedef float f32x4 __attribute__((ext_vector_type(4)));
typedef float f32x16 __attribute__((ext_vector_type(16)));
typedef unsigned u32x4 __attribute__((ext_vector_type(4)));
typedef unsigned u32x2 __attribute__((ext_vector_type(2)));

constexpr int DM = 1024, NP = 4096  , NS = 8192  , MT = NP + NS;
constexpr int SEQP = 256, SEQS = 4096, PAST = 256, SKV_S = PAST + SEQS;
constexpr int DFF = 2816, NMOD = 6, NQKV = 1536;
constexpr int NTHREADS = 512;
constexpr int NSW = 2 * 3072 + 1536 + 4 * 5632;
constexpr int LDS_BYTES = 132 * 1024;

constexpr size_t AL(size_t x) { return (x + 255) / 256 * 256; }
constexpr size_t WS_MOD   = 0;
constexpr size_t WS_CIN   = AL(WS_MOD + 4ull * 3 * 6 * 1024 * 4);
constexpr size_t WS_COUT  = AL(WS_CIN + 2ull * 3072 * 1024 * 2);
constexpr size_t WS_POOL  = AL(WS_COUT + 2ull * 1024 * 1024 * 2);
constexpr size_t WS_QKVW  = AL(WS_POOL + 4ull * 256 * 256 * 2);
constexpr size_t WS_AOUT  = AL(WS_QKVW + 1536ull * 1024 * 2);
constexpr size_t WS_FIN   = AL(WS_AOUT + 1024ull * 1024 * 2);
constexpr size_t WS_FOUT  = AL(WS_FIN + 4ull * 5632 * 1024 * 2);
constexpr size_t WS_X     = AL(WS_FOUT + 4ull * 1024 * 2816 * 2);
constexpr size_t WS_H     = AL(WS_X + (size_t)MT * 1024 * 4);
constexpr size_t WS_A2    = AL(WS_H + (size_t)MT * 1024 * 2);
constexpr size_t WS_BB    = AL(WS_A2 + (size_t)MT * 1024 * 2);
constexpr size_t WS_Z     = AL(WS_BB + (size_t)MT * 1024 * 2);
constexpr size_t WS_ACT   = AL(WS_Z + (size_t)MT * 1024 * 2);
constexpr size_t WS_QKV   = WS_BB;
constexpr size_t WS_Q     = WS_H;
constexpr size_t WS_KP    = AL(WS_ACT + (size_t)MT * 2816 * 2);
constexpr size_t WS_VP    = AL(WS_KP + 16ull * 2 * 256 * 128 * 2);
constexpr size_t WS_KS    = AL(WS_VP + 16ull * 2 * 256 * 128 * 2);
constexpr size_t WS_VS    = AL(WS_KS + 2ull * 2 * SKV_S * 128 * 2);
constexpr size_t WS_SSQ   = AL(WS_VS + 2ull * 2 * SKV_S * 128 * 2);
constexpr size_t WS_SW    = AL(WS_SSQ + (size_t)MT * 16 * 4);
constexpr size_t WS_BAR   = AL(WS_SW + 3ull * 30208 * 4);
constexpr size_t WS_X2    = AL(WS_BAR + 16384);
constexpr size_t WS_END   = AL(WS_X2 + (size_t)MT * 1024 * 4);

struct Params {
    const float* in[22];
    float* out;
    unsigned char* ws;
    int ph_lo, ph_hi;
};

__device__ __forceinline__ unsigned cvt_pk_bf16(float lo, float hi) { unsigned r; asm volatile("v_cvt_pk_bf16_f32 %0, %1, %2" : "=v"(r) : "v"(lo), "v"(hi)); return r; }
__device__ __forceinline__ float bf2f(unsigned short b) { return __uint_as_float(((unsigned)b) << 16); }
__device__ __forceinline__ float bflo(unsigned w) { return __uint_as_float(w << 16); }
__device__ __forceinline__ float bfhi(unsigned w) { return __uint_as_float(w & 0xffff0000u); }
__device__ __forceinline__ float silu_f(float x) { return x * __builtin_amdgcn_rcpf(1.0f + __builtin_amdgcn_exp2f(-1.4426950408889634f * x)); }
__device__ __forceinline__ int tid_opaque() { int t = threadIdx.x; asm volatile("" : "+v"(t)); return t; }
__device__ __forceinline__ float quad_row_sum(float s) {
    { auto r = __builtin_amdgcn_permlane16_swap(__float_as_uint(s), __float_as_uint(s), false, false); s = __uint_as_float(r[0]) + __uint_as_float(r[1]); }
    { auto r = __builtin_amdgcn_permlane32_swap(__float_as_uint(s), __float_as_uint(s), false, false); s = __uint_as_float(r[0]) + __uint_as_float(r[1]); }
    return s;
}
__device__ __forceinline__ float wave_sum(float v) {
#pragma unroll
    for (int o = 32; o >= 1; o >>= 1) v += __shfl_xor(v, o);
    return v;
}

namespace pg8 {
constexpr int BM = 256, BK = 64, HALF = 128, HTB = HALF * BK * 2, STAGE_BYTES = 8 * HTB, NXCD = 8, WGM = 8;
__host__ __device__ __forceinline__ int lds_byte(int r, int c) { const int st = (r >> 4) * 2 + (c >> 5), rr = r & 15, cc = c & 31, ob = rr * 64 + cc * 2; return st * 1024 + (ob ^ (((ob >> 9) & 1) << 5)); }
__host__ __device__ __forceinline__ void stage_rc(int b, int& R, int& C) { const int st = b / 1024, sb = b % 1024, swz = sb ^ (((sb >> 9) & 1) << 5); R = (st >> 1) * 16 + swz / 64; C = (st & 1) * 32 + (swz % 64) / 2; }
__host__ __device__ __forceinline__ int perm32(int rho) { const int n = rho >> 4, i = rho & 15; return 8 * (i >> 2) + 4 * n + (i & 3); }

struct Unit { int pm, pn; };
struct Gemm { const bf16_t* A; const bf16_t* Bt; int M, N, K, lda, a_pn_off; };

struct StaticOrder {
    int nM, nN, nwg, G, c, wgm;
    __device__ void init(int M, int N, int G_, int c_, int tile_rows) { nM = M / tile_rows; nN = N / BM; nwg = nM * nN; G = G_; c = c_; wgm = (nM % 8 == 0) ? nM / 8 : WGM; }
    __device__ bool next(int i, Unit& u) const {
        const long L = (long)i * G + c; if (L >= nwg) return false;
        int wgid = (int)L; { const int q = nwg / NXCD, r = nwg % NXCD, xcd = wgid % NXCD, off = wgid / NXCD; wgid = (xcd < r ? xcd * (q + 1) : r * (q + 1) + (xcd - r) * q) + off; }
        const int nig = wgm * nN, gid = wgid / nig, fm = gid * wgm, gsz = (nM - fm) < wgm ? (nM - fm) : wgm;
        u.pm = fm + ((wgid % nig) % gsz); u.pn = (wgid % nig) / gsz; return true;
    }
};

template <int MF, class Epi>
__device__ __forceinline__ void gemm_phase(LAS unsigned char* lds, const Gemm g, const StaticOrder& S, const Epi& E) {
    const int tid = tid_opaque(), wid = __builtin_amdgcn_readfirstlane(tid >> 6), lane = tid & 63, wr = wid >> 2, wc = wid & 3, fr = lane & 15, fq = lane >> 4;
    const int K = g.K, nt = K / BK, lda = g.lda;
    unsigned voffA[2], voffB[2];
#pragma unroll
    for (int i = 0; i < 2; ++i) { int R, C; stage_rc(tid * 16 + i * 8192, R, C); const int Rb = Epi::PERM ? ((R & ~31) + perm32(R & 31)) : R;
        voffA[i] = (unsigned)(R * lda + C) * 2u; voffB[i] = (unsigned)(Rb * K + C) * 2u; }
    const size_t kstep = (size_t)(BK * 2);
    const size_t hstepA = (size_t)(32 * MF) * lda * 2, hstepB = (size_t)HALF * K * 2;
    const size_t tstepA = 2 * hstepA, tstepB = 2 * hstepB;
    const size_t pnoffA = (size_t)g.a_pn_off * 2;
    const unsigned ldsw = (unsigned)wid * 1024u;
    const int aoff = lds_byte(wr * 16 * MF + fr, fq * 8), boff = lds_byte(wc * 32 + fr, fq * 8);
#define PG8_SA(b, h) (((b) * 2 + (h)) * HTB)
#define PG8_SB(b, h) ((4 + (b) * 2 + (h)) * HTB)
#define PG8_STAGE(bufoff, gbase, voff) do { _Pragma("unroll") for (int _i = 0; _i < 2; ++_i) \
        __builtin_amdgcn_global_load_lds((const unsigned*)((const char*)(gbase) + (voff)[_i]), (LAS unsigned*)(lds + (bufoff) + ldsw + _i * 8192), 16, 0, 0); } while (0)
#define PG8_LDA(dst, b, h) do { _Pragma("unroll") for (int m = 0; m < MF; ++m) _Pragma("unroll") for (int k = 0; k < 2; ++k) dst[m][k] = *(const LAS bf16x8*)(lds + PG8_SA(b, h) + aoff + m * 2048 + k * 1024); } while (0)
#define PG8_LDB(dst, b, h) do { _Pragma("unroll") for (int n = 0; n < 2; ++n) _Pragma("unroll") for (int k = 0; k < 2; ++k) dst[n][k] = *(const LAS bf16x8*)(lds + PG8_SB(b, h) + boff + n * 2048 + k * 1024); } while (0)
#define PG8_MMA(ai, bj, At, Bt) do { __builtin_amdgcn_s_setprio(1); _Pragma("unroll") for (int m = 0; m < MF; ++m) _Pragma("unroll") for (int n = 0; n < 2; ++n) _Pragma("unroll") for (int k = 0; k < 2; ++k) \
        acc[ai][bj][m][n] = __builtin_amdgcn_mfma_f32_16x16x32_bf16(Bt[n][k], At[m][k], acc[ai][bj][m][n], 0, 0, 0); __builtin_amdgcn_s_setprio(0); } while (0)
#define PG8_WAIT_V(n) asm volatile("s_waitcnt vmcnt(" #n ")" ::: "memory")
#define PG8_WAIT_L(n) asm volatile("s_waitcnt lgkmcnt(" #n ")" ::: "memory")
#define PG8_BAR __builtin_amdgcn_s_barrier()
#define PG8_SCHED __builtin_amdgcn_sched_barrier(0)
    Unit cur, nxt; int ui = 0;
    if (!S.next(0, cur)) return;
    f32x4 acc[2][2][MF][2];
#pragma unroll
    for (int a = 0; a < 2; ++a)
#pragma unroll
        for (int b = 0; b < 2; ++b)
#pragma unroll
            for (int m = 0; m < MF; ++m)
#pragma unroll
                for (int n = 0; n < 2; ++n) acc[a][b][m][n] = (f32x4){0.f, 0.f, 0.f, 0.f};
    bf16x8 At[MF][2], B0[2][2], B1[2][2];
    const char* cA = (const char*)g.A + (size_t)cur.pm * tstepA + (size_t)cur.pn * pnoffA; const char* cB = (const char*)g.Bt + (size_t)cur.pn * tstepB;
    PG8_STAGE(PG8_SB(0, 0), cB, voffB); PG8_STAGE(PG8_SA(0, 0), cA, voffA); PG8_STAGE(PG8_SB(0, 1), cB + hstepB, voffB); PG8_STAGE(PG8_SA(0, 1), cA + hstepA, voffA);
    if (wr == 1) PG8_BAR;
    PG8_WAIT_V(4); PG8_BAR;
    PG8_STAGE(PG8_SB(1, 0), cB + kstep, voffB); PG8_STAGE(PG8_SA(1, 0), cA + kstep, voffA); PG8_STAGE(PG8_SB(1, 1), cB + hstepB + kstep, voffB);
    PG8_WAIT_V(6); PG8_BAR;
    for (;;) {
        const bool has_next = S.next(ui + 1, nxt);
        const char* nA = has_next ? (const char*)g.A + (size_t)nxt.pm * tstepA + (size_t)nxt.pn * pnoffA : cA; const char* nB = has_next ? (const char*)g.Bt + (size_t)nxt.pn * tstepB : cB;
        for (int t = 0; t < nt; t += 2) {
            const bool last = (t == nt - 2);
            const char* a1 = cA + (size_t)(t + 1) * kstep;
            const char* a2 = last ? nA : cA + (size_t)(t + 2) * kstep; const char* b2 = last ? nB : cB + (size_t)(t + 2) * kstep;
            const char* a3 = a2 + kstep; const char* b3 = b2 + kstep;
            PG8_LDB(B0, 0, 0); PG8_SCHED; PG8_LDA(At, 0, 0); PG8_STAGE(PG8_SA(1, 1), a1 + hstepA, voffA);
            PG8_WAIT_L(8); PG8_BAR; PG8_WAIT_L(0); PG8_MMA(0, 0, At, B0); PG8_BAR; PG8_SCHED;
            PG8_LDB(B1, 0, 1); PG8_STAGE(PG8_SB(0, 0), b2, voffB);
            PG8_BAR; PG8_WAIT_L(0); PG8_MMA(0, 1, At, B1); PG8_BAR;
            PG8_LDA(At, 0, 1); PG8_STAGE(PG8_SA(0, 0), a2, voffA);
            PG8_BAR; PG8_WAIT_L(0); PG8_MMA(1, 0, At, B0); PG8_BAR; PG8_SCHED;
            PG8_STAGE(PG8_SB(0, 1), b2 + hstepB, voffB);
            PG8_WAIT_V(6); PG8_BAR; PG8_MMA(1, 1, At, B1); PG8_BAR;
            PG8_LDB(B0, 1, 0); PG8_SCHED; PG8_LDA(At, 1, 0); PG8_STAGE(PG8_SA(0, 1), a2 + hstepA, voffA);
            PG8_WAIT_L(8); PG8_BAR; PG8_WAIT_L(0); PG8_MMA(0, 0, At, B0); PG8_BAR; PG8_SCHED;
            PG8_LDB(B1, 1, 1); PG8_STAGE(PG8_SB(1, 0), b3, voffB);
            PG8_BAR; PG8_WAIT_L(0); PG8_MMA(0, 1, At, B1); PG8_BAR;
            PG8_LDA(At, 1, 1); PG8_STAGE(PG8_SA(1, 0), a3, voffA);
            PG8_BAR; PG8_WAIT_L(0); PG8_MMA(1, 0, At, B0); PG8_BAR; PG8_SCHED;
            PG8_STAGE(PG8_SB(1, 1), b3 + hstepB, voffB);
            PG8_WAIT_V(6); PG8_BAR; PG8_MMA(1, 1, At, B1); PG8_BAR;
        }
        E(acc, cur, wr, wc, fr, fq);
        if (!has_next) break;
#pragma unroll
        for (int a = 0; a < 2; ++a)
#pragma unroll
            for (int b = 0; b < 2; ++b)
#pragma unroll
                for (int m = 0; m < MF; ++m)
#pragma unroll
                    for (int n = 0; n < 2; ++n) acc[a][b][m][n] = (f32x4){0.f, 0.f, 0.f, 0.f};
        cur = nxt; cA = nA; cB = nB; ++ui;
    }
    PG8_WAIT_V(0);
    if (wr == 0) PG8_BAR;
    PG8_BAR;
#undef PG8_SA
#undef PG8_SB
#undef PG8_STAGE
#undef PG8_LDA
#undef PG8_LDB
#undef PG8_MMA
#undef PG8_WAIT_V
#undef PG8_WAIT_L
#undef PG8_BAR
#undef PG8_SCHED
}

__device__ __forceinline__ int grp_of_row(int row) { return row < NP ? 0 : (row < NP + SEQS ? 1 : 2); }
__device__ __forceinline__ float row_rstd1(const float* ssq, int row, int fq) {
    const f32x4 p = *(const f32x4*)(ssq + (size_t)row * 16 + fq * 4);
    float s = (p[0] + p[1]) + (p[2] + p[3]);
    s = quad_row_sum(s);
    return __builtin_amdgcn_rsqf(s * (1.0f / 1024.0f) + 1e-6f);
}

template <int MF> __device__ __forceinline__ void rows_rstd(const float* ssq, int row0, int fq, float (&rs)[2][MF]) {
    f32x4 p[2][MF];
#pragma unroll
    for (int ai = 0; ai < 2; ++ai)
#pragma unroll
        for (int m = 0; m < MF; ++m) p[ai][m] = *(const f32x4*)(ssq + (size_t)(row0 + ai * (32 * MF) + m * 16) * 16 + fq * 4);
#pragma unroll
    for (int ai = 0; ai < 2; ++ai)
#pragma unroll
        for (int m = 0; m < MF; ++m) { float t = (p[ai][m][0] + p[ai][m][1]) + (p[ai][m][2] + p[ai][m][3]); t = quad_row_sum(t); rs[ai][m] = __builtin_amdgcn_rsqf(t * (1.0f / 1024.0f) + 1e-6f); }
}
template <int MF> struct EpiBf16N {
    static constexpr bool PERM = true;
    bf16_t* C; int ldc; const float* ssq; const float* sw;
    __device__ __forceinline__ void operator()(const f32x4 (&acc)[2][2][MF][2], const Unit& u, int wr, int wc, int fr, int fq) const {
        const int row0 = u.pm * (64 * MF) + wr * (16 * MF) + fr, col0 = u.pn * BM + wc * 32 + 8 * fq;
        f32x4 sv[2][2]; int curg = grp_of_row(row0);
        { const float* swp = sw + curg * NSW + col0;
#pragma unroll
          for (int bj = 0; bj < 2; ++bj) { sv[bj][0] = *(const f32x4*)(swp + bj * HALF); sv[bj][1] = *(const f32x4*)(swp + bj * HALF + 4); } }
        float rsv[2][MF]; rows_rstd<MF>(ssq, row0, fq, rsv);
#pragma unroll
        for (int ai = 0; ai < 2; ++ai)
#pragma unroll
            for (int m = 0; m < MF; ++m) { const int row = row0 + ai * (32 * MF) + m * 16; bf16_t* rowp = C + (size_t)row * ldc + col0;
                const float rs = rsv[ai][m]; const int grp = grp_of_row(row);
                if (grp != curg) { curg = grp; const float* swp = sw + grp * NSW + col0;
#pragma unroll
                    for (int bj = 0; bj < 2; ++bj) { sv[bj][0] = *(const f32x4*)(swp + bj * HALF); sv[bj][1] = *(const f32x4*)(swp + bj * HALF + 4); } }
#pragma unroll
                for (int bj = 0; bj < 2; ++bj) { const f32x4 v0 = acc[ai][bj][m][0] * rs + sv[bj][0], v1 = acc[ai][bj][m][1] * rs + sv[bj][1];
                    u32x4 w; w.x = cvt_pk_bf16(v0[0], v0[1]); w.y = cvt_pk_bf16(v0[2], v0[3]); w.z = cvt_pk_bf16(v1[0], v1[1]); w.w = cvt_pk_bf16(v1[2], v1[3]);
                    *(u32x4*)(rowp + bj * HALF) = w; } }
    }
};
template <int MF> struct EpiResid {
    static constexpr bool PERM = true;
    const bf16_t* base; bf16_t* out; const float* gate; const float* cscale;
    bf16_t* xg; float* ssq; const float* nw; const float* nscale;
    __device__ __forceinline__ void operator()(const f32x4 (&acc)[2][2][MF][2], const Unit& u, int wr, int wc, int fr, int fq) const {
        const int row0 = u.pm * (64 * MF) + wr * (16 * MF) + fr, col0 = u.pn * BM + wc * 32 + 8 * fq;
        f32x4 gvh[2][2], gnh[2][2]; int curg = grp_of_row(row0);
        { const float* gp = gate + curg * (NMOD * DM) + col0; const float* np_ = nscale + curg * (NMOD * DM) + col0;
#pragma unroll
          for (int bj = 0; bj < 2; ++bj)
#pragma unroll
            for (int n = 0; n < 2; ++n) { gvh[bj][n] = *(const f32x4*)(gp + bj * HALF + n * 4); if (cscale) gvh[bj][n] *= *(const f32x4*)(cscale + col0 + bj * HALF + n * 4);
                gnh[bj][n] = xg ? *(const f32x4*)(nw + col0 + bj * HALF + n * 4) * (1.0f + *(const f32x4*)(np_ + bj * HALF + n * 4)) : (f32x4){0.f, 0.f, 0.f, 0.f}; } }
        u32x4 xb[2][MF][2];
#pragma unroll
        for (int ai = 0; ai < 2; ++ai)
#pragma unroll
            for (int m = 0; m < MF; ++m)
#pragma unroll
                for (int bj = 0; bj < 2; ++bj) xb[ai][m][bj] = *(const u32x4*)(base + (size_t)(row0 + ai * (32 * MF) + m * 16) * DM + col0 + bj * HALF);
        asm volatile("" ::: "memory");
#pragma unroll
        for (int ai = 0; ai < 2; ++ai)
#pragma unroll
            for (int m = 0; m < MF; ++m) { const int row = row0 + ai * (32 * MF) + m * 16; const int grp = grp_of_row(row);
                bf16_t* op = out + (size_t)row * DM + col0;
                if (grp != curg) { curg = grp;
                    const float* gp = gate + grp * (NMOD * DM) + col0; const float* np_ = nscale + grp * (NMOD * DM) + col0;
#pragma unroll
                    for (int bj = 0; bj < 2; ++bj)
#pragma unroll
                        for (int n = 0; n < 2; ++n) { gvh[bj][n] = *(const f32x4*)(gp + bj * HALF + n * 4); if (cscale) gvh[bj][n] *= *(const f32x4*)(cscale + col0 + bj * HALF + n * 4);
                            gnh[bj][n] = xg ? *(const f32x4*)(nw + col0 + bj * HALF + n * 4) * (1.0f + *(const f32x4*)(np_ + bj * HALF + n * 4)) : (f32x4){0.f, 0.f, 0.f, 0.f}; } }
                float s = 0.f;
#pragma unroll
                for (int bj = 0; bj < 2; ++bj) { f32x4 h[2], x[2];
                    const u32x4 bw = xb[ai][m][bj];
                    const f32x4 b0 = {bflo(bw.x), bfhi(bw.x), bflo(bw.y), bfhi(bw.y)}, b1 = {bflo(bw.z), bfhi(bw.z), bflo(bw.w), bfhi(bw.w)};
#pragma unroll
                    for (int n = 0; n < 2; ++n) {
                        x[n] = (n == 0 ? b0 : b1) + gvh[bj][n] * acc[ai][bj][m][n];
                        s += (x[n][0] * x[n][0] + x[n][1] * x[n][1]) + (x[n][2] * x[n][2] + x[n][3] * x[n][3]);
                        if (xg) h[n] = x[n] * gnh[bj][n]; }
                    { u32x4 w; w.x = cvt_pk_bf16(x[0][0], x[0][1]); w.y = cvt_pk_bf16(x[0][2], x[0][3]); w.z = cvt_pk_bf16(x[1][0], x[1][1]); w.w = cvt_pk_bf16(x[1][2], x[1][3]);
                      *(u32x4*)(op + bj * HALF) = w; }
                    if (xg) { u32x4 w; w.x = cvt_pk_bf16(h[0][0], h[0][1]); w.y = cvt_pk_bf16(h[0][2], h[0][3]); w.z = cvt_pk_bf16(h[1][0], h[1][1]); w.w = cvt_pk_bf16(h[1][2], h[1][3]);
                        *(u32x4*)(xg + (size_t)row * DM + col0 + bj * HALF) = w; } }
                s = quad_row_sum(s);
                if (fq == 0) ssq[(size_t)row * 16 + u.pn * 4 + wc] = s; }
    }
};
template <int MF> struct EpiConvIn {
    static constexpr bool PERM = true;
    bf16_t* Bb; bf16_t* Z; const float* ssq; const float* sw;
    __device__ __forceinline__ void operator()(const f32x4 (&acc)[2][2][MF][2], const Unit& u, int wr, int wc, int fr, int fq) const {
        const int row0 = u.pm * (64 * MF) + wr * (16 * MF) + fr;
        const int swc = u.pn * BM + wc * 32 + 8 * fq;
        f32x4 sv[2][2]; int curg = grp_of_row(row0);
        { const float* swp = sw + curg * NSW + swc;
#pragma unroll
          for (int bj = 0; bj < 2; ++bj) { sv[bj][0] = *(const f32x4*)(swp + bj * HALF); sv[bj][1] = *(const f32x4*)(swp + bj * HALF + 4); } }
        float rsv[2][MF]; rows_rstd<MF>(ssq, row0, fq, rsv);
        if (u.pn < 4) {
            const int col0 = u.pn * BM + wc * 32 + 8 * fq;
#pragma unroll
            for (int ai = 0; ai < 2; ++ai)
#pragma unroll
                for (int m = 0; m < MF; ++m) { const int row = row0 + ai * (32 * MF) + m * 16; bf16_t* rowp = Bb + (size_t)row * DM + col0;
                    const float rs = rsv[ai][m]; const int grp = grp_of_row(row);
                    if (grp != curg) { curg = grp; const float* swp = sw + grp * NSW + swc;
#pragma unroll
                        for (int bj = 0; bj < 2; ++bj) { sv[bj][0] = *(const f32x4*)(swp + bj * HALF); sv[bj][1] = *(const f32x4*)(swp + bj * HALF + 4); } }
#pragma unroll
                    for (int bj = 0; bj < 2; ++bj) { const f32x4 v0 = acc[ai][bj][m][0] * rs + sv[bj][0], v1 = acc[ai][bj][m][1] * rs + sv[bj][1];
                        u32x4 w; w.x = cvt_pk_bf16(v0[0], v0[1]); w.y = cvt_pk_bf16(v0[2], v0[3]); w.z = cvt_pk_bf16(v1[0], v1[1]); w.w = cvt_pk_bf16(v1[2], v1[3]);
                        *(u32x4*)(rowp + bj * HALF) = w; } }
        } else {
            const int col0 = (u.pn - 4) * HALF + wc * 32 + 8 * fq;
#pragma unroll
            for (int ai = 0; ai < 2; ++ai)
#pragma unroll
                for (int m = 0; m < MF; ++m) { const int row = row0 + ai * (32 * MF) + m * 16; bf16_t* rowp = Z + (size_t)row * DM + col0;
                    const float rs = rsv[ai][m]; const int grp = grp_of_row(row);
                    if (grp != curg) { curg = grp; const float* swp = sw + grp * NSW + swc;
#pragma unroll
                        for (int bj = 0; bj < 2; ++bj) { sv[bj][0] = *(const f32x4*)(swp + bj * HALF); sv[bj][1] = *(const f32x4*)(swp + bj * HALF + 4); } }
                    const f32x4 v0 = (acc[ai][0][m][0] * rs + sv[0][0]) * (acc[ai][1][m][0] * rs + sv[1][0]);
                    const f32x4 v1 = (acc[ai][0][m][1] * rs + sv[0][1]) * (acc[ai][1][m][1] * rs + sv[1][1]);
                    u32x4 w; w.x = cvt_pk_bf16(v0[0], v0[1]); w.y = cvt_pk_bf16(v0[2], v0[3]); w.z = cvt_pk_bf16(v1[0], v1[1]); w.w = cvt_pk_bf16(v1[2], v1[3]);
                    *(u32x4*)rowp = w; }
        }
    }
};
template <int MF> struct EpiSwiglu {
    static constexpr bool PERM = true;
    bf16_t* ACT; const float* ssq; const float* sw;
    __device__ __forceinline__ void operator()(const f32x4 (&acc)[2][2][MF][2], const Unit& u, int wr, int wc, int fr, int fq) const {
        const int row0 = u.pm * (64 * MF) + wr * (16 * MF) + fr, col0 = u.pn * HALF + wc * 32 + 8 * fq;
        const int swc = u.pn * BM + wc * 32 + 8 * fq;
        f32x4 sv[2][2], svn[2]; int curg = grp_of_row(row0);
        { const float* swp = sw + curg * NSW + swc;
#pragma unroll
          for (int bj = 0; bj < 2; ++bj) { sv[bj][0] = *(const f32x4*)(swp + bj * HALF); sv[bj][1] = *(const f32x4*)(swp + bj * HALF + 4); } }
        float rsv[2][MF]; rows_rstd<MF>(ssq, row0, fq, rsv);
        svn[0] = sv[0][0] * -1.4426950408889634f; svn[1] = sv[0][1] * -1.4426950408889634f;
#pragma unroll
        for (int ai = 0; ai < 2; ++ai)
#pragma unroll
            for (int m = 0; m < MF; ++m) { const int row = row0 + ai * (32 * MF) + m * 16; bf16_t* rowp = ACT + (size_t)row * DFF + col0;
                const float rs = rsv[ai][m]; const int grp = grp_of_row(row);
                if (grp != curg) { curg = grp; const float* swp = sw + grp * NSW + swc;
#pragma unroll
                    for (int bj = 0; bj < 2; ++bj) { sv[bj][0] = *(const f32x4*)(swp + bj * HALF); sv[bj][1] = *(const f32x4*)(swp + bj * HALF + 4); }
                    svn[0] = sv[0][0] * -1.4426950408889634f; svn[1] = sv[0][1] * -1.4426950408889634f; }
                const f32x4 sg0 = sv[0][0], sg1 = sv[0][1];
                const f32x4 g0 = acc[ai][0][m][0] * rs + sg0, g1 = acc[ai][0][m][1] * rs + sg1;
                const float rsn = rs * -1.4426950408889634f;
                f32x4 e0 = acc[ai][0][m][0] * rsn + svn[0], e1 = acc[ai][0][m][1] * rsn + svn[1];
                const f32x4 u0 = acc[ai][1][m][0] * rs + sv[1][0], u1 = acc[ai][1][m][1] * rs + sv[1][1];
#pragma unroll
                for (int j = 0; j < 4; ++j) { e0[j] = __builtin_amdgcn_exp2f(e0[j]); e1[j] = __builtin_amdgcn_exp2f(e1[j]); }
                e0 = e0 + 1.0f; e1 = e1 + 1.0f;
#pragma unroll
                for (int j = 0; j < 4; ++j) { e0[j] = __builtin_amdgcn_rcpf(e0[j]); e1[j] = __builtin_amdgcn_rcpf(e1[j]); }
                const f32x4 v0 = (g0 * u0) * e0, v1 = (g1 * u1) * e1;
                u32x4 w; w.x = cvt_pk_bf16(v0[0], v0[1]); w.y = cvt_pk_bf16(v0[2], v0[3]); w.z = cvt_pk_bf16(v1[0], v1[1]); w.w = cvt_pk_bf16(v1[2], v1[3]);
                *(u32x4*)rowp = w; }
    }
};
}

namespace att {
constexpr int D = 128, NW = 8, QBLK = 32, KVBLK = 64;
constexpr float SCALE = 0.088388347648318440f;
constexpr float THR = 8.f;
constexpr int LDQ = 1024, LDK = 128, LDO = 1024;
constexpr size_t SHM_V = KVBLK * D * 2, SHM_K = KVBLK * D * 2, SHM_ATTN = 2 * SHM_V + 2 * SHM_K + NW * 64 * 4;
#define KSWZ(row, colB) ((row) * 256 + ((colB) ^ (((row) & 7) << 4)))
#define SBAR() __builtin_amdgcn_sched_barrier(0)
__device__ __forceinline__ int crow(int r, int hi) { return (r & 3) + 8 * (r >> 2) + 4 * hi; }
__device__ __forceinline__ unsigned cvtpk(float lo, float hi) { unsigned r; asm volatile("v_cvt_pk_bf16_f32 %0, %1, %2" : "=v"(r) : "v"(lo), "v"(hi)); return r; }

__device__ __forceinline__ void partialSM(f32x16& p0, f32x16& p1, float& m_reg, float& mn, float& alpha) {
  constexpr float C = SCALE * 1.4426950408889634f;
  float pmax = p0[0];
#pragma unroll
  for (int r = 1; r < 16; ++r) pmax = fmaxf(pmax, p0[r]);
#pragma unroll
  for (int r = 0; r < 16; ++r) pmax = fmaxf(pmax, p1[r]);
  { auto rr = __builtin_amdgcn_permlane32_swap(__float_as_uint(pmax), __float_as_uint(pmax), false, false);
    pmax = fmaxf(__uint_as_float(rr[0]), __uint_as_float(rr[1])); }
  if (__builtin_expect(__all(pmax - m_reg <= THR / SCALE), 1)) { mn = m_reg; alpha = 1.f; }
  else { mn = fmaxf(m_reg, pmax); alpha = __builtin_amdgcn_exp2f((m_reg - mn) * C); m_reg = mn; }
  float mnC = -mn * C;
#pragma unroll
  for (int r = 0; r < 16; ++r) p0[r] = fmaf(p0[r], C, mnC);
#pragma unroll
  for (int r = 0; r < 16; ++r) p1[r] = fmaf(p1[r], C, mnC);
#pragma unroll
  for (int r = 0; r < 16; ++r) p0[r] = __builtin_amdgcn_exp2f(p0[r]);
}
__device__ __forceinline__ void finishSM(f32x16& p0, f32x16& p1, float alpha, float& l_reg, bf16x8& pa0, bf16x8& pa1, bf16x8& pa2, bf16x8& pa3) {
#pragma unroll
  for (int r = 0; r < 16; ++r) p1[r] = __builtin_amdgcn_exp2f(p1[r]);
  float ps = 0;
#pragma unroll
  for (int r = 0; r < 16; ++r) ps += p0[r];
#pragma unroll
  for (int r = 0; r < 16; ++r) ps += p1[r];
  { auto rr = __builtin_amdgcn_permlane32_swap(__float_as_uint(ps), __float_as_uint(ps), false, false);
    ps = __uint_as_float(rr[0]) + __uint_as_float(rr[1]); }
  l_reg = l_reg * alpha + ps;
#define PK4(P, BASE, OUT) do { unsigned a0 = cvtpk(P[BASE + 0], P[BASE + 1]), a1 = cvtpk(P[BASE + 2], P[BASE + 3]);   \
    unsigned b0 = cvtpk(P[BASE + 4], P[BASE + 5]), b1 = cvtpk(P[BASE + 6], P[BASE + 7]);                              \
    auto r0 = __builtin_amdgcn_permlane32_swap(a0, b0, false, false); auto r1 = __builtin_amdgcn_permlane32_swap(a1, b1, false, false); \
    u32x4 w = {r0[0], r1[0], r0[1], r1[1]}; OUT = *reinterpret_cast<bf16x8*>(&w); } while (0)
  PK4(p0, 0, pa0); PK4(p0, 8, pa1); PK4(p1, 0, pa2); PK4(p1, 8, pa3);
#undef PK4
}
__device__ __forceinline__ void qkt(f32x16& p0, f32x16& p1, const bf16_t* Ks, const bf16x8* qr, int r32, int hi) {
  p0 = f32x16{}; p1 = f32x16{};
#pragma unroll
  for (int d0 = 0; d0 < 8; ++d0) { int cb = (d0 * 16 + hi * 8) * 2;
    bf16x8 b0 = *reinterpret_cast<const bf16x8*>((const char*)Ks + KSWZ(r32, cb));
    bf16x8 b1 = *reinterpret_cast<const bf16x8*>((const char*)Ks + KSWZ(32 + r32, cb));
    p0 = __builtin_amdgcn_mfma_f32_32x32x16_bf16(b0, qr[d0], p0, 0, 0, 0);
    p1 = __builtin_amdgcn_mfma_f32_32x32x16_bf16(b1, qr[d0], p1, 0, 0, 0); }
}
__device__ __forceinline__ int v_st(int k, int c) { const int kk = (k & ~0xC) | ((k & 4) << 1) | ((k & 8) >> 1); return ((kk >> 3) * 4 + (c >> 5)) * 512 + ((kk & 7) * 32 + (c & 31)) * 2; }
__device__ __forceinline__ int v_rd_base(int lane) { return ((lane & 3) << 3) | (((lane >> 2) & 3) << 6) | (((lane >> 4) & 1) << 5) | (((lane >> 5) & 1) << 8); }
constexpr int v_rd_off(int d0, int ks, int half) { return d0 * 512 + ks * 4096 + half * 2048; }
template <int OFF> __device__ __forceinline__ s16x4 tr_read(int vb) {
  s16x4 r; asm volatile("ds_read_b64_tr_b16 %0, %1 offset:%2" : "=&v"(r) : "v"(vb), "i"(OFF) : "memory"); return r;
}
template <int D0> __device__ __forceinline__ void pv_one(f32x16& od, int vb, bf16x8 pa0, bf16x8 pa1, bf16x8 pa2, bf16x8 pa3) {
  const s16x4 l0 = tr_read<v_rd_off(D0, 0, 0)>(vb), h0 = tr_read<v_rd_off(D0, 0, 1)>(vb), l1 = tr_read<v_rd_off(D0, 1, 0)>(vb), h1 = tr_read<v_rd_off(D0, 1, 1)>(vb);
  const s16x4 l2 = tr_read<v_rd_off(D0, 2, 0)>(vb), h2 = tr_read<v_rd_off(D0, 2, 1)>(vb), l3 = tr_read<v_rd_off(D0, 3, 0)>(vb), h3 = tr_read<v_rd_off(D0, 3, 1)>(vb);
  asm volatile("s_waitcnt lgkmcnt(0)" ::: "memory"); SBAR();
#define PK(L, H) (bf16x8){L[0], L[1], L[2], L[3], H[0], H[1], H[2], H[3]}
  od = __builtin_amdgcn_mfma_f32_32x32x16_bf16(pa0, PK(l0, h0), od, 0, 0, 0);
  od = __builtin_amdgcn_mfma_f32_32x32x16_bf16(pa1, PK(l1, h1), od, 0, 0, 0);
  od = __builtin_amdgcn_mfma_f32_32x32x16_bf16(pa2, PK(l2, h2), od, 0, 0, 0);
  od = __builtin_amdgcn_mfma_f32_32x32x16_bf16(pa3, PK(l3, h3), od, 0, 0, 0);
#undef PK
}
__device__ __forceinline__ void pv_d0(f32x16* o, int vb, bf16x8 pa0, bf16x8 pa1, bf16x8 pa2, bf16x8 pa3) {
  pv_one<0>(o[0], vb, pa0, pa1, pa2, pa3); pv_one<1>(o[1], vb, pa0, pa1, pa2, pa3); pv_one<2>(o[2], vb, pa0, pa1, pa2, pa3); pv_one<3>(o[3], vb, pa0, pa1, pa2, pa3);
}

__device__ __forceinline__ void attn_dense_body(const bf16_t* __restrict__ Qb, const bf16_t* __restrict__ Kh, const bf16_t* __restrict__ Vh,
                                                bf16_t* __restrict__ Ob, int seq, char* lds) {
  const int tid = tid_opaque(), wid = tid >> 6, lane = tid & 63, r32 = lane & 31, hi = lane >> 5;
  bf16_t* V_lds = (bf16_t*)lds; bf16_t* K_lds = (bf16_t*)(lds + 2 * SHM_V);
  float* ws = (float*)(lds + 2 * SHM_V + 2 * SHM_K) + wid * 64; float* li_l = ws; float* al_l = ws + 32;
  float m_reg = -1e30f, l_reg = 0; f32x16 o[4] = {}; bf16x8 qr[8];
  const bf16_t* Qw = Qb + (long)(wid * QBLK + r32) * LDQ + hi * 8;
#pragma unroll
  for (int d0 = 0; d0 < 8; ++d0) qr[d0] = *reinterpret_cast<const bf16x8*>(Qw + d0 * 16);
  const int sr = tid >> 4, sc = (tid & 15) * 8, vst0 = v_st(sr, sc), vst1 = v_st(32 + sr, sc);
  const int vb0 = (int)(uintptr_t)V_lds + v_rd_base(lane);
  struct { bf16x8 vs0, vs1, ks0, ks1; } sr_[2];
#define SLOAD(i, k0) do { sr_[i].vs0 = *reinterpret_cast<const bf16x8*>(&Vh[(long)((k0) + sr) * LDK + sc]); sr_[i].vs1 = *reinterpret_cast<const bf16x8*>(&Vh[(long)((k0) + 32 + sr) * LDK + sc]); \
    sr_[i].ks0 = *reinterpret_cast<const bf16x8*>(&Kh[(long)((k0) + sr) * LDK + sc]); sr_[i].ks1 = *reinterpret_cast<const bf16x8*>(&Kh[(long)((k0) + 32 + sr) * LDK + sc]); } while (0)
#define SWRITE(b, i) do { *(bf16x8*)((char*)V_lds + (b) * SHM_V + vst0) = sr_[i].vs0;          \
    *(bf16x8*)((char*)V_lds + (b) * SHM_V + vst1) = sr_[i].vs1; int kc = sc * 2;               \
    *(bf16x8*)((char*)K_lds + (b) * SHM_K + KSWZ(sr, kc)) = sr_[i].ks0;                       \
    *(bf16x8*)((char*)K_lds + (b) * SHM_K + KSWZ(32 + sr, kc)) = sr_[i].ks1; } while (0)
#define SWAIT() asm volatile("s_waitcnt vmcnt(4)" ::: "memory")
#define RESC(a) do { if (__any((a) < 1.f)) { if (hi == 0) al_l[r32] = (a); asm volatile("s_waitcnt lgkmcnt(0)" ::: "memory"); \
    _Pragma("unroll") for (int d = 0; d < 4; ++d) _Pragma("unroll") for (int r = 0; r < 16; ++r) o[d][r] *= al_l[crow(r, hi)]; } } while (0)
  f32x16 pA0, pA1, pB0, pB1; float mnA, mnB, alA, alB; bf16x8 pa0, pa1, pa2, pa3; const int NT = seq / KVBLK;
  constexpr int SE = 0, SO = 1;
  SLOAD(SE, 0); asm volatile("s_waitcnt vmcnt(0)" ::: "memory"); SWRITE(0, SE); __syncthreads();
  qkt(pA0, pA1, K_lds, qr, r32, hi); partialSM(pA0, pA1, m_reg, mnA, alA);
  SLOAD(SO, KVBLK); if (2 < NT) SLOAD(SE, 2 * KVBLK);
  SWAIT(); SWRITE(1, SO); __syncthreads();
  for (int j = 1; j + 1 < NT; j += 2) {
    SBAR(); qkt(pB0, pB1, (bf16_t*)((char*)K_lds + SHM_K), qr, r32, hi);
    finishSM(pA0, pA1, alA, l_reg, pa0, pa1, pa2, pa3); SBAR();
    SLOAD(SO, (j + 2) * KVBLK); SBAR();
    pv_d0(o, vb0, pa0, pa1, pa2, pa3); partialSM(pB0, pB1, m_reg, mnB, alB);
    __syncthreads(); SWAIT(); SWRITE(0, SE);
    RESC(alB); __syncthreads();
    SBAR(); qkt(pA0, pA1, K_lds, qr, r32, hi);
    finishSM(pB0, pB1, alB, l_reg, pa0, pa1, pa2, pa3); SBAR();
    if (j + 3 < NT) SLOAD(SE, (j + 3) * KVBLK); SBAR();
    pv_d0(o, vb0 + (int)SHM_V, pa0, pa1, pa2, pa3); partialSM(pA0, pA1, m_reg, mnA, alA);
    __syncthreads(); SWAIT(); SWRITE(1, SO);
    RESC(alA); __syncthreads();
  }
  SBAR(); qkt(pB0, pB1, (bf16_t*)((char*)K_lds + SHM_K), qr, r32, hi);
  finishSM(pA0, pA1, alA, l_reg, pa0, pa1, pa2, pa3); SBAR();
  pv_d0(o, vb0, pa0, pa1, pa2, pa3); partialSM(pB0, pB1, m_reg, mnB, alB);
  __syncthreads(); RESC(alB);
  finishSM(pB0, pB1, alB, l_reg, pa0, pa1, pa2, pa3); SBAR();
  pv_d0(o, vb0 + (int)SHM_V, pa0, pa1, pa2, pa3);
  if (hi == 0) li_l[r32] = l_reg; asm volatile("s_waitcnt lgkmcnt(0)" ::: "memory");
  float rli[16];
#pragma unroll
  for (int r = 0; r < 16; ++r) rli[r] = __builtin_amdgcn_rcpf(li_l[crow(r, hi)]);
  bf16_t* Ow = Ob + (long)(wid * QBLK) * LDO;
#pragma unroll
  for (int r = 0; r < 16; ++r) { int orow = crow(r, hi);
#pragma unroll
    for (int d0 = 0; d0 < 4; ++d0) Ow[(long)orow * LDO + d0 * 32 + r32] = (bf16_t)(cvtpk(o[d0][r] * rli[r], 0.f) & 0xffffu); }
  __syncthreads();
#undef SLOAD
#undef SWRITE
#undef SWAIT
#undef RESC
}
}

__device__ __forceinline__ int src_col(int mode, int nd) {
    if (mode == 1) { if (nd < 1024) return nd; const int q = nd - 1024, j = q >> 8, r = q & 255; return r < 128 ? 1024 + 128 * j + r : 2048 + 128 * j + (r - 128); }
    if (mode == 2) { const int j = nd >> 8, r = nd & 255; return r < 128 ? 128 * j + r : DFF + 128 * j + (r - 128); }
    return nd;
}
struct CvtRegs { f32x4 v[4]; };
__device__ __forceinline__ void cvt_load(const float* __restrict__ W, int ldw, int mode, int nkt, int u, int tid, CvtRegs& rg) {
    const int kt = u % nkt, ntile = u / nkt, r = tid >> 3, c16 = (tid & 7) * 16;
    const float* src = W + (size_t)(kt * 64 + r) * ldw + src_col(mode, ntile * 128) + c16;
#pragma unroll
    for (int i = 0; i < 4; ++i) rg.v[i] = *(const f32x4*)(src + 4 * i);
}
__device__ __forceinline__ void cvt_matrix(const float* __restrict__ W, int K, int N, bf16_t* __restrict__ Bt, int mode, int& uoff, float* tile, int wk, int nwk) {
    const int tid = tid_opaque(), nkt = K / 64, nu = nkt * (N / 128);
    const int first = (wk - (uoff % nwk) + nwk) % nwk;
    uoff += nu;
    if (first >= nu) return;
    CvtRegs cur, nxt; cvt_load(W, N, mode, nkt, first, tid, cur);
    for (int u = first; u < nu; u += nwk) {
        const int r = tid >> 3, c16 = (tid & 7) * 16;
        float* tp = tile + r * 129 + c16;
#pragma unroll
        for (int i = 0; i < 4; ++i) { tp[4 * i + 0] = cur.v[i][0]; tp[4 * i + 1] = cur.v[i][1]; tp[4 * i + 2] = cur.v[i][2]; tp[4 * i + 3] = cur.v[i][3]; }
        __syncthreads();
        if (u + nwk < nu) cvt_load(W, N, mode, nkt, u + nwk, tid, nxt);
        const int kt = u % nkt, ntile = u / nkt, n = tid >> 2, kc = (tid & 3) * 16;
        const float* rp = tile + kc * 129 + n;
        u32x4 w0, w1;
        w0.x = cvt_pk_bf16(rp[0 * 129], rp[1 * 129]); w0.y = cvt_pk_bf16(rp[2 * 129], rp[3 * 129]); w0.z = cvt_pk_bf16(rp[4 * 129], rp[5 * 129]); w0.w = cvt_pk_bf16(rp[6 * 129], rp[7 * 129]);
        w1.x = cvt_pk_bf16(rp[8 * 129], rp[9 * 129]); w1.y = cvt_pk_bf16(rp[10 * 129], rp[11 * 129]); w1.z = cvt_pk_bf16(rp[12 * 129], rp[13 * 129]); w1.w = cvt_pk_bf16(rp[14 * 129], rp[15 * 129]);
        bf16_t* dst = Bt + (size_t)(ntile * 128 + n) * K + kt * 64 + kc;
        *(u32x4*)dst = w0; *(u32x4*)(dst + 8) = w1;
        __syncthreads();
        cur = nxt;
    }
}

__device__ __forceinline__ void adaln_units(const float* c, const float* c_ctx, const float* ada_w, const float* ada_b, float* MOD, float* lds_f, int& uoff, int l0, int wk, int G) {
    const int tid = tid_opaque();
    float* sv = lds_f;
    float* red = lds_f + 3 * 1024;
    for (int i = tid; i < 3 * 1024; i += NTHREADS) { const int g = i >> 10, k = i & 1023; const float v = g == 0 ? c_ctx[k] : c[(g - 1) * 1024 + k]; sv[i] = silu_f(v); }
    __syncthreads();
    const int nu = 192;
    int first = (wk - (uoff % G) + G) % G;
    const int cq = tid & 7, ks = tid >> 3;
    for (int u = first; u < nu; u += G) {
        const int l = l0, cc = u * 32;
        const float* wp = ada_w + (size_t)l * 1024 * 6144 + cc + cq * 4;
        f32x4 a0 = {0, 0, 0, 0}, a1 = a0, a2 = a0;
#pragma unroll 8
        for (int it = 0; it < 16; ++it) { const int k = ks + 64 * it; const f32x4 w = *(const f32x4*)(wp + (size_t)k * 6144);
            a0 += sv[k] * w; a1 += sv[1024 + k] * w; a2 += sv[2048 + k] * w; }
        float* rp = red + ks * 96 + cq * 4;
#pragma unroll
        for (int j = 0; j < 4; ++j) { rp[j] = a0[j]; rp[32 + j] = a1[j]; rp[64 + j] = a2[j]; }
        __syncthreads();
        if (tid < 96) { float s = 0; for (int q = 0; q < 64; ++q) s += red[q * 96 + tid]; const int g = tid >> 5, n = cc + (tid & 31);
            MOD[((size_t)l * 3 + g) * 6144 + n] = s + ada_b[l * 6144 + n]; }
        __syncthreads();
    }
    uoff += nu;
}

__device__ __forceinline__ void unpack8(const u32x4 w, float* f) { f[0] = bflo(w.x); f[1] = bfhi(w.x); f[2] = bflo(w.y); f[3] = bfhi(w.y); f[4] = bflo(w.z); f[5] = bfhi(w.z); f[6] = bflo(w.w); f[7] = bfhi(w.w); }
__device__ __forceinline__ u32x4 pack8(const float* f) { u32x4 w; w.x = cvt_pk_bf16(f[0], f[1]); w.y = cvt_pk_bf16(f[2], f[3]); w.z = cvt_pk_bf16(f[4], f[5]); w.w = cvt_pk_bf16(f[6], f[7]); return w; }
__device__ __forceinline__ void norm0_phase(const float* __restrict__ xp, const float* __restrict__ xs, const float* __restrict__ nw, const float* __restrict__ scale, bf16_t* __restrict__ XG, float* __restrict__ SSQ, bf16_t* __restrict__ XB) {
    const int tidq = tid_opaque(); const int lane = tidq & 63, wid = tidq >> 6;
    f32x4 wv[4];
#pragma unroll
    for (int j = 0; j < 4; ++j) wv[j] = *(const f32x4*)(nw + j * 256 + lane * 4);
    const int stride = gridDim.x * 8;
    for (int row = blockIdx.x * 8 + wid; row < MT; row += 2 * stride) {
        const int rowb = row + stride < MT ? row + stride : row;
        const float* xa = row < NP ? xp + (size_t)row * DM : xs + (size_t)(row - NP) * DM;
        const float* xb = rowb < NP ? xp + (size_t)rowb * DM : xs + (size_t)(rowb - NP) * DM;
        f32x4 va[4], vb[4];
#pragma unroll
        for (int j = 0; j < 4; ++j) { va[j] = *(const f32x4*)(xa + j * 256 + lane * 4); vb[j] = *(const f32x4*)(xb + j * 256 + lane * 4); }
        const float* sca = scale + (row < NP ? 0 : (row < NP + SEQS ? 1 : 2)) * 6144; const float* scb = scale + (rowb < NP ? 0 : (rowb < NP + SEQS ? 1 : 2)) * 6144;
        float sa = 0, sb = 0;
#pragma unroll
        for (int j = 0; j < 4; ++j) {
            sa += (va[j][0] * va[j][0] + va[j][1] * va[j][1]) + (va[j][2] * va[j][2] + va[j][3] * va[j][3]);
            sb += (vb[j][0] * vb[j][0] + vb[j][1] * vb[j][1]) + (vb[j][2] * vb[j][2] + vb[j][3] * vb[j][3]);
            const f32x4 ha = va[j] * wv[j] * (1.0f + *(const f32x4*)(sca + j * 256 + lane * 4)), hb = vb[j] * wv[j] * (1.0f + *(const f32x4*)(scb + j * 256 + lane * 4));
            u32x2 oa, ob; oa.x = cvt_pk_bf16(ha[0], ha[1]); oa.y = cvt_pk_bf16(ha[2], ha[3]); ob.x = cvt_pk_bf16(hb[0], hb[1]); ob.y = cvt_pk_bf16(hb[2], hb[3]);
            *(u32x2*)(XG + (size_t)row * DM + j * 256 + lane * 4) = oa; *(u32x2*)(XG + (size_t)rowb * DM + j * 256 + lane * 4) = ob;
            u32x2 xa, xb; xa.x = cvt_pk_bf16(va[j][0], va[j][1]); xa.y = cvt_pk_bf16(va[j][2], va[j][3]); xb.x = cvt_pk_bf16(vb[j][0], vb[j][1]); xb.y = cvt_pk_bf16(vb[j][2], vb[j][3]);
            *(u32x2*)(XB + (size_t)row * DM + j * 256 + lane * 4) = xa; *(u32x2*)(XB + (size_t)rowb * DM + j * 256 + lane * 4) = xb; }
        sa = wave_sum(sa); sb = wave_sum(sb);
        if (lane < 16) { SSQ[(size_t)row * 16 + lane] = lane == 0 ? sa : 0.f; SSQ[(size_t)rowb * 16 + lane] = lane == 0 ? sb : 0.f; }
    }
}
__device__ __forceinline__ void sw_rows(const bf16_t* __restrict__ Bt, int N, const float* __restrict__ shift, float* __restrict__ SWo, int wave0, int nwaves) {
    const int lane = tid_opaque() & 63;
    float sh[3][16];
#pragma unroll
    for (int g = 0; g < 3; ++g)
#pragma unroll
        for (int h = 0; h < 2; ++h)
#pragma unroll
            for (int j4 = 0; j4 < 2; ++j4) { const f32x4 t = *(const f32x4*)(shift + g * 6144 + h * 512 + lane * 8 + j4 * 4); sh[g][h * 8 + j4 * 4 + 0] = t[0]; sh[g][h * 8 + j4 * 4 + 1] = t[1]; sh[g][h * 8 + j4 * 4 + 2] = t[2]; sh[g][h * 8 + j4 * 4 + 3] = t[3]; }
    for (int n = wave0; n < N; n += 2 * nwaves) {
        const int n2 = n + nwaves < N ? n + nwaves : n;
        const bf16_t* rp = Bt + (size_t)n * 1024 + lane * 8; const bf16_t* rq = Bt + (size_t)n2 * 1024 + lane * 8;
        const u32x4 a0 = *(const u32x4*)rp, a1 = *(const u32x4*)(rp + 512), b0 = *(const u32x4*)rq, b1 = *(const u32x4*)(rq + 512);
        float w[16], v[16]; unpack8(a0, w); unpack8(a1, w + 8); unpack8(b0, v); unpack8(b1, v + 8);
        float d0 = 0, d1 = 0, d2 = 0, e0 = 0, e1 = 0, e2 = 0;
#pragma unroll
        for (int j = 0; j < 16; ++j) { d0 += sh[0][j] * w[j]; d1 += sh[1][j] * w[j]; d2 += sh[2][j] * w[j]; e0 += sh[0][j] * v[j]; e1 += sh[1][j] * v[j]; e2 += sh[2][j] * v[j]; }
#pragma unroll
        for (int o = 32; o >= 1; o >>= 1) { d0 += __shfl_xor(d0, o); d1 += __shfl_xor(d1, o); d2 += __shfl_xor(d2, o); e0 += __shfl_xor(e0, o); e1 += __shfl_xor(e1, o); e2 += __shfl_xor(e2, o); }
        if (lane == 0) { SWo[n] = d0; SWo[NSW + n] = d1; SWo[2 * NSW + n] = d2; SWo[n2] = e0; SWo[NSW + n2] = e1; SWo[2 * NSW + n2] = e2; }
    }
}
__device__ __forceinline__ void final_norm_phase(const bf16_t* __restrict__ X, const float* __restrict__ SSQ, const float* __restrict__ w, float* __restrict__ out) {
    const int tidq = tid_opaque(); const int lane = tidq & 63, wid = tidq >> 6;
    f32x4 wv[4];
#pragma unroll
    for (int j = 0; j < 4; ++j) wv[j] = *(const f32x4*)(w + j * 256 + lane * 4);
    const int stride = gridDim.x * 8;
    for (int row = blockIdx.x * 8 + wid; row < MT; row += 2 * stride) {
        const int rowb = row + stride < MT ? row + stride : row;
        f32x4 va[4], vb[4];
#pragma unroll
        for (int j = 0; j < 4; ++j) { const u32x2 pa = *(const u32x2*)(X + (size_t)row * DM + j * 256 + lane * 4), pb = *(const u32x2*)(X + (size_t)rowb * DM + j * 256 + lane * 4);
            va[j] = (f32x4){bflo(pa.x), bfhi(pa.x), bflo(pa.y), bfhi(pa.y)}; vb[j] = (f32x4){bflo(pb.x), bfhi(pb.x), bflo(pb.y), bfhi(pb.y)}; }
        float sa = SSQ[(size_t)row * 16 + (lane & 15)], sb = SSQ[(size_t)rowb * 16 + (lane & 15)];
#pragma unroll
        for (int o = 8; o >= 1; o >>= 1) { sa += __shfl_xor(sa, o); sb += __shfl_xor(sb, o); }
        const float ra = 1.0f / sqrtf(sa * (1.0f / 1024.0f) + 1e-6f), rb = 1.0f / sqrtf(sb * (1.0f / 1024.0f) + 1e-6f);
#pragma unroll
        for (int j = 0; j < 4; ++j) { *(f32x4*)(out + (size_t)row * DM + j * 256 + lane * 4) = va[j] * ra * wv[j]; *(f32x4*)(out + (size_t)rowb * DM + j * 256 + lane * 4) = vb[j] * rb * wv[j]; }
    }
}

__device__ __forceinline__ void conv_item_load(const bf16_t* __restrict__ Bb, const bf16_t* __restrict__ Z, long i, u32x4& z0, u32x4& z1, u32x4& z2, u32x4& b) {
    const int row = (int)(i >> 7), c = (int)(i & 127) * 8;
    int t, T; if (row < NP) { t = row & (SEQP - 1); T = SEQP; } else { t = (row - NP) & (SEQS - 1); T = SEQS; }
    const bf16_t* zp = Z + (size_t)row * DM + c;
    const u32x4 zero = {0u, 0u, 0u, 0u};
    z1 = *(const u32x4*)zp; z0 = t > 0 ? *(const u32x4*)(zp - DM) : zero; z2 = t < T - 1 ? *(const u32x4*)(zp + DM) : zero;
    b = *(const u32x4*)(Bb + (size_t)row * DM + c);
}
__device__ __forceinline__ void conv_item_store(const float* __restrict__ cw, bf16_t* __restrict__ A2, long i, const u32x4& z0, const u32x4& z1, const u32x4& z2, const u32x4& b) {
    const int row = (int)(i >> 7), c = (int)(i & 127) * 8;
    float f0[8], f1[8], f2[8], fb[8], o[8];
    unpack8(z0, f0); unpack8(z1, f1); unpack8(z2, f2); unpack8(b, fb);
#pragma unroll
    for (int j = 0; j < 8; ++j) o[j] = fb[j] * (f0[j] * cw[c + j] + f1[j] * cw[1024 + c + j] + f2[j] * cw[2048 + c + j]);
    *(u32x4*)(A2 + (size_t)row * DM + c) = pack8(o);
}
__device__ __forceinline__ void conv_phase(const bf16_t* __restrict__ Bb, const bf16_t* __restrict__ Z, const float* __restrict__ cw, bf16_t* __restrict__ A2) {
    const long total = (long)MT * 128, stride = (long)gridDim.x * NTHREADS;
    for (long i = (long)blockIdx.x * NTHREADS + tid_opaque(); i < total; i += 2 * stride) {
        const long i2 = i + stride < total ? i + stride : i;
        u32x4 a0, a1, a2, ab, c0, c1, c2, cb;
        conv_item_load(Bb, Z, i, a0, a1, a2, ab); conv_item_load(Bb, Z, i2, c0, c1, c2, cb);
        conv_item_store(cw, A2, i, a0, a1, a2, ab); conv_item_store(cw, A2, i2, c0, c1, c2, cb);
    }
}

template <int HW> __device__ __forceinline__ void pool_item(const bf16_t* __restrict__ hp, const float* rl, int t, int T, bf16_t* __restrict__ dp) {
    u32x4 v[2 * HW]; float wgt[2 * HW];
    int cnt = 0;
#pragma unroll
    for (int q = 0; q < 2 * HW; ++q) { const int d = q - HW; const bool ok = (t + d >= 0) && (t + d < T); v[q] = *(const u32x4*)(hp + (long)(ok ? d : 0) * DM); wgt[q] = ok ? rl[d] : 0.f; cnt += ok ? 1 : 0; }
    float s[8], f[8];
#pragma unroll
    for (int j = 0; j < 8; ++j) s[j] = 0.f;
#pragma unroll
    for (int q = 0; q < 2 * HW; ++q) { unpack8(v[q], f);
#pragma unroll
        for (int j = 0; j < 8; ++j) s[j] += f[j] * wgt[q]; }
    unpack8(v[HW], f);
    const float inv = 1.0f / (float)cnt, rt = rl[0];
#pragma unroll
    for (int j = 0; j < 8; ++j) s[j] = s[j] * inv - f[j] * rt;
    *(u32x4*)dp = pack8(s);
}
__device__ __forceinline__ void pool_phase(const bf16_t* __restrict__ XG, const float* __restrict__ SSQ, bf16_t* __restrict__ DIFF, float* lds_f) {
    const int tid = tid_opaque(), wid = tid >> 6, lane = tid & 63, g = wid & 3;
    for (int unit = blockIdx.x; unit < MT / 16; unit += gridDim.x) {
        const int r0 = unit * 16;
        if (tid < 32) { int r = r0 - 8 + tid; r = r < 0 ? 0 : (r > MT - 1 ? MT - 1 : r);
            const f32x4 p0 = *(const f32x4*)(SSQ + (size_t)r * 16), p1 = *(const f32x4*)(SSQ + (size_t)r * 16 + 4), p2 = *(const f32x4*)(SSQ + (size_t)r * 16 + 8), p3 = *(const f32x4*)(SSQ + (size_t)r * 16 + 12);
            const float s = (((p0[0] + p0[1]) + (p0[2] + p0[3])) + ((p1[0] + p1[1]) + (p1[2] + p1[3]))) + (((p2[0] + p2[1]) + (p2[2] + p2[3])) + ((p3[0] + p3[1]) + (p3[2] + p3[3])));
            lds_f[tid] = __builtin_amdgcn_rsqf(s * (1.0f / 1024.0f) + 1e-6f); }
        __syncthreads();
#pragma unroll 1
        for (int pass = 0; pass < 4; ++pass) {
            const int lr = (wid >> 2) * 2 + (lane >> 5) + 4 * pass, row = r0 + lr, c = g * 256 + (lane & 31) * 8;
            int t, T; if (row < NP) { t = row & (SEQP - 1); T = SEQP; } else { t = (row - NP) & (SEQS - 1); T = SEQS; }
            const bf16_t* hp = XG + (size_t)row * DM + c; bf16_t* dp = DIFF + (size_t)row * DM + c; const float* rl = lds_f + lr + 8;
            if (g == 0) pool_item<1>(hp, rl, t, T, dp); else if (g == 1) pool_item<2>(hp, rl, t, T, dp); else if (g == 2) pool_item<4>(hp, rl, t, T, dp); else pool_item<8>(hp, rl, t, T, dp);
        }
        __syncthreads();
    }
}

__device__ __forceinline__ void qkprep_phase(const bf16_t* __restrict__ QKV, const float* __restrict__ qnw, const float* __restrict__ knw, const float* __restrict__ cache_k, const float* __restrict__ cache_v,
                                             bf16_t* __restrict__ Q, bf16_t* __restrict__ KP, bf16_t* __restrict__ VP, bf16_t* __restrict__ KS, bf16_t* __restrict__ VS, float* __restrict__ newk, float* __restrict__ newv) {
    const int tidq = tid_opaque(); const int lane = tidq & 63, wid = tidq >> 6;
    const int half = lane >> 5, i = lane & 31;
    const int d1 = half * 64 + i, d2 = d1 + 32;
    const float qw1 = qnw[d1], qw2 = qnw[d2], kw1 = knw[d1], kw2 = knw[d2];
    const float inv_freq = __builtin_amdgcn_exp2f(-(float)(2 * i) * (13.287712379549449f / 64.0f));
    for (int row = blockIdx.x * 8 + wid; row < MT; row += gridDim.x * 8) {
        const bf16_t* qp = QKV + (size_t)row * NQKV;
        float x1[10], x2[10], vv[2][2];
#pragma unroll
        for (int h = 0; h < 10; ++h) { x1[h] = bf2f(qp[h * 128 + d1]); x2[h] = bf2f(qp[h * 128 + d2]); }
#pragma unroll
        for (int h = 0; h < 2; ++h) { const unsigned t2 = *(const unsigned*)(qp + 1280 + h * 128 + lane * 2); vv[h][0] = bflo(t2); vv[h][1] = bfhi(t2); }
        float cs = 1.f, sn = 0.f; int b, t;
        const bool smp = row >= NP;
        if (smp) { b = (row - NP) >> 12; t = (row - NP) & (SEQS - 1); const float pos = (float)(half == 0 ? (t >> 6) : (t & 63)); const float ang = pos * inv_freq;
            const float nrev = rintf(ang * 0.15915494309189535f); float rr = fmaf(nrev, -6.28318548202514648f, ang); rr = fmaf(nrev, 1.74845553146951715e-07f, rr); sn = __sinf(rr); cs = __cosf(rr); }
        else { b = row >> 8; t = row & (SEQP - 1); }
        float ss[10];
#pragma unroll
        for (int h = 0; h < 10; ++h) ss[h] = x1[h] * x1[h] + x2[h] * x2[h];
#pragma unroll
        for (int o = 32; o >= 1; o >>= 1) {
#pragma unroll
            for (int h = 0; h < 10; ++h) ss[h] += __shfl_xor(ss[h], o); }
#pragma unroll
        for (int h = 0; h < 10; ++h) {
            const float rstd = 1.0f / sqrtf(ss[h] * (1.0f / 128.0f) + 1e-6f);
            const float a1 = x1[h] * rstd * (h < 8 ? qw1 : kw1), a2 = x2[h] * rstd * (h < 8 ? qw2 : kw2);
            if (!smp && h >= 8) { const size_t o = (((size_t)b * 2 + (h - 8)) * SEQP + t) * 128; newk[o + d1] = a1; newk[o + d2] = a2; }
            const float y1 = a1 * cs - a2 * sn, y2 = a2 * cs + a1 * sn;
            const bf16_t o1 = (bf16_t)(cvt_pk_bf16(y1, 0.f) & 0xffffu), o2 = (bf16_t)(cvt_pk_bf16(y2, 0.f) & 0xffffu);
            if (h < 8) { bf16_t* dst = Q + (size_t)row * DM + h * 128; dst[d1] = o1; dst[d2] = o2; }
            else { bf16_t* dst = smp ? KS + (((size_t)b * 2 + (h - 8)) * SKV_S + PAST + t) * 128 : KP + (((size_t)b * 2 + (h - 8)) * SEQP + t) * 128; dst[d1] = o1; dst[d2] = o2; }
        }
#pragma unroll
        for (int h = 0; h < 2; ++h) {
            if (!smp) { const size_t o = (((size_t)b * 2 + h) * SEQP + t) * 128 + lane * 2; *(float2*)(newv + o) = make_float2(vv[h][0], vv[h][1]); }
            bf16_t* dst = smp ? VS + (((size_t)b * 2 + h) * SKV_S + PAST + t) * 128 : VP + (((size_t)b * 2 + h) * SEQP + t) * 128;
            *(unsigned*)(dst + lane * 2) = cvt_pk_bf16(vv[h][0], vv[h][1]);
        }
    }
    const int ncr = 2 * 2 * PAST;
    for (int r = blockIdx.x * 8 + wid; r < 2 * ncr; r += gridDim.x * 8) {
        const bool isv = r >= ncr; const int rr = isv ? r - ncr : r; const int bh = rr >> 8, p = rr & 255;
        const float* src = (isv ? cache_v : cache_k) + ((size_t)bh * PAST + p) * 128 + lane * 2;
        bf16_t* dst = (isv ? VS : KS) + ((size_t)bh * SKV_S + p) * 128 + lane * 2;
        *(unsigned*)dst = cvt_pk_bf16(src[0], src[1]);
    }
}

__device__ __forceinline__ void attn_phase(const bf16_t* Q, const bf16_t* KP, const bf16_t* VP, const bf16_t* KS, const bf16_t* VS, bf16_t* O, char* lds) {
    for (int u = blockIdx.x; u < 384; u += gridDim.x) {
        if (u < 256) { const int b = u >> 7, h = (u >> 4) & 7, qb = u & 15, kvh = h >> 2;
            const size_t row0 = (size_t)NP + (size_t)b * SEQS + qb * 256;
            const size_t ko = ((size_t)b * 2 + kvh) * SKV_S * 128;
            att::attn_dense_body(Q + row0 * DM + h * 128, KS + ko, VS + ko, O + row0 * DM + h * 128, SKV_S, lds);
        } else { const int v = u - 256, b = v >> 3, h = v & 7, kvh = h >> 2;
            const size_t row0 = (size_t)b * SEQP;
            const size_t ko = ((size_t)b * 2 + kvh) * SEQP * 128;
            att::attn_dense_body(Q + row0 * DM + h * 128, KP + ko, VP + ko, O + row0 * DM + h * 128, SEQP, lds);
        }
    }
}

#define XB_TMO      128
#define XB_XCNT(j)  (256  + 64 * (j))
#define XB_XSUB(j)  (1280 + 64 * (j))
#define XB_XGEN(j)  (2304 + 64 * (j))
#define XB_TOP      3328
#define XB_TOPGEN   3392
#define XCD_BAR_WORDS 3456
#define XB_SPIN_CAP (1u << 18)

__device__ __forceinline__ unsigned xb_ld(unsigned* p)              { return __hip_atomic_load(p, __ATOMIC_RELAXED, __HIP_MEMORY_SCOPE_AGENT); }
__device__ __forceinline__ unsigned xb_add(unsigned* p, unsigned v) { return __hip_atomic_fetch_add(p, v, __ATOMIC_RELAXED, __HIP_MEMORY_SCOPE_AGENT); }
__device__ __forceinline__ unsigned xb_xcc_id() { return (unsigned)__builtin_amdgcn_s_getreg((3 << 11) | 20) & 0xFu; }
#define XB_SPIN(cond, bar) do { unsigned _sp = 0; while (cond) { __builtin_amdgcn_s_sleep(1); \
    if ((++_sp & 255u) == 0u) { if (xb_ld(&(bar)[XB_TMO])) break; if (_sp > XB_SPIN_CAP) { atomicAdd(&(bar)[XB_TMO], 1u); break; } } } } while (0)

struct XcdBarrier {
    unsigned* bar; unsigned x;
    volatile LAS unsigned* st;
};

__device__ __forceinline__ XcdBarrier xcd_barrier_post(unsigned* bar, volatile LAS unsigned* st) {
    XcdBarrier b; b.bar = bar; b.x = xb_xcc_id(); b.st = st;
    if (threadIdx.x == 0) (void)xb_add(&bar[XB_XCNT(b.x)], 1u);
    return b;
}
__device__ __forceinline__ void xcd_barrier_complete(unsigned* bar, unsigned x, unsigned& nloc, unsigned& nx) {
    const unsigned G = gridDim.x * gridDim.y * gridDim.z;
    unsigned sum, cnt, mine, sp = 0u;
    for (;;) {
        sum = 0u; cnt = 0u; mine = 0u;
#pragma unroll
        for (unsigned j = 0; j < 16; ++j) { const unsigned c = xb_ld(&bar[XB_XCNT(j)]); sum += c; cnt += (c > 0u) ? 1u : 0u; mine = (j == x) ? c : mine; }
        if (sum == G) break;
        __builtin_amdgcn_s_sleep(1);
        if ((++sp & 255u) == 0u) { if (xb_ld(&bar[XB_TMO])) break; if (sp > XB_SPIN_CAP) { atomicAdd(&bar[XB_TMO], 1u); break; } }
    }
    nloc = mine > 0u ? mine : 1u; nx = cnt > 0u ? cnt : 1u;
}

__device__ __forceinline__ void xcd_barrier(const XcdBarrier& b) {
    asm volatile("s_waitcnt vmcnt(0)" ::: "memory");
    __syncthreads();
    if (threadIdx.x == 0) {
        unsigned* bar = b.bar;
        __builtin_amdgcn_s_waitcnt(0);
        unsigned nloc = b.st[0], nx = b.st[1];
        if (nloc == 0u) { xcd_barrier_complete(bar, b.x, nloc, nx); b.st[0] = nloc; b.st[1] = nx; }
        const unsigned old = xb_add(&bar[XB_XSUB(b.x)], 1u);
        const unsigned gen = old / nloc;
        if (old + 1u == (gen + 1u) * nloc) {
            __builtin_amdgcn_fence(__ATOMIC_RELEASE, "agent");
            asm volatile("s_waitcnt vmcnt(0)" ::: "memory");
            const unsigned og = xb_add(&bar[XB_TOP], 1u);
            const unsigned tg = og / nx;
            if (og + 1u == (tg + 1u) * nx) xb_add(&bar[XB_TOPGEN], 1u);
            else XB_SPIN(xb_ld(&bar[XB_TOPGEN]) == tg, bar);
            __builtin_amdgcn_fence(__ATOMIC_ACQUIRE, "agent");
            xb_add(&bar[XB_XGEN(b.x)], 1u);
            asm volatile("s_waitcnt vmcnt(0)" ::: "memory");
        } else {
            XB_SPIN(xb_ld(&bar[XB_XGEN(b.x)]) == gen, bar);
            __builtin_amdgcn_fence(__ATOMIC_ACQUIRE, "agent");
            asm volatile("s_waitcnt vmcnt(0)" ::: "memory");
        }
    }
    __syncthreads();
}


constexpr int NPH = 2 + 8 * 4 + 1;

typedef const __attribute__((address_space(4))) Params* KPtr;
__device__ __forceinline__ KPtr kargs() { KPtr q = (KPtr)__builtin_amdgcn_kernarg_segment_ptr(); asm volatile("" : "+s"(q)); return q; }
#define WSP(T, off) ((T*)(q->ws + (off)))

__global__ void __launch_bounds__(NTHREADS, 2) fwd_megakernel(Params p) {
    extern __shared__ __attribute__((aligned(16))) unsigned char lds_raw[];
    LAS unsigned char* lds = (LAS unsigned char*)lds_raw;
    cg::grid_group grid = cg::this_grid();
    const int ph_lo = p.ph_lo, ph_hi = p.ph_hi;
    int ph = 0; bool need_sync = false;
    if (ph_lo < 0) grid.sync();
    volatile LAS unsigned* bst = (volatile LAS unsigned*)(lds + 131072 + 2048);
    if (threadIdx.x < 4) bst[threadIdx.x] = 0u;
    __syncthreads();
    XcdBarrier bar; bar.bar = (unsigned*)(p.ws + WS_BAR); bar.x = 0; bar.st = bst;
    if (ph_hi - ph_lo > 1) bar = xcd_barrier_post((unsigned*)(p.ws + WS_BAR), bst);
    if (threadIdx.x == 0) { bst[3] = blockIdx.x; if (ph_hi - ph_lo > 1) bst[2] = xb_add(&((unsigned*)(p.ws + WS_BAR))[3460 + 64 * bar.x], 1u); }
    __syncthreads();
#define PHASE_BEGIN_R(R) if (ph >= ph_lo && ph < ph_hi) { _Pragma("unroll 1") for (int rep_ = 0; rep_ < (R); ++rep_) { if (need_sync) xcd_barrier(bar); need_sync = true; KPtr q = kargs();
#define PHASE_BEGIN PHASE_BEGIN_R(1)
#define PHASE_END } } ++ph;

    PHASE_BEGIN_R(REP_PREP)
    {
        int uoff = 0; float* lf = (float*)lds_raw;
        adaln_units(q->in[4], q->in[5], q->in[8], q->in[9], WSP(float, WS_MOD), lf, uoff, 0, blockIdx.x, gridDim.x);
        cvt_matrix(q->in[10], 1024, 3072, WSP(bf16_t, WS_CIN), 1, uoff, lf, blockIdx.x, gridDim.x);
        cvt_matrix(q->in[12], 1024, 1024, WSP(bf16_t, WS_COUT), 0, uoff, lf, blockIdx.x, gridDim.x);
        cvt_matrix(q->in[19], 1024, 5632, WSP(bf16_t, WS_FIN), 2, uoff, lf, blockIdx.x, gridDim.x);
        cvt_matrix(q->in[20], 2816, 1024, WSP(bf16_t, WS_FOUT), 0, uoff, lf, blockIdx.x, gridDim.x);
    }
    PHASE_END
    PHASE_BEGIN_R(REP_NORM)
    {
        if (threadIdx.x == 0 && ph_hi - ph_lo > 1) {
            unsigned* bw = (unsigned*)(q->ws + WS_BAR); const unsigned per = gridDim.x >> 3; bool ok = (gridDim.x & 7u) == 0u && bar.x < 8u;
            for (unsigned jx = 0; jx < 8; ++jx) ok = ok && (xb_ld(&bw[3460 + 64 * jx]) == per);
            if (ok) bst[3] = bst[2] * 8u + bar.x;
        }
        const float* MOD = WSP(float, WS_MOD); float* SW = WSP(float, WS_SW);
        norm0_phase(q->in[0], q->in[1], q->in[6], MOD + 1 * 1024, WSP(bf16_t, WS_H), WSP(float, WS_SSQ), WSP(bf16_t, WS_X));
        const int w0 = blockIdx.x * 8 + (tid_opaque() >> 6), nw = gridDim.x * 8;
        sw_rows(WSP(bf16_t, WS_CIN), 3072, MOD + 0 * 1024, SW + 0, w0, nw);
        sw_rows(WSP(bf16_t, WS_FIN), 5632, MOD + 3 * 1024, SW + 7680, w0, nw);
    }
    PHASE_END

#pragma unroll 1
    for (int hl = 0; hl < 8; ++hl) {
        const int layer = hl >> 1, part = hl & 1, kind = layer % 3, j = layer / 3;
        if (part == 1) {
            PHASE_BEGIN_R(REP_FIN)
            pg8::Gemm g{WSP(bf16_t, WS_H), WSP(bf16_t, WS_FIN) + (size_t)layer * 5632 * 1024, MT, 5632, 1024, 1024, 0}; pg8::StaticOrder S; S.init(g.M, g.N, gridDim.x, (int)__builtin_amdgcn_readfirstlane(bst[3]), 64 * MF_FIN);
            pg8::gemm_phase<MF_FIN>(lds, g, S, pg8::EpiSwiglu<MF_FIN>{WSP(bf16_t, WS_ACT), WSP(float, WS_SSQ), WSP(float, WS_SW) + 7680 + layer * 5632});
            {
                const int nlast = (MT / (64 * MF_FIN)) * 22 % (int)gridDim.x;
                const int vc = (int)__builtin_amdgcn_readfirstlane(bst[3]);
                if (layer < 3 && nlast > 0 && vc >= nlast) {
                    KPtr q2 = kargs(); int uoff = 0; float* lf = (float*)lds_raw; const int wk = vc - nlast, nwk = gridDim.x - nlast, ln = layer + 1;
                    adaln_units(q2->in[4], q2->in[5], q2->in[8], q2->in[9], (float*)(q2->ws + WS_MOD), lf, uoff, ln, wk, nwk);
                    if (ln == 1) {
#pragma unroll 1
                        for (int gq = 0; gq < 4; ++gq) cvt_matrix(q2->in[13] + (size_t)gq * 65536, 256, 256, (bf16_t*)(q2->ws + WS_POOL) + (size_t)gq * 65536, 0, uoff, lf, wk, nwk);
                    } else if (ln == 2) {
                        cvt_matrix(q2->in[15], 1024, 1536, (bf16_t*)(q2->ws + WS_QKVW), 0, uoff, lf, wk, nwk);
                        cvt_matrix(q2->in[18], 1024, 1024, (bf16_t*)(q2->ws + WS_AOUT), 0, uoff, lf, wk, nwk);
                    } else {
                        cvt_matrix(q2->in[10] + (size_t)1024 * 3072, 1024, 3072, (bf16_t*)(q2->ws + WS_CIN) + (size_t)3072 * 1024, 1, uoff, lf, wk, nwk);
                        cvt_matrix(q2->in[12] + (size_t)1024 * 1024, 1024, 1024, (bf16_t*)(q2->ws + WS_COUT) + (size_t)1024 * 1024, 0, uoff, lf, wk, nwk);
                    }
                    cvt_matrix(q2->in[19] + (size_t)ln * 1024 * 5632, 1024, 5632, (bf16_t*)(q2->ws + WS_FIN) + (size_t)ln * 5632 * 1024, 2, uoff, lf, wk, nwk);
                    cvt_matrix(q2->in[20] + (size_t)ln * 2816 * 1024, 2816, 1024, (bf16_t*)(q2->ws + WS_FOUT) + (size_t)ln * 1024 * 2816, 0, uoff, lf, wk, nwk);
                }
            }
            PHASE_END
        } else if (kind == 0) {
            PHASE_BEGIN_R(REP_CIN)
            pg8::Gemm g{WSP(bf16_t, WS_H), WSP(bf16_t, WS_CIN) + (size_t)j * 3072 * 1024, MT, 3072, 1024, 1024, 0}; pg8::StaticOrder S; S.init(g.M, g.N, gridDim.x, (int)__builtin_amdgcn_readfirstlane(bst[3]), 64 * MF_CIN);
            pg8::gemm_phase<MF_CIN>(lds, g, S, pg8::EpiConvIn<MF_CIN>{WSP(bf16_t, WS_BB), WSP(bf16_t, WS_Z), WSP(float, WS_SSQ), WSP(float, WS_SW) + j * 3072});
            PHASE_END
        } else if (kind == 1) {
            PHASE_BEGIN_R(REP_EW)
            pool_phase(WSP(bf16_t, WS_H), WSP(float, WS_SSQ), WSP(bf16_t, WS_A2), (float*)lds_raw);
            PHASE_END
        } else {
            PHASE_BEGIN
            pg8::Gemm g{WSP(bf16_t, WS_H), WSP(bf16_t, WS_QKVW), MT, NQKV, 1024, 1024, 0}; pg8::StaticOrder S; S.init(g.M, g.N, gridDim.x, (int)__builtin_amdgcn_readfirstlane(bst[3]), 64 * MF_QKV);
            pg8::gemm_phase<MF_QKV>(lds, g, S, pg8::EpiBf16N<MF_QKV>{WSP(bf16_t, WS_QKV), NQKV, WSP(float, WS_SSQ), WSP(float, WS_SW) + 6144});
            PHASE_END
        }
        if (part == 0 && kind == 0) {
            PHASE_BEGIN_R(REP_EW)
            conv_phase(WSP(bf16_t, WS_BB), WSP(bf16_t, WS_Z), q->in[11] + (size_t)j * 3 * 1024, WSP(bf16_t, WS_A2));
            PHASE_END
        } else if (part == 0 && kind == 2) {
            PHASE_BEGIN_R(REP_EW)
            float* new_k = q->out + (size_t)MT * DM; float* new_v = new_k + 16 * 2 * 256 * 128;
            qkprep_phase(WSP(bf16_t, WS_QKV), q->in[16] + j * 128, q->in[17] + j * 128, q->in[2], q->in[3], WSP(bf16_t, WS_Q), WSP(bf16_t, WS_KP), WSP(bf16_t, WS_VP), WSP(bf16_t, WS_KS), WSP(bf16_t, WS_VS), new_k, new_v);
            PHASE_END
        } else { ++ph; }
        if (part == 0 && kind == 2) {
            PHASE_BEGIN_R(REP_ATT)
            attn_phase(WSP(bf16_t, WS_Q), WSP(bf16_t, WS_KP), WSP(bf16_t, WS_VP), WSP(bf16_t, WS_KS), WSP(bf16_t, WS_VS), WSP(bf16_t, WS_A2), (char*)lds_raw);
            PHASE_END
        } else { ++ph; }
        PHASE_BEGIN_R(part ? REP_FOUT : REP_MIXOUT)
        {
            const float* MOD = WSP(float, WS_MOD);
            const float* modl = MOD + (size_t)layer * 3 * 6144;
            pg8::Gemm g; const float* cs = nullptr;
            if (part == 1) g = pg8::Gemm{WSP(bf16_t, WS_ACT), WSP(bf16_t, WS_FOUT) + (size_t)layer * 1024 * 2816, MT, 1024, DFF, DFF, 0};
            else if (kind == 0) g = pg8::Gemm{WSP(bf16_t, WS_A2), WSP(bf16_t, WS_COUT) + (size_t)j * 1024 * 1024, MT, 1024, 1024, 1024, 0};
            else if (kind == 1) { g = pg8::Gemm{WSP(bf16_t, WS_A2), WSP(bf16_t, WS_POOL), MT, 1024, 256, 1024, 256}; cs = q->in[14] + j * 1024; }
            else g = pg8::Gemm{WSP(bf16_t, WS_A2), WSP(bf16_t, WS_AOUT), MT, 1024, 1024, 1024, 0};
            pg8::StaticOrder S; S.init(g.M, g.N, gridDim.x, (int)__builtin_amdgcn_readfirstlane(bst[3]), 64 * MF_RES);
            const float* nw = part == 0 ? q->in[7] + layer * 1024 : q->in[6] + (layer + 1) * 1024;
            const float* nsc = part == 0 ? modl + 4 * 1024 : modl + 3 * 6144 + 1 * 1024;
            bf16_t* xg = hl == 7 ? nullptr : WSP(bf16_t, WS_H);
            bf16_t* xo = rep_ + 1 < (part ? REP_FOUT : REP_MIXOUT) ? WSP(bf16_t, WS_X2) : WSP(bf16_t, WS_X);
            pg8::gemm_phase<MF_RES>(lds, g, S, pg8::EpiResid<MF_RES>{WSP(bf16_t, WS_X), xo, modl + (part ? 5 : 2) * 1024, cs, xg, WSP(float, WS_SSQ), nw, nsc});
            if (part == 1 && layer < 3) {
                const int ln = layer + 1; float* SW = WSP(float, WS_SW); const float* modn = MOD + (size_t)ln * 3 * 6144;
                const int w0 = blockIdx.x * 8 + (tid_opaque() >> 6), nwv = gridDim.x * 8;
                if (ln == 2) sw_rows(WSP(bf16_t, WS_QKVW), 1536, modn, SW + 6144, w0, nwv);
                else if (ln == 3) sw_rows(WSP(bf16_t, WS_CIN) + (size_t)3072 * 1024, 3072, modn, SW + 3072, w0, nwv);
                sw_rows(WSP(bf16_t, WS_FIN) + (size_t)ln * 5632 * 1024, 5632, modn + 3 * 1024, SW + 7680 + ln * 5632, w0, nwv);
            }
        }
        PHASE_END
    }
    PHASE_BEGIN_R(REP_NORM)
    final_norm_phase(WSP(bf16_t, WS_X), WSP(float, WS_SSQ), q->in[21], q->out);
    PHASE_END
#ifdef EXTRA_SYNCS
    if (ph_hi - ph_lo > 1) { for (int i_ = 0; i_ < EXTRA_SYNCS; ++i_) xcd_barrier(bar); }
#endif
#undef PHASE_BEGIN
#undef PHASE_END
}

extern "C" void kernel_launch(void* const* d_in, const int* in_sizes, int n_in, void* d_out, int out_size, void* d_ws, size_t ws_size, hipStream_t stream) {
    static int grid = 0;
    if (grid == 0) {
        if (n_in != 22 || ws_size < WS_END) { fprintf(stderr, "kernel_launch: unexpected n_in %d / ws %zu (need %zu)\n", n_in, ws_size, (size_t)WS_END); grid = -1; return; }
        int dev = 0, cus = 0, per_cu = 0;
        hipGetDevice(&dev);
        hipDeviceGetAttribute(&cus, hipDeviceAttributeMultiprocessorCount, dev);
        if (hipFuncSetAttribute((const void*)fwd_megakernel, hipFuncAttributeMaxDynamicSharedMemorySize, LDS_BYTES) != hipSuccess) { fprintf(stderr, "kernel_launch: hipFuncSetAttribute failed\n"); grid = -1; return; }
        if (hipOccupancyMaxActiveBlocksPerMultiprocessor(&per_cu, (const void*)fwd_megakernel, NTHREADS, LDS_BYTES) != hipSuccess || per_cu < 1) { fprintf(stderr, "kernel_launch: occupancy query gave %d\n", per_cu); per_cu = 1; }
        (void)hipGetLastError();
        grid = cus * per_cu;
        fprintf(stderr, "kernel_launch: grid %d (cus %d x %d)\n", grid, cus, per_cu);
    }
    if (grid < 0) return;
    Params p{};
    for (int i = 0; i < 22; ++i) p.in[i] = (const float*)d_in[i];
    p.out = (float*)d_out; p.ws = (unsigned char*)d_ws;
#if MK_MULTI
    for (int ph = 0; ph < NPH; ++ph) {
        p.ph_lo = ph; p.ph_hi = ph + 1;
        hipLaunchKernelGGL(fwd_megakernel, dim3(grid), dim3(NTHREADS), LDS_BYTES, stream, p);
    }
#else
    p.ph_lo = 0; p.ph_hi = NPH;
    (void)hipMemsetAsync((char*)d_ws + WS_BAR, 0, 16384, stream);
    void* args[] = {&p};
    hipError_t e = hipLaunchCooperativeKernel((const void*)fwd_megakernel, dim3(grid), dim3(NTHREADS), args, LDS_BYTES, stream);
    if (e != hipSuccess) fprintf(stderr, "kernel_launch: cooperative launch failed: %s (grid %d)\n", hipGetErrorString(e), grid);
#endif
}
```

```cpp
#include <hip/hip_runtime.h>
#include <hip/hip_cooperative_groups.h>
#include <cstdio>
#include <cstdint>
namespace cg = cooperative_groups;

#ifndef MK_MULTI
#define MK_MULTI 0
#endif

#ifndef REP_PREP
#define REP_PREP 1
#endif
#ifndef REP_NORM
#define REP_NORM 1
#endif
#ifndef REP_FIN
#define REP_FIN 1
#endif
#ifndef REP_FOUT
#define REP_FOUT 1
#endif
#ifndef REP_CIN
#define REP_CIN 1
#endif
#ifndef REP_ATT
#define REP_ATT 1
#endif
#ifndef REP_EW
#define REP_EW 1
#endif
#ifndef REP_MIXOUT
#define REP_MIXOUT 1
#endif
#ifndef MF_FIN
#define MF_FIN 4
#endif
#ifndef MF_CIN
#define MF_CIN 3
#endif
#ifndef MF_QKV
#define MF_QKV 3
#endif
#ifndef MF_RES
#define MF_RES 3
#endif
#define LAS __attribute__((address_space(3)))
typedef unsigned short bf16_t;
typedef short bf16x8 __attribute__((ext_vector_type(8)));
typedef short s16x4 __attribute__((ext_vector_type(4)));
typedef float f32x4 __attribute__((ext_vector_type(4)));
typedef float f32x16 __attribute__((ext_vector_type(16)));
typedef unsigned u32x4 __attribute__((ext_vector_type(4)));
typedef unsigned u32x2 __attribute__((ext_vector_type(2)));

constexpr int DM = 1024, NP = 4096  , NS = 8192  , MT = NP + NS;
constexpr int SEQP = 256, SEQS = 4096, PAST = 256, SKV_S = PAST + SEQS;
constexpr int DFF = 2816, NMOD = 6, NQKV = 1536;
constexpr int NTHREADS = 512;
constexpr int NSW = 2 * 3072 + 1536 + 4 * 5632;
constexpr int LDS_BYTES = 132 * 1024;

constexpr size_t AL(size_t x) { return (x + 255) / 256 * 256; }
constexpr size_t WS_MOD   = 0;
constexpr size_t WS_CIN   = AL(WS_MOD + 4ull * 3 * 6 * 1024 * 4);
constexpr size_t WS_COUT  = AL(WS_CIN + 2ull * 3072 * 1024 * 2);
constexpr size_t WS_POOL  = AL(WS_COUT + 2ull * 1024 * 1024 * 2);
constexpr size_t WS_QKVW  = AL(WS_POOL + 4ull * 256 * 256 * 2);
constexpr size_t WS_AOUT  = AL(WS_QKVW + 1536ull * 1024 * 2);
constexpr size_t WS_FIN   = AL(WS_AOUT + 1024ull * 1024 * 2);
constexpr size_t WS_FOUT  = AL(WS_FIN + 4ull * 5632 * 1024 * 2);
constexpr size_t WS_X     = AL(WS_FOUT + 4ull * 1024 * 2816 * 2);
constexpr size_t WS_H     = AL(WS_X + (size_t)MT * 1024 * 4);
constexpr size_t WS_A2    = AL(WS_H + (size_t)MT * 1024 * 2);
constexpr size_t WS_BB    = AL(WS_A2 + (size_t)MT * 1024 * 2);
constexpr size_t WS_Z     = AL(WS_BB + (size_t)MT * 1024 * 2);
constexpr size_t WS_ACT   = AL(WS_Z + (size_t)MT * 1024 * 2);
constexpr size_t WS_QKV   = WS_BB;
constexpr size_t WS_Q     = WS_H;
constexpr size_t WS_KP    = AL(WS_ACT + (size_t)MT * 2816 * 2);
constexpr size_t WS_VP    = AL(WS_KP + 16ull * 2 * 256 * 128 * 2);
constexpr size_t WS_KS    = AL(WS_VP + 16ull * 2 * 256 * 128 * 2);
constexpr size_t WS_VS    = AL(WS_KS + 2ull * 2 * SKV_S * 128 * 2);
constexpr size_t WS_SSQ   = AL(WS_VS + 2ull * 2 * SKV_S * 128 * 2);
constexpr size_t WS_SW    = AL(WS_SSQ + (size_t)MT * 16 * 4);
constexpr size_t WS_BAR   = AL(WS_SW + 3ull * 30208 * 4);
constexpr size_t WS_X2    = AL(WS_BAR + 16384);
constexpr size_t WS_END   = AL(WS_X2 + (size_t)MT * 1024 * 4);

struct Params {
    const float* in[22];
    float* out;
    unsigned char* ws;
    int ph_lo, ph_hi;
};

__device__ __forceinline__ unsigned cvt_pk_bf16(float lo, float hi) { unsigned r; asm volatile("v_cvt_pk_bf16_f32 %0, %1, %2" : "=v"(r) : "v"(lo), "v"(hi)); return r; }
__device__ __forceinline__ float bf2f(unsigned short b) { return __uint_as_float(((unsigned)b) << 16); }
__device__ __forceinline__ float bflo(unsigned w) { return __uint_as_float(w << 16); }
__device__ __forceinline__ float bfhi(unsigned w) { return __uint_as_float(w & 0xffff0000u); }
__device__ __forceinline__ float silu_f(float x) { return x * __builtin_amdgcn_rcpf(1.0f + __builtin_amdgcn_exp2f(-1.4426950408889634f * x)); }
__device__ __forceinline__ int tid_opaque() { int t = threadIdx.x; asm volatile("" : "+v"(t)); return t; }
__device__ __forceinline__ float quad_row_sum(float s) {
    { auto r = __builtin_amdgcn_permlane16_swap(__float_as_uint(s), __float_as_uint(s), false, false); s = __uint_as_float(r[0]) + __uint_as_float(r[1]); }
    { auto r = __builtin_amdgcn_permlane32_swap(__float_as_uint(s), __float_as_uint(s), false, false); s = __uint_as_float(r[0]) + __uint_as_float(r[1]); }
    return s;
}
__device__ __forceinline__ float wave_sum(float v) {
#pragma unroll
    for (int o = 32; o >= 1; o >>= 1) v += __shfl_xor(v, o);
    return v;
}

namespace pg8 {
constexpr int BM = 256, BK = 64, HALF = 128, HTB = HALF * BK * 2, STAGE_BYTES = 8 * HTB, NXCD = 8, WGM = 8;
__host__ __device__ __forceinline__ int lds_byte(int r, int c) { const int st = (r >> 4) * 2 + (c >> 5), rr = r & 15, cc = c & 31, ob = rr * 64 + cc * 2; return st * 1024 + (ob ^ (((ob >> 9) & 1) << 5)); }
__host__ __device__ __forceinline__ void stage_rc(int b, int& R, int& C) { const int st = b / 1024, sb = b % 1024, swz = sb ^ (((sb >> 9) & 1) << 5); R = (st >> 1) * 16 + swz / 64; C = (st & 1) * 32 + (swz % 64) / 2; }
__host__ __device__ __forceinline__ int perm32(int rho) { const int n = rho >> 4, i = rho & 15; return 8 * (i >> 2) + 4 * n + (i & 3); }

struct Unit { int pm, pn; };
struct Gemm { const bf16_t* A; const bf16_t* Bt; int M, N, K, lda, a_pn_off; };

struct StaticOrder {
    int nM, nN, nwg, G, c, wgm;
    __device__ void init(int M, int N, int G_, int c_, int tile_rows) { nM = M / tile_rows; nN = N / BM; nwg = nM * nN; G = G_; c = c_; wgm = (nM % 8 == 0) ? nM / 8 : WGM; }
    __device__ bool next(int i, Unit& u) const {
        const long L = (long)i * G + c; if (L >= nwg) return false;
        int wgid = (int)L; { const int q = nwg / NXCD, r = nwg % NXCD, xcd = wgid % NXCD, off = wgid / NXCD; wgid = (xcd < r ? xcd * (q + 1) : r * (q + 1) + (xcd - r) * q) + off; }
        const int nig = wgm * nN, gid = wgid / nig, fm = gid * wgm, gsz = (nM - fm) < wgm ? (nM - fm) : wgm;
        u.pm = fm + ((wgid % nig) % gsz); u.pn = (wgid % nig) / gsz; return true;
    }
};

template <int MF, class Epi>
__device__ __forceinline__ void gemm_phase(LAS unsigned char* lds, const Gemm g, const StaticOrder& S, const Epi& E) {
    const int tid = tid_opaque(), wid = __builtin_amdgcn_readfirstlane(tid >> 6), lane = tid & 63, wr = wid >> 2, wc = wid & 3, fr = lane & 15, fq = lane >> 4;
    const int K = g.K, nt = K / BK, lda = g.lda;
    unsigned voffA[2], voffB[2];
#pragma unroll
    for (int i = 0; i < 2; ++i) { int R, C; stage_rc(tid * 16 + i * 8192, R, C); const int Rb = Epi::PERM ? ((R & ~31) + perm32(R & 31)) : R;
        voffA[i] = (unsigned)(R * lda + C) * 2u; voffB[i] = (unsigned)(Rb * K + C) * 2u; }
    const size_t kstep = (size_t)(BK * 2);
    const size_t hstepA = (size_t)(32 * MF) * lda * 2, hstepB = (size_t)HALF * K * 2;
    const size_t tstepA = 2 * hstepA, tstepB = 2 * hstepB;
    const size_t pnoffA = (size_t)g.a_pn_off * 2;
    const unsigned ldsw = (unsigned)wid * 1024u;
    const int aoff = lds_byte(wr * 16 * MF + fr, fq * 8), boff = lds_byte(wc * 32 + fr, fq * 8);
#define PG8_SA(b, h) (((b) * 2 + (h)) * HTB)
#define PG8_SB(b, h) ((4 + (b) * 2 + (h)) * HTB)
#define PG8_STAGE(bufoff, gbase, voff) do { _Pragma("unroll") for (int _i = 0; _i < 2; ++_i) \
        __builtin_amdgcn_global_load_lds((const unsigned*)((const char*)(gbase) + (voff)[_i]), (LAS unsigned*)(lds + (bufoff) + ldsw + _i * 8192), 16, 0, 0); } while (0)
#define PG8_LDA(dst, b, h) do { _Pragma("unroll") for (int m = 0; m < MF; ++m) _Pragma("unroll") for (int k = 0; k < 2; ++k) dst[m][k] = *(const LAS bf16x8*)(lds + PG8_SA(b, h) + aoff + m * 2048 + k * 1024); } while (0)
#define PG8_LDB(dst, b, h) do { _Pragma("unroll") for (int n = 0; n < 2; ++n) _Pragma("unroll") for (int k = 0; k < 2; ++k) dst[n][k] = *(const LAS bf16x8*)(lds + PG8_SB(b, h) + boff + n * 2048 + k * 1024); } while (0)
#define PG8_MMA(ai, bj, At, Bt) do { __builtin_amdgcn_s_setprio(1); _Pragma("unroll") for (int m = 0; m < MF; ++m) _Pragma("unroll") for (int n = 0; n < 2; ++n) _Pragma("unroll") for (int k = 0; k < 2; ++k) \
        acc[ai][bj][m][n] = __builtin_amdgcn_mfma_f32_16x16x32_bf16(Bt[n][k], At[m][k], acc[ai][bj][m][n], 0, 0, 0); __builtin_amdgcn_s_setprio(0); } while (0)
#define PG8_WAIT_V(n) asm volatile("s_waitcnt vmcnt(" #n ")" ::: "memory")
#define PG8_WAIT_L(n) asm volatile("s_waitcnt lgkmcnt(" #n ")" ::: "memory")
#define PG8_BAR __builtin_amdgcn_s_barrier()
#define PG8_SCHED __builtin_amdgcn_sched_barrier(0)
    Unit cur, nxt; int ui = 0;
    if (!S.next(0, cur)) return;
    f32x4 acc[2][2][MF][2];
#pragma unroll
    for (int a = 0; a < 2; ++a)
#pragma unroll
        for (int b = 0; b < 2; ++b)
#pragma unroll
            for (int m = 0; m < MF; ++m)
#pragma unroll
                for (int n = 0; n < 2; ++n) acc[a][b][m][n] = (f32x4){0.f, 0.f, 0.f, 0.f};
    bf16x8 At[MF][2], B0[2][2], B1[2][2];
    const char* cA = (const char*)g.A + (size_t)cur.pm * tstepA + (size_t)cur.pn * pnoffA; const char* cB = (const char*)g.Bt + (size_t)cur.pn * tstepB;
    PG8_STAGE(PG8_SB(0, 0), cB, voffB); PG8_STAGE(PG8_SA(0, 0), cA, voffA); PG8_STAGE(PG8_SB(0, 1), cB + hstepB, voffB); PG8_STAGE(PG8_SA(0, 1), cA + hstepA, voffA);
    if (wr == 1) PG8_BAR;
    PG8_WAIT_V(4); PG8_BAR;
    PG8_STAGE(PG8_SB(1, 0), cB + kstep, voffB); PG8_STAGE(PG8_SA(1, 0), cA + kstep, voffA); PG8_STAGE(PG8_SB(1, 1), cB + hstepB + kstep, voffB);
    PG8_WAIT_V(6); PG8_BAR;
    for (;;) {
        const bool has_next = S.next(ui + 1, nxt);
        const char* nA = has_next ? (const char*)g.A + (size_t)nxt.pm * tstepA + (size_t)nxt.pn * pnoffA : cA; const char* nB = has_next ? (const char*)g.Bt + (size_t)nxt.pn * tstepB : cB;
        for (int t = 0; t < nt; t += 2) {
            const bool last = (t == nt - 2);
            const char* a1 = cA + (size_t)(t + 1) * kstep;
            const char* a2 = last ? nA : cA + (size_t)(t + 2) * kstep; const char* b2 = last ? nB : cB + (size_t)(t + 2) * kstep;
            const char* a3 = a2 + kstep; const char* b3 = b2 + kstep;
            PG8_LDB(B0, 0, 0); PG8_SCHED; PG8_LDA(At, 0, 0); PG8_STAGE(PG8_SA(1, 1), a1 + hstepA, voffA);
            PG8_WAIT_L(8); PG8_BAR; PG8_WAIT_L(0); PG8_MMA(0, 0, At, B0); PG8_BAR; PG8_SCHED;
            PG8_LDB(B1, 0, 1); PG8_STAGE(PG8_SB(0, 0), b2, voffB);
            PG8_BAR; PG8_WAIT_L(0); PG8_MMA(0, 1, At, B1); PG8_BAR;
            PG8_LDA(At, 0, 1); PG8_STAGE(PG8_SA(0, 0), a2, voffA);
            PG8_BAR; PG8_WAIT_L(0); PG8_MMA(1, 0, At, B0); PG8_BAR; PG8_SCHED;
            PG8_STAGE(PG8_SB(0, 1), b2 + hstepB, voffB);
            PG8_WAIT_V(6); PG8_BAR; PG8_MMA(1, 1, At, B1); PG8_BAR;
            PG8_LDB(B0, 1, 0); PG8_SCHED; PG8_LDA(At, 1, 0); PG8_STAGE(PG8_SA(0, 1), a2 + hstepA, voffA);
            PG8_WAIT_L(8); PG8_BAR; PG8_WAIT_L(0); PG8_MMA(0, 0, At, B0); PG8_BAR; PG8_SCHED;
            PG8_LDB(B1, 1, 1); PG8_STAGE(PG8_SB(1, 0), b3, voffB);
            PG8_BAR; PG8_WAIT_L(0); PG8_MMA(0, 1, At, B1); PG8_BAR;
            PG8_LDA(At, 1, 1); PG8_STAGE(PG8_SA(1, 0), a3, voffA);
            PG8_BAR; PG8_WAIT_L(0); PG8_MMA(1, 0, At, B0); PG8_BAR; PG8_SCHED;
            PG8_STAGE(PG8_SB(1, 1), b3 + hstepB, voffB);
            PG8_WAIT_V(6); PG8_BAR; PG8_MMA(1, 1, At, B1); PG8_BAR;
        }
        E(acc, cur, wr, wc, fr, fq);
        if (!has_next) break;
#pragma unroll
        for (int a = 0; a < 2; ++a)
#pragma unroll
            for (int b = 0; b < 2; ++b)
#pragma unroll
                for (int m = 0; m < MF; ++m)
#pragma unroll
                    for (int n = 0; n < 2; ++n) acc[a][b][m][n] = (f32x4){0.f, 0.f, 0.f, 0.f};
        cur = nxt; cA = nA; cB = nB; ++ui;
    }
    PG8_WAIT_V(0);
    if (wr == 0) PG8_BAR;
    PG8_BAR;
#undef PG8_SA
#undef PG8_SB
#undef PG8_STAGE
#undef PG8_LDA
#undef PG8_LDB
#undef PG8_MMA
#undef PG8_WAIT_V
#undef PG8_WAIT_L
#undef PG8_BAR
#undef PG8_SCHED
}

__device__ __forceinline__ int grp_of_row(int row) { return row < NP ? 0 : (row < NP + SEQS ? 1 : 2); }
__device__ __forceinline__ float row_rstd1(const float* ssq, int row, int fq) {
    const f32x4 p = *(const f32x4*)(ssq + (size_t)row * 16 + fq * 4);
    float s = (p[0] + p[1]) + (p[2] + p[3]);
    s = quad_row_sum(s);
    return __builtin_amdgcn_rsqf(s * (1.0f / 1024.0f) + 1e-6f);
}

template <int MF> __device__ __forceinline__ void rows_rstd(const float* ssq, int row0, int fq, float (&rs)[2][MF]) {
    f32x4 p[2][MF];
#pragma unroll
    for (int ai = 0; ai < 2; ++ai)
#pragma unroll
        for (int m = 0; m < MF; ++m) p[ai][m] = *(const f32x4*)(ssq + (size_t)(row0 + ai * (32 * MF) + m * 16) * 16 + fq * 4);
#pragma unroll
    for (int ai = 0; ai < 2; ++ai)
#pragma unroll
        for (int m = 0; m < MF; ++m) { float t = (p[ai][m][0] + p[ai][m][1]) + (p[ai][m][2] + p[ai][m][3]); t = quad_row_sum(t); rs[ai][m] = __builtin_amdgcn_rsqf(t * (1.0f / 1024.0f) + 1e-6f); }
}
template <int MF> struct EpiBf16N {
    static constexpr bool PERM = true;
    bf16_t* C; int ldc; const float* ssq; const float* sw;
    __device__ __forceinline__ void operator()(const f32x4 (&acc)[2][2][MF][2], const Unit& u, int wr, int wc, int fr, int fq) const {
        const int row0 = u.pm * (64 * MF) + wr * (16 * MF) + fr, col0 = u.pn * BM + wc * 32 + 8 * fq;
        f32x4 sv[2][2]; int curg = grp_of_row(row0);
        { const float* swp = sw + curg * NSW + col0;
#pragma unroll
          for (int bj = 0; bj < 2; ++bj) { sv[bj][0] = *(const f32x4*)(swp + bj * HALF); sv[bj][1] = *(const f32x4*)(swp + bj * HALF + 4); } }
        float rsv[2][MF]; rows_rstd<MF>(ssq, row0, fq, rsv);
#pragma unroll
        for (int ai = 0; ai < 2; ++ai)
#pragma unroll
            for (int m = 0; m < MF; ++m) { const int row = row0 + ai * (32 * MF) + m * 16; bf16_t* rowp = C + (size_t)row * ldc + col0;
                const float rs = rsv[ai][m]; const int grp = grp_of_row(row);
                if (grp != curg) { curg = grp; const float* swp = sw + grp * NSW + col0;
#pragma unroll
                    for (int bj = 0; bj < 2; ++bj) { sv[bj][0] = *(const f32x4*)(swp + bj * HALF); sv[bj][1] = *(const f32x4*)(swp + bj * HALF + 4); } }
#pragma unroll
                for (int bj = 0; bj < 2; ++bj) { const f32x4 v0 = acc[ai][bj][m][0] * rs + sv[bj][0], v1 = acc[ai][bj][m][1] * rs + sv[bj][1];
                    u32x4 w; w.x = cvt_pk_bf16(v0[0], v0[1]); w.y = cvt_pk_bf16(v0[2], v0[3]); w.z = cvt_pk_bf16(v1[0], v1[1]); w.w = cvt_pk_bf16(v1[2], v1[3]);
                    *(u32x4*)(rowp + bj * HALF) = w; } }
    }
};
template <int MF> struct EpiResid {
    static constexpr bool PERM = true;
    const bf16_t* base; bf16_t* out; const float* gate; const float* cscale;
    bf16_t* xg; float* ssq; const float* nw; const float* nscale;
    __device__ __forceinline__ void operator()(const f32x4 (&acc)[2][2][MF][2], const Unit& u, int wr, int wc, int fr, int fq) const {
        const int row0 = u.pm * (64 * MF) + wr * (16 * MF) + fr, col0 = u.pn * BM + wc * 32 + 8 * fq;
        f32x4 gvh[2][2], gnh[2][2]; int curg = grp_of_row(row0);
        { const float* gp = gate + curg * (NMOD * DM) + col0; const float* np_ = nscale + curg * (NMOD * DM) + col0;
#pragma unroll
          for (int bj = 0; bj < 2; ++bj)
#pragma unroll
            for (int n = 0; n < 2; ++n) { gvh[bj][n] = *(const f32x4*)(gp + bj * HALF + n * 4); if (cscale) gvh[bj][n] *= *(const f32x4*)(cscale + col0 + bj * HALF + n * 4);
                gnh[bj][n] = xg ? *(const f32x4*)(nw + col0 + bj * HALF + n * 4) * (1.0f + *(const f32x4*)(np_ + bj * HALF + n * 4)) : (f32x4){0.f, 0.f, 0.f, 0.f}; } }
        u32x4 xb[2][MF][2];
#pragma unroll
        for (int ai = 0; ai < 2; ++ai)
#pragma unroll
            for (int m = 0; m < MF; ++m)
#pragma unroll
                for (int bj = 0; bj < 2; ++bj) xb[ai][m][bj] = *(const u32x4*)(base + (size_t)(row0 + ai * (32 * MF) + m * 16) * DM + col0 + bj * HALF);
        asm volatile("" ::: "memory");
#pragma unroll
        for (int ai = 0; ai < 2; ++ai)
#pragma unroll
            for (int m = 0; m < MF; ++m) { const int row = row0 + ai * (32 * MF) + m * 16; const int grp = grp_of_row(row);
                bf16_t* op = out + (size_t)row * DM + col0;
                if (grp != curg) { curg = grp;
                    const float* gp = gate + grp * (NMOD * DM) + col0; const float* np_ = nscale + grp * (NMOD * DM) + col0;
#pragma unroll
                    for (int bj = 0; bj < 2; ++bj)
#pragma unroll
                        for (int n = 0; n < 2; ++n) { gvh[bj][n] = *(const f32x4*)(gp + bj * HALF + n * 4); if (cscale) gvh[bj][n] *= *(const f32x4*)(cscale + col0 + bj * HALF + n * 4);
                            gnh[bj][n] = xg ? *(const f32x4*)(nw + col0 + bj * HALF + n * 4) * (1.0f + *(const f32x4*)(np_ + bj * HALF + n * 4)) : (f32x4){0.f, 0.f, 0.f, 0.f}; } }
                float s = 0.f;
#pragma unroll
                for (int bj = 0; bj < 2; ++bj) { f32x4 h[2], x[2];
                    const u32x4 bw = xb[ai][m][bj];
                    const f32x4 b0 = {bflo(bw.x), bfhi(bw.x), bflo(bw.y), bfhi(bw.y)}, b1 = {bflo(bw.z), bfhi(bw.z), bflo(bw.w), bfhi(bw.w)};
#pragma unroll
                    for (int n = 0; n < 2; ++n) {
                        x[n] = (n == 0 ? b0 : b1) + gvh[bj][n] * acc[ai][bj][m][n];
                        s += (x[n][0] * x[n][0] + x[n][1] * x[n][1]) + (x[n][2] * x[n][2] + x[n][3] * x[n][3]);
                        if (xg) h[n] = x[n] * gnh[bj][n]; }
                    { u32x4 w; w.x = cvt_pk_bf16(x[0][0], x[0][1]); w.y = cvt_pk_bf16(x[0][2], x[0][3]); w.z = cvt_pk_bf16(x[1][0], x[1][1]); w.w = cvt_pk_bf16(x[1][2], x[1][3]);
                      *(u32x4*)(op + bj * HALF) = w; }
                    if (xg) { u32x4 w; w.x = cvt_pk_bf16(h[0][0], h[0][1]); w.y = cvt_pk_bf16(h[0][2], h[0][3]); w.z = cvt_pk_bf16(h[1][0], h[1][1]); w.w = cvt_pk_bf16(h[1][2], h[1][3]);
                        *(u32x4*)(xg + (size_t)row * DM + col0 + bj * HALF) = w; } }
                s = quad_row_sum(s);
                if (fq == 0) ssq[(size_t)row * 16 + u.pn * 4 + wc] = s; }
    }
};
template <int MF> struct EpiConvIn {
    static constexpr bool PERM = true;
    bf16_t* Bb; bf16_t* Z; const float* ssq; const float* sw;
    __device__ __forceinline__ void operator()(const f32x4 (&acc)[2][2][MF][2], const Unit& u, int wr, int wc, int fr, int fq) const {
        const int row0 = u.pm * (64 * MF) + wr * (16 * MF) + fr;
        const int swc = u.pn * BM + wc * 32 + 8 * fq;
        f32x4 sv[2][2]; int curg = grp_of_row(row0);
        { const float* swp = sw + curg * NSW + swc;
#pragma unroll
          for (int bj = 0; bj < 2; ++bj) { sv[bj][0] = *(const f32x4*)(swp + bj * HALF); sv[bj][1] = *(const f32x4*)(swp + bj * HALF + 4); } }
        float rsv[2][MF]; rows_rstd<MF>(ssq, row0, fq, rsv);
        if (u.pn < 4) {
            const int col0 = u.pn * BM + wc * 32 + 8 * fq;
#pragma unroll
            for (int ai = 0; ai < 2; ++ai)
#pragma unroll
                for (int m = 0; m < MF; ++m) { const int row = row0 + ai * (32 * MF) + m * 16; bf16_t* rowp = Bb + (size_t)row * DM + col0;
                    const float rs = rsv[ai][m]; const int grp = grp_of_row(row);
                    if (grp != curg) { curg = grp; const float* swp = sw + grp * NSW + swc;
#pragma unroll
                        for (int bj = 0; bj < 2; ++bj) { sv[bj][0] = *(const f32x4*)(swp + bj * HALF); sv[bj][1] = *(const f32x4*)(swp + bj * HALF + 4); } }
#pragma unroll
                    for (int bj = 0; bj < 2; ++bj) { const f32x4 v0 = acc[ai][bj][m][0] * rs + sv[bj][0], v1 = acc[ai][bj][m][1] * rs + sv[bj][1];
                        u32x4 w; w.x = cvt_pk_bf16(v0[0], v0[1]); w.y = cvt_pk_bf16(v0[2], v0[3]); w.z = cvt_pk_bf16(v1[0], v1[1]); w.w = cvt_pk_bf16(v1[2], v1[3]);
                        *(u32x4*)(rowp + bj * HALF) = w; } }
        } else {
            const int col0 = (u.pn - 4) * HALF + wc * 32 + 8 * fq;
#pragma unroll
            for (int ai = 0; ai < 2; ++ai)
#pragma unroll
                for (int m = 0; m < MF; ++m) { const int row = row0 + ai * (32 * MF) + m * 16; bf16_t* rowp = Z + (size_t)row * DM + col0;
                    const float rs = rsv[ai][m]; const int grp = grp_of_row(row);
                    if (grp != curg) { curg = grp; const float* swp = sw + grp * NSW + swc;
#pragma unroll
                        for (int bj = 0; bj < 2; ++bj) { sv[bj][0] = *(const f32x4*)(swp + bj * HALF); sv[bj][1] = *(const f32x4*)(swp + bj * HALF + 4); } }
                    const f32x4 v0 = (acc[ai][0][m][0] * rs + sv[0][0]) * (acc[ai][1][m][0] * rs + sv[1][0]);
                    const f32x4 v1 = (acc[ai][0][m][1] * rs + sv[0][1]) * (acc[ai][1][m][1] * rs + sv[1][1]);
                    u32x4 w; w.x = cvt_pk_bf16(v0[0], v0[1]); w.y = cvt_pk_bf16(v0[2], v0[3]); w.z = cvt_pk_bf16(v1[0], v1[1]); w.w = cvt_pk_bf16(v1[2], v1[3]);
                    *(u32x4*)rowp = w; }
        }
    }
};
template <int MF> struct EpiSwiglu {
    static constexpr bool PERM = true;
    bf16_t* ACT; const float* ssq; const float* sw;
    __device__ __forceinline__ void operator()(const f32x4 (&acc)[2][2][MF][2], const Unit& u, int wr, int wc, int fr, int fq) const {
        const int row0 = u.pm * (64 * MF) + wr * (16 * MF) + fr, col0 = u.pn * HALF + wc * 32 + 8 * fq;
        const int swc = u.pn * BM + wc * 32 + 8 * fq;
        f32x4 sv[2][2], svn[2]; int curg = grp_of_row(row0);
        { const float* swp = sw + curg * NSW + swc;
#pragma unroll
          for (int bj = 0; bj < 2; ++bj) { sv[bj][0] = *(const f32x4*)(swp + bj * HALF); sv[bj][1] = *(const f32x4*)(swp + bj * HALF + 4); } }
        float rsv[2][MF]; rows_rstd<MF>(ssq, row0, fq, rsv);
        svn[0] = sv[0][0] * -1.4426950408889634f; svn[1] = sv[0][1] * -1.4426950408889634f;
#pragma unroll
        for (int ai = 0; ai < 2; ++ai)
#pragma unroll
            for (int m = 0; m < MF; ++m) { const int row = row0 + ai * (32 * MF) + m * 16; bf16_t* rowp = ACT + (size_t)row * DFF + col0;
                const float rs = rsv[ai][m]; const int grp = grp_of_row(row);
                if (grp != curg) { curg = grp; const float* swp = sw + grp * NSW + swc;
#pragma unroll
                    for (int bj = 0; bj < 2; ++bj) { sv[bj][0] = *(const f32x4*)(swp + bj * HALF); sv[bj][1] = *(const f32x4*)(swp + bj * HALF + 4); }
                    svn[0] = sv[0][0] * -1.4426950408889634f; svn[1] = sv[0][1] * -1.4426950408889634f; }
                const f32x4 sg0 = sv[0][0], sg1 = sv[0][1];
                const f32x4 g0 = acc[ai][0][m][0] * rs + sg0, g1 = acc[ai][0][m][1] * rs + sg1;
                const float rsn = rs * -1.4426950408889634f;
                f32x4 e0 = acc[ai][0][m][0] * rsn + svn[0], e1 = acc[ai][0][m][1] * rsn + svn[1];
                const f32x4 u0 = acc[ai][1][m][0] * rs + sv[1][0], u1 = acc[ai][1][m][1] * rs + sv[1][1];
#pragma unroll
                for (int j = 0; j < 4; ++j) { e0[j] = __builtin_amdgcn_exp2f(e0[j]); e1[j] = __builtin_amdgcn_exp2f(e1[j]); }
                e0 = e0 + 1.0f; e1 = e1 + 1.0f;
#pragma unroll
                for (int j = 0; j < 4; ++j) { e0[j] = __builtin_amdgcn_rcpf(e0[j]); e1[j] = __builtin_amdgcn_rcpf(e1[j]); }
                const f32x4 v0 = (g0 * u0) * e0, v1 = (g1 * u1) * e1;
                u32x4 w; w.x = cvt_pk_bf16(v0[0], v0[1]); w.y = cvt_pk_bf16(v0[2], v0[3]); w.z = cvt_pk_bf16(v1[0], v1[1]); w.w = cvt_pk_bf16(v1[2], v1[3]);
                *(u32x4*)rowp = w; }
    }
};
}

namespace att {
constexpr int D = 128, NW = 8, QBLK = 32, KVBLK = 64;
constexpr float SCALE = 0.088388347648318440f;
constexpr float THR = 8.f;
constexpr int LDQ = 1024, LDK = 128, LDO = 1024;
constexpr size_t SHM_V = KVBLK * D * 2, SHM_K = KVBLK * D * 2, SHM_ATTN = 2 * SHM_V + 2 * SHM_K + NW * 64 * 4;
#define KSWZ(row, colB) ((row) * 256 + ((colB) ^ (((row) & 7) << 4)))
#define SBAR() __builtin_amdgcn_sched_barrier(0)
__device__ __forceinline__ int crow(int r, int hi) { return (r & 3) + 8 * (r >> 2) + 4 * hi; }
__device__ __forceinline__ unsigned cvtpk(float lo, float hi) { unsigned r; asm volatile("v_cvt_pk_bf16_f32 %0, %1, %2" : "=v"(r) : "v"(lo), "v"(hi)); return r; }

__device__ __forceinline__ void partialSM(f32x16& p0, f32x16& p1, float& m_reg, float& mn, float& alpha) {
  constexpr float C = SCALE * 1.4426950408889634f;
  float pmax = p0[0];
#pragma unroll
  for (int r = 1; r < 16; ++r) pmax = fmaxf(pmax, p0[r]);
#pragma unroll
  for (int r = 0; r < 16; ++r) pmax = fmaxf(pmax, p1[r]);
  { auto rr = __builtin_amdgcn_permlane32_swap(__float_as_uint(pmax), __float_as_uint(pmax), false, false);
    pmax = fmaxf(__uint_as_float(rr[0]), __uint_as_float(rr[1])); }
  if (__builtin_expect(__all(pmax - m_reg <= THR / SCALE), 1)) { mn = m_reg; alpha = 1.f; }
  else { mn = fmaxf(m_reg, pmax); alpha = __builtin_amdgcn_exp2f((m_reg - mn) * C); m_reg = mn; }
  float mnC = -mn * C;
#pragma unroll
  for (int r = 0; r < 16; ++r) p0[r] = fmaf(p0[r], C, mnC);
#pragma unroll
  for (int r = 0; r < 16; ++r) p1[r] = fmaf(p1[r], C, mnC);
#pragma unroll
  for (int r = 0; r < 16; ++r) p0[r] = __builtin_amdgcn_exp2f(p0[r]);
}
__device__ __forceinline__ void finishSM(f32x16& p0, f32x16& p1, float alpha, float& l_reg, bf16x8& pa0, bf16x8& pa1, bf16x8& pa2, bf16x8& pa3) {
#pragma unroll
  for (int r = 0; r < 16; ++r) p1[r] = __builtin_amdgcn_exp2f(p1[r]);
  float ps = 0;
#pragma unroll
  for (int r = 0; r < 16; ++r) ps += p0[r];
#pragma unroll
  for (int r = 0; r < 16; ++r) ps += p1[r];
  { auto rr = __builtin_amdgcn_permlane32_swap(__float_as_uint(ps), __float_as_uint(ps), false, false);
    ps = __uint_as_float(rr[0]) + __uint_as_float(rr[1]); }
  l_reg = l_reg * alpha + ps;
#define PK4(P, BASE, OUT) do { unsigned a0 = cvtpk(P[BASE + 0], P[BASE + 1]), a1 = cvtpk(P[BASE + 2], P[BASE + 3]);   \
    unsigned b0 = cvtpk(P[BASE + 4], P[BASE + 5]), b1 = cvtpk(P[BASE + 6], P[BASE + 7]);                              \
    auto r0 = __builtin_amdgcn_permlane32_swap(a0, b0, false, false); auto r1 = __builtin_amdgcn_permlane32_swap(a1, b1, false, false); \
    u32x4 w = {r0[0], r1[0], r0[1], r1[1]}; OUT = *reinterpret_cast<bf16x8*>(&w); } while (0)
  PK4(p0, 0, pa0); PK4(p0, 8, pa1); PK4(p1, 0, pa2); PK4(p1, 8, pa3);
#undef PK4
}
__device__ __forceinline__ void qkt(f32x16& p0, f32x16& p1, const bf16_t* Ks, const bf16x8* qr, int r32, int hi) {
  p0 = f32x16{}; p1 = f32x16{};
#pragma unroll
  for (int d0 = 0; d0 < 8; ++d0) { int cb = (d0 * 16 + hi * 8) * 2;
    bf16x8 b0 = *reinterpret_cast<const bf16x8*>((const char*)Ks + KSWZ(r32, cb));
    bf16x8 b1 = *reinterpret_cast<const bf16x8*>((const char*)Ks + KSWZ(32 + r32, cb));
    p0 = __builtin_amdgcn_mfma_f32_32x32x16_bf16(b0, qr[d0], p0, 0, 0, 0);
    p1 = __builtin_amdgcn_mfma_f32_32x32x16_bf16(b1, qr[d0], p1, 0, 0, 0); }
}
__device__ __forceinline__ int v_st(int k, int c) { const int kk = (k & ~0xC) | ((k & 4) << 1) | ((k & 8) >> 1); return ((kk >> 3) * 4 + (c >> 5)) * 512 + ((kk & 7) * 32 + (c & 31)) * 2; }
__device__ __forceinline__ int v_rd_base(int lane) { return ((lane & 3) << 3) | (((lane >> 2) & 3) << 6) | (((lane >> 4) & 1) << 5) | (((lane >> 5) & 1) << 8); }
constexpr int v_rd_off(int d0, int ks, int half) { return d0 * 512 + ks * 4096 + half * 2048; }
template <int OFF> __device__ __forceinline__ s16x4 tr_read(int vb) {
  s16x4 r; asm volatile("ds_read_b64_tr_b16 %0, %1 offset:%2" : "=&v"(r) : "v"(vb), "i"(OFF) : "memory"); return r;
}
template <int D0> __device__ __forceinline__ void pv_one(f32x16& od, int vb, bf16x8 pa0, bf16x8 pa1, bf16x8 pa2, bf16x8 pa3) {
  const s16x4 l0 = tr_read<v_rd_off(D0, 0, 0)>(vb), h0 = tr_read<v_rd_off(D0, 0, 1)>(vb), l1 = tr_read<v_rd_off(D0, 1, 0)>(vb), h1 = tr_read<v_rd_off(D0, 1, 1)>(vb);
  const s16x4 l2 = tr_read<v_rd_off(D0, 2, 0)>(vb), h2 = tr_read<v_rd_off(D0, 2, 1)>(vb), l3 = tr_read<v_rd_off(D0, 3, 0)>(vb), h3 = tr_read<v_rd_off(D0, 3, 1)>(vb);
  asm volatile("s_waitcnt lgkmcnt(0)" ::: "memory"); SBAR();
#define PK(L, H) (bf16x8){L[0], L[1], L[2], L[3], H[0], H[1], H[2], H[3]}
  od = __builtin_amdgcn_mfma_f32_32x32x16_bf16(pa0, PK(l0, h0), od, 0, 0, 0);
  od = __builtin_amdgcn_mfma_f32_32x32x16_bf16(pa1, PK(l1, h1), od, 0, 0, 0);
  od = __builtin_amdgcn_mfma_f32_32x32x16_bf16(pa2, PK(l2, h2), od, 0, 0, 0);
  od = __builtin_amdgcn_mfma_f32_32x32x16_bf16(pa3, PK(l3, h3), od, 0, 0, 0);
#undef PK
}
__device__ __forceinline__ void pv_d0(f32x16* o, int vb, bf16x8 pa0, bf16x8 pa1, bf16x8 pa2, bf16x8 pa3) {
  pv_one<0>(o[0], vb, pa0, pa1, pa2, pa3); pv_one<1>(o[1], vb, pa0, pa1, pa2, pa3); pv_one<2>(o[2], vb, pa0, pa1, pa2, pa3); pv_one<3>(o[3], vb, pa0, pa1, pa2, pa3);
}

__device__ __forceinline__ void attn_dense_body(const bf16_t* __restrict__ Qb, const bf16_t* __restrict__ Kh, const bf16_t* __restrict__ Vh,
                                                bf16_t* __restrict__ Ob, int seq, char* lds) {
  const int tid = tid_opaque(), wid = tid >> 6, lane = tid & 63, r32 = lane & 31, hi = lane >> 5;
  bf16_t* V_lds = (bf16_t*)lds; bf16_t* K_lds = (bf16_t*)(lds + 2 * SHM_V);
  float* ws = (float*)(lds + 2 * SHM_V + 2 * SHM_K) + wid * 64; float* li_l = ws; float* al_l = ws + 32;
  float m_reg = -1e30f, l_reg = 0; f32x16 o[4] = {}; bf16x8 qr[8];
  const bf16_t* Qw = Qb + (long)(wid * QBLK + r32) * LDQ + hi * 8;
#pragma unroll
  for (int d0 = 0; d0 < 8; ++d0) qr[d0] = *reinterpret_cast<const bf16x8*>(Qw + d0 * 16);
  const int sr = tid >> 4, sc = (tid & 15) * 8, vst0 = v_st(sr, sc), vst1 = v_st(32 + sr, sc);
  const int vb0 = (int)(uintptr_t)V_lds + v_rd_base(lane);
  struct { bf16x8 vs0, vs1, ks0, ks1; } sr_[2];
#define SLOAD(i, k0) do { sr_[i].vs0 = *reinterpret_cast<const bf16x8*>(&Vh[(long)((k0) + sr) * LDK + sc]); sr_[i].vs1 = *reinterpret_cast<const bf16x8*>(&Vh[(long)((k0) + 32 + sr) * LDK + sc]); \
    sr_[i].ks0 = *reinterpret_cast<const bf16x8*>(&Kh[(long)((k0) + sr) * LDK + sc]); sr_[i].ks1 = *reinterpret_cast<const bf16x8*>(&Kh[(long)((k0) + 32 + sr) * LDK + sc]); } while (0)
#define SWRITE(b, i) do { *(bf16x8*)((char*)V_lds + (b) * SHM_V + vst0) = sr_[i].vs0;          \
    *(bf16x8*)((char*)V_lds + (b) * SHM_V + vst1) = sr_[i].vs1; int kc = sc * 2;               \
    *(bf16x8*)((char*)K_lds + (b) * SHM_K + KSWZ(sr, kc)) = sr_[i].ks0;                       \
    *(bf16x8*)((char*)K_lds + (b) * SHM_K + KSWZ(32 + sr, kc)) = sr_[i].ks1; } while (0)
#define SWAIT() asm volatile("s_waitcnt vmcnt(4)" ::: "memory")
#define RESC(a) do { if (__any((a) < 1.f)) { if (hi == 0) al_l[r32] = (a); asm volatile("s_waitcnt lgkmcnt(0)" ::: "memory"); \
    _Pragma("unroll") for (int d = 0; d < 4; ++d) _Pragma("unroll") for (int r = 0; r < 16; ++r) o[d][r] *= al_l[crow(r, hi)]; } } while (0)
  f32x16 pA0, pA1, pB0, pB1; float mnA, mnB, alA, alB; bf16x8 pa0, pa1, pa2, pa3; const int NT = seq / KVBLK;
  constexpr int SE = 0, SO = 1;
  SLOAD(SE, 0); asm volatile("s_waitcnt vmcnt(0)" ::: "memory"); SWRITE(0, SE); __syncthreads();
  qkt(pA0, pA1, K_lds, qr, r32, hi); partialSM(pA0, pA1, m_reg, mnA, alA);
  SLOAD(SO, KVBLK); if (2 < NT) SLOAD(SE, 2 * KVBLK);
  SWAIT(); SWRITE(1, SO); __syncthreads();
  for (int j = 1; j + 1 < NT; j += 2) {
    SBAR(); qkt(pB0, pB1, (bf16_t*)((char*)K_lds + SHM_K), qr, r32, hi);
    finishSM(pA0, pA1, alA, l_reg, pa0, pa1, pa2, pa3); SBAR();
    SLOAD(SO, (j + 2) * KVBLK); SBAR();
    pv_d0(o, vb0, pa0, pa1, pa2, pa3); partialSM(pB0, pB1, m_reg, mnB, alB);
    __syncthreads(); SWAIT(); SWRITE(0, SE);
    RESC(alB); __syncthreads();
    SBAR(); qkt(pA0, pA1, K_lds, qr, r32, hi);
    finishSM(pB0, pB1, alB, l_reg, pa0, pa1, pa2, pa3); SBAR();
    if (j + 3 < NT) SLOAD(SE, (j + 3) * KVBLK); SBAR();
    pv_d0(o, vb0 + (int)SHM_V, pa0, pa1, pa2, pa3); partialSM(pA0, pA1, m_reg, mnA, alA);
    __syncthreads(); SWAIT(); SWRITE(1, SO);
    RESC(alA); __syncthreads();
  }
  SBAR(); qkt(pB0, pB1, (bf16_t*)((char*)K_lds + SHM_K), qr, r32, hi);
  finishSM(pA0, pA1, alA, l_reg, pa0, pa1, pa2, pa3); SBAR();
  pv_d0(o, vb0, pa0, pa1, pa2, pa3); partialSM(pB0, pB1, m_reg, mnB, alB);
  __syncthreads(); RESC(alB);
  finishSM(pB0, pB1, alB, l_reg, pa0, pa1, pa2, pa3); SBAR();
  pv_d0(o, vb0 + (int)SHM_V, pa0, pa1, pa2, pa3);
  if (hi == 0) li_l[r32] = l_reg; asm volatile("s_waitcnt lgkmcnt(0)" ::: "memory");
  float rli[16];
#pragma unroll
  for (int r = 0; r < 16; ++r) rli[r] = __builtin_amdgcn_rcpf(li_l[crow(r, hi)]);
  bf16_t* Ow = Ob + (long)(wid * QBLK) * LDO;
#pragma unroll
  for (int r = 0; r < 16; ++r) { int orow = crow(r, hi);
#pragma unroll
    for (int d0 = 0; d0 < 4; ++d0) Ow[(long)orow * LDO + d0 * 32 + r32] = (bf16_t)(cvtpk(o[d0][r] * rli[r], 0.f) & 0xffffu); }
  __syncthreads();
#undef SLOAD
#undef SWRITE
#undef SWAIT
#undef RESC
}
}

__device__ __forceinline__ int src_col(int mode, int nd) {
    if (mode == 1) { if (nd < 1024) return nd; const int q = nd - 1024, j = q >> 8, r = q & 255; return r < 128 ? 1024 + 128 * j + r : 2048 + 128 * j + (r - 128); }
    if (mode == 2) { const int j = nd >> 8, r = nd & 255; return r < 128 ? 128 * j + r : DFF + 128 * j + (r - 128); }
    return nd;
}
struct CvtRegs { f32x4 v[4]; };
__device__ __forceinline__ void cvt_load(const float* __restrict__ W, int ldw, int mode, int nkt, int u, int tid, CvtRegs& rg) {
    const int kt = u % nkt, ntile = u / nkt, r = tid >> 3, c4 = (tid & 7) * 4;
    const float* src = W + (size_t)(kt * 64 + r) * ldw + src_col(mode, ntile * 128) + c4;
#pragma unroll
    for (int i = 0; i < 4; ++i) rg.v[i] = *(const f32x4*)(src + 32 * i);
}
__device__ __forceinline__ void cvt_matrix(const float* __restrict__ W, int K, int N, bf16_t* __restrict__ Bt, int mode, int& uoff, float* tile, int wk, int nwk) {
    const int tid = tid_opaque(), nkt = K / 64, nu = nkt * (N / 128);
    const int first = (wk - (uoff % nwk) + nwk) % nwk;
    uoff += nu;
    if (first >= nu) return;
    CvtRegs cur, n1, n2; cvt_load(W, N, mode, nkt, first, tid, cur);
    if (first + nwk < nu) cvt_load(W, N, mode, nkt, first + nwk, tid, n1);
    if (first + 2 * nwk < nu) cvt_load(W, N, mode, nkt, first + 2 * nwk, tid, n2);
    for (int u = first; u < nu; u += nwk) {
        const int r = tid >> 3, c4 = (tid & 7) * 4;
        float* tp = tile + r * 129 + c4;
#pragma unroll
        for (int i = 0; i < 4; ++i) { tp[32 * i + 0] = cur.v[i][0]; tp[32 * i + 1] = cur.v[i][1]; tp[32 * i + 2] = cur.v[i][2]; tp[32 * i + 3] = cur.v[i][3]; }
        __syncthreads();
        cur = n1; n1 = n2;
        if (u + 3 * nwk < nu) cvt_load(W, N, mode, nkt, u + 3 * nwk, tid, n2);
        const int kt = u % nkt, ntile = u / nkt, n = tid >> 2, kc = (tid & 3) * 8;
        const float* rp = tile + kc * 129 + n;
        u32x4 w0, w1;
        w0.x = cvt_pk_bf16(rp[0 * 129], rp[1 * 129]); w0.y = cvt_pk_bf16(rp[2 * 129], rp[3 * 129]); w0.z = cvt_pk_bf16(rp[4 * 129], rp[5 * 129]); w0.w = cvt_pk_bf16(rp[6 * 129], rp[7 * 129]);
        w1.x = cvt_pk_bf16(rp[32 * 129], rp[33 * 129]); w1.y = cvt_pk_bf16(rp[34 * 129], rp[35 * 129]); w1.z = cvt_pk_bf16(rp[36 * 129], rp[37 * 129]); w1.w = cvt_pk_bf16(rp[38 * 129], rp[39 * 129]);
        bf16_t* dst = Bt + (size_t)(ntile * 128 + n) * K + kt * 64 + kc;
        *(u32x4*)dst = w0; *(u32x4*)(dst + 32) = w1;
        __syncthreads();
    }
}

__device__ __forceinline__ void adaln_units(const float* c, const float* c_ctx, const float* ada_w, const float* ada_b, float* MOD, float* lds_f, int& uoff, int l0, int wk, int G) {
    const int tid = tid_opaque();
    float* sv = lds_f;
    float* red = lds_f + 3 * 1024;
    for (int i = tid; i < 3 * 1024; i += NTHREADS) { const int g = i >> 10, k = i & 1023; const float v = g == 0 ? c_ctx[k] : c[(g - 1) * 1024 + k]; sv[i] = silu_f(v); }
    __syncthreads();
    const int nu = 192;
    int first = (wk - (uoff % G) + G) % G;
    const int cq = tid & 7, ks = tid >> 3;
    for (int u = first; u < nu; u += G) {
        const int l = l0, cc = u * 32;
        const float* wp = ada_w + (size_t)l * 1024 * 6144 + cc + cq * 4;
        f32x4 a0 = {0, 0, 0, 0}, a1 = a0, a2 = a0;
#pragma unroll 8
        for (int it = 0; it < 16; ++it) { const int k = ks + 64 * it; const f32x4 w = *(const f32x4*)(wp + (size_t)k * 6144);
            a0 += sv[k] * w; a1 += sv[1024 + k] * w; a2 += sv[2048 + k] * w; }
        float* rp = red + ks * 96 + cq * 4;
#pragma unroll
        for (int j = 0; j < 4; ++j) { rp[j] = a0[j]; rp[32 + j] = a1[j]; rp[64 + j] = a2[j]; }
        __syncthreads();
        if (tid < 96) { float s = 0; for (int q = 0; q < 64; ++q) s += red[q * 96 + tid]; const int g = tid >> 5, n = cc + (tid & 31);
            MOD[((size_t)l * 3 + g) * 6144 + n] = s + ada_b[l * 6144 + n]; }
        __syncthreads();
    }
    uoff += nu;
}

__device__ __forceinline__ void unpack8(const u32x4 w, float* f) { f[0] = bflo(w.x); f[1] = bfhi(w.x); f[2] = bflo(w.y); f[3] = bfhi(w.y); f[4] = bflo(w.z); f[5] = bfhi(w.z); f[6] = bflo(w.w); f[7] = bfhi(w.w); }
__device__ __forceinline__ u32x4 pack8(const float* f) { u32x4 w; w.x = cvt_pk_bf16(f[0], f[1]); w.y = cvt_pk_bf16(f[2], f[3]); w.z = cvt_pk_bf16(f[4], f[5]); w.w = cvt_pk_bf16(f[6], f[7]); return w; }
__device__ __forceinline__ void norm0_phase(const float* __restrict__ xp, const float* __restrict__ xs, const float* __restrict__ nw, const float* __restrict__ scale, bf16_t* __restrict__ XG, float* __restrict__ SSQ, bf16_t* __restrict__ XB) {
    const int tidq = tid_opaque(); const int lane = tidq & 63, wid = tidq >> 6;
    f32x4 wv[4];
#pragma unroll
    for (int j = 0; j < 4; ++j) wv[j] = *(const f32x4*)(nw + j * 256 + lane * 4);
    const int stride = gridDim.x * 8;
    for (int row = blockIdx.x * 8 + wid; row < MT; row += 2 * stride) {
        const int rowb = row + stride < MT ? row + stride : row;
        const float* xa = row < NP ? xp + (size_t)row * DM : xs + (size_t)(row - NP) * DM;
        const float* xb = rowb < NP ? xp + (size_t)rowb * DM : xs + (size_t)(rowb - NP) * DM;
        f32x4 va[4], vb[4];
#pragma unroll
        for (int j = 0; j < 4; ++j) { va[j] = *(const f32x4*)(xa + j * 256 + lane * 4); vb[j] = *(const f32x4*)(xb + j * 256 + lane * 4); }
        const float* sca = scale + (row < NP ? 0 : (row < NP + SEQS ? 1 : 2)) * 6144; const float* scb = scale + (rowb < NP ? 0 : (rowb < NP + SEQS ? 1 : 2)) * 6144;
        float sa = 0, sb = 0;
#pragma unroll
        for (int j = 0; j < 4; ++j) {
            sa += (va[j][0] * va[j][0] + va[j][1] * va[j][1]) + (va[j][2] * va[j][2] + va[j][3] * va[j][3]);
            sb += (vb[j][0] * vb[j][0] + vb[j][1] * vb[j][1]) + (vb[j][2] * vb[j][2] + vb[j][3] * vb[j][3]);
            const f32x4 ha = va[j] * wv[j] * (1.0f + *(const f32x4*)(sca + j * 256 + lane * 4)), hb = vb[j] * wv[j] * (1.0f + *(const f32x4*)(scb + j * 256 + lane * 4));
            u32x2 oa, ob; oa.x = cvt_pk_bf16(ha[0], ha[1]); oa.y = cvt_pk_bf16(ha[2], ha[3]); ob.x = cvt_pk_bf16(hb[0], hb[1]); ob.y = cvt_pk_bf16(hb[2], hb[3]);
            *(u32x2*)(XG + (size_t)row * DM + j * 256 + lane * 4) = oa; *(u32x2*)(XG + (size_t)rowb * DM + j * 256 + lane * 4) = ob;
            u32x2 xa, xb; xa.x = cvt_pk_bf16(va[j][0], va[j][1]); xa.y = cvt_pk_bf16(va[j][2], va[j][3]); xb.x = cvt_pk_bf16(vb[j][0], vb[j][1]); xb.y = cvt_pk_bf16(vb[j][2], vb[j][3]);
            *(u32x2*)(XB + (size_t)row * DM + j * 256 + lane * 4) = xa; *(u32x2*)(XB + (size_t)rowb * DM + j * 256 + lane * 4) = xb; }
        sa = wave_sum(sa); sb = wave_sum(sb);
        if (lane < 16) { SSQ[(size_t)row * 16 + lane] = lane == 0 ? sa : 0.f; SSQ[(size_t)rowb * 16 + lane] = lane == 0 ? sb : 0.f; }
    }
}
__device__ __forceinline__ void sw_rows(const bf16_t* __restrict__ Bt, int N, const float* __restrict__ shift, float* __restrict__ SWo, int wave0, int nwaves) {
    const int lane = tid_opaque() & 63;
    float sh[3][16];
#pragma unroll
    for (int g = 0; g < 3; ++g)
#pragma unroll
        for (int h = 0; h < 2; ++h)
#pragma unroll
            for (int j4 = 0; j4 < 2; ++j4) { const f32x4 t = *(const f32x4*)(shift + g * 6144 + h * 512 + lane * 8 + j4 * 4); sh[g][h * 8 + j4 * 4 + 0] = t[0]; sh[g][h * 8 + j4 * 4 + 1] = t[1]; sh[g][h * 8 + j4 * 4 + 2] = t[2]; sh[g][h * 8 + j4 * 4 + 3] = t[3]; }
    for (int n = wave0; n < N; n += 2 * nwaves) {
        const int n2 = n + nwaves < N ? n + nwaves : n;
        const bf16_t* rp = Bt + (size_t)n * 1024 + lane * 8; const bf16_t* rq = Bt + (size_t)n2 * 1024 + lane * 8;
        const u32x4 a0 = *(const u32x4*)rp, a1 = *(const u32x4*)(rp + 512), b0 = *(const u32x4*)rq, b1 = *(const u32x4*)(rq + 512);
        float w[16], v[16]; unpack8(a0, w); unpack8(a1, w + 8); unpack8(b0, v); unpack8(b1, v + 8);
        float d0 = 0, d1 = 0, d2 = 0, e0 = 0, e1 = 0, e2 = 0;
#pragma unroll
        for (int j = 0; j < 16; ++j) { d0 += sh[0][j] * w[j]; d1 += sh[1][j] * w[j]; d2 += sh[2][j] * w[j]; e0 += sh[0][j] * v[j]; e1 += sh[1][j] * v[j]; e2 += sh[2][j] * v[j]; }
#pragma unroll
        for (int o = 32; o >= 1; o >>= 1) { d0 += __shfl_xor(d0, o); d1 += __shfl_xor(d1, o); d2 += __shfl_xor(d2, o); e0 += __shfl_xor(e0, o); e1 += __shfl_xor(e1, o); e2 += __shfl_xor(e2, o); }
        if (lane == 0) { SWo[n] = d0; SWo[NSW + n] = d1; SWo[2 * NSW + n] = d2; SWo[n2] = e0; SWo[NSW + n2] = e1; SWo[2 * NSW + n2] = e2; }
    }
}
__device__ __forceinline__ void final_norm_phase(const bf16_t* __restrict__ X, const float* __restrict__ SSQ, const float* __restrict__ w, float* __restrict__ out) {
    const int tidq = tid_opaque(); const int lane = tidq & 63, wid = tidq >> 6;
    f32x4 wv[4];
#pragma unroll
    for (int j = 0; j < 4; ++j) wv[j] = *(const f32x4*)(w + j * 256 + lane * 4);
    const int stride = gridDim.x * 8;
    for (int row = blockIdx.x * 8 + wid; row < MT; row += 2 * stride) {
        const int rowb = row + stride < MT ? row + stride : row;
        f32x4 va[4], vb[4];
#pragma unroll
        for (int j = 0; j < 4; ++j) { const u32x2 pa = *(const u32x2*)(X + (size_t)row * DM + j * 256 + lane * 4), pb = *(const u32x2*)(X + (size_t)rowb * DM + j * 256 + lane * 4);
            va[j] = (f32x4){bflo(pa.x), bfhi(pa.x), bflo(pa.y), bfhi(pa.y)}; vb[j] = (f32x4){bflo(pb.x), bfhi(pb.x), bflo(pb.y), bfhi(pb.y)}; }
        float sa = SSQ[(size_t)row * 16 + (lane & 15)], sb = SSQ[(size_t)rowb * 16 + (lane & 15)];
#pragma unroll
        for (int o = 8; o >= 1; o >>= 1) { sa += __shfl_xor(sa, o); sb += __shfl_xor(sb, o); }
        const float ra = 1.0f / sqrtf(sa * (1.0f / 1024.0f) + 1e-6f), rb = 1.0f / sqrtf(sb * (1.0f / 1024.0f) + 1e-6f);
#pragma unroll
        for (int j = 0; j < 4; ++j) { *(f32x4*)(out + (size_t)row * DM + j * 256 + lane * 4) = va[j] * ra * wv[j]; *(f32x4*)(out + (size_t)rowb * DM + j * 256 + lane * 4) = vb[j] * rb * wv[j]; }
    }
}

__device__ __forceinline__ void conv_item_load(const bf16_t* __restrict__ Bb, const bf16_t* __restrict__ Z, long i, u32x4& z0, u32x4& z1, u32x4& z2, u32x4& b) {
    const int row = (int)(i >> 7), c = (int)(i & 127) * 8;
    int t, T; if (row < NP) { t = row & (SEQP - 1); T = SEQP; } else { t = (row - NP) & (SEQS - 1); T = SEQS; }
    const bf16_t* zp = Z + (size_t)row * DM + c;
    const u32x4 zero = {0u, 0u, 0u, 0u};
    z1 = *(const u32x4*)zp; z0 = t > 0 ? *(const u32x4*)(zp - DM) : zero; z2 = t < T - 1 ? *(const u32x4*)(zp + DM) : zero;
    b = *(const u32x4*)(Bb + (size_t)row * DM + c);
}
__device__ __forceinline__ void conv_item_store(const float* __restrict__ cw, bf16_t* __restrict__ A2, long i, const u32x4& z0, const u32x4& z1, const u32x4& z2, const u32x4& b) {
    const int row = (int)(i >> 7), c = (int)(i & 127) * 8;
    float f0[8], f1[8], f2[8], fb[8], o[8];
    unpack8(z0, f0); unpack8(z1, f1); unpack8(z2, f2); unpack8(b, fb);
#pragma unroll
    for (int j = 0; j < 8; ++j) o[j] = fb[j] * (f0[j] * cw[c + j] + f1[j] * cw[1024 + c + j] + f2[j] * cw[2048 + c + j]);
    *(u32x4*)(A2 + (size_t)row * DM + c) = pack8(o);
}
__device__ __forceinline__ void conv_phase(const bf16_t* __restrict__ Bb, const bf16_t* __restrict__ Z, const float* __restrict__ cw, bf16_t* __restrict__ A2) {
    const long total = (long)MT * 128, stride = (long)gridDim.x * NTHREADS;
    for (long i = (long)blockIdx.x * NTHREADS + tid_opaque(); i < total; i += 2 * stride) {
        const long i2 = i + stride < total ? i + stride : i;
        u32x4 a0, a1, a2, ab, c0, c1, c2, cb;
        conv_item_load(Bb, Z, i, a0, a1, a2, ab); conv_item_load(Bb, Z, i2, c0, c1, c2, cb);
        conv_item_store(cw, A2, i, a0, a1, a2, ab); conv_item_store(cw, A2, i2, c0, c1, c2, cb);
    }
}

template <int HW> __device__ __forceinline__ void pool_item(const bf16_t* __restrict__ hp, const float* rl, int t, int T, bf16_t* __restrict__ dp) {
    u32x4 v[2 * HW]; float wgt[2 * HW];
    int cnt = 0;
#pragma unroll
    for (int q = 0; q < 2 * HW; ++q) { const int d = q - HW; const bool ok = (t + d >= 0) && (t + d < T); v[q] = *(const u32x4*)(hp + (long)(ok ? d : 0) * DM); wgt[q] = ok ? rl[d] : 0.f; cnt += ok ? 1 : 0; }
    float s[8], f[8];
#pragma unroll
    for (int j = 0; j < 8; ++j) s[j] = 0.f;
#pragma unroll
    for (int q = 0; q < 2 * HW; ++q) { unpack8(v[q], f);
#pragma unroll
        for (int j = 0; j < 8; ++j) s[j] += f[j] * wgt[q]; }
    unpack8(v[HW], f);
    const float inv = 1.0f / (float)cnt, rt = rl[0];
#pragma unroll
    for (int j = 0; j < 8; ++j) s[j] = s[j] * inv - f[j] * rt;
    *(u32x4*)dp = pack8(s);
}
__device__ __forceinline__ void pool_phase(const bf16_t* __restrict__ XG, const float* __restrict__ SSQ, bf16_t* __restrict__ DIFF, float* lds_f) {
    const int tid = tid_opaque(), wid = tid >> 6, lane = tid & 63, g = wid & 3;
    for (int unit = blockIdx.x; unit < MT / 16; unit += gridDim.x) {
        const int r0 = unit * 16;
        if (tid < 32) { int r = r0 - 8 + tid; r = r < 0 ? 0 : (r > MT - 1 ? MT - 1 : r);
            const f32x4 p0 = *(const f32x4*)(SSQ + (size_t)r * 16), p1 = *(const f32x4*)(SSQ + (size_t)r * 16 + 4), p2 = *(const f32x4*)(SSQ + (size_t)r * 16 + 8), p3 = *(const f32x4*)(SSQ + (size_t)r * 16 + 12);
            const float s = (((p0[0] + p0[1]) + (p0[2] + p0[3])) + ((p1[0] + p1[1]) + (p1[2] + p1[3]))) + (((p2[0] + p2[1]) + (p2[2] + p2[3])) + ((p3[0] + p3[1]) + (p3[2] + p3[3])));
            lds_f[tid] = __builtin_amdgcn_rsqf(s * (1.0f / 1024.0f) + 1e-6f); }
        __syncthreads();
#pragma unroll 1
        for (int pass = 0; pass < 4; ++pass) {
            const int lr = (wid >> 2) * 2 + (lane >> 5) + 4 * pass, row = r0 + lr, c = g * 256 + (lane & 31) * 8;
            int t, T; if (row < NP) { t = row & (SEQP - 1); T = SEQP; } else { t = (row - NP) & (SEQS - 1); T = SEQS; }
            const bf16_t* hp = XG + (size_t)row * DM + c; bf16_t* dp = DIFF + (size_t)row * DM + c; const float* rl = lds_f + lr + 8;
            if (g == 0) pool_item<1>(hp, rl, t, T, dp); else if (g == 1) pool_item<2>(hp, rl, t, T, dp); else if (g == 2) pool_item<4>(hp, rl, t, T, dp); else pool_item<8>(hp, rl, t, T, dp);
        }
        __syncthreads();
    }
}

__device__ __forceinline__ void qkprep_phase(const bf16_t* __restrict__ QKV, const float* __restrict__ qnw, const float* __restrict__ knw, const float* __restrict__ cache_k, const float* __restrict__ cache_v,
                                             bf16_t* __restrict__ Q, bf16_t* __restrict__ KP, bf16_t* __restrict__ VP, bf16_t* __restrict__ KS, bf16_t* __restrict__ VS, float* __restrict__ newk, float* __restrict__ newv) {
    const int tidq = tid_opaque(); const int lane = tidq & 63, wid = tidq >> 6;
    const int half = lane >> 5, i = lane & 31;
    const int d1 = half * 64 + i, d2 = d1 + 32;
    const float qw1 = qnw[d1], qw2 = qnw[d2], kw1 = knw[d1], kw2 = knw[d2];
    const float inv_freq = __builtin_amdgcn_exp2f(-(float)(2 * i) * (13.287712379549449f / 64.0f));
    for (int row = blockIdx.x * 8 + wid; row < MT; row += gridDim.x * 8) {
        const bf16_t* qp = QKV + (size_t)row * NQKV;
        float x1[10], x2[10], vv[2][2];
#pragma unroll
        for (int h = 0; h < 10; ++h) { x1[h] = bf2f(qp[h * 128 + d1]); x2[h] = bf2f(qp[h * 128 + d2]); }
#pragma unroll
        for (int h = 0; h < 2; ++h) { const unsigned t2 = *(const unsigned*)(qp + 1280 + h * 128 + lane * 2); vv[h][0] = bflo(t2); vv[h][1] = bfhi(t2); }
        float cs = 1.f, sn = 0.f; int b, t;
        const bool smp = row >= NP;
        if (smp) { b = (row - NP) >> 12; t = (row - NP) & (SEQS - 1); const float pos = (float)(half == 0 ? (t >> 6) : (t & 63)); const float ang = pos * inv_freq;
            const float nrev = rintf(ang * 0.15915494309189535f); float rr = fmaf(nrev, -6.28318548202514648f, ang); rr = fmaf(nrev, 1.74845553146951715e-07f, rr); sn = __sinf(rr); cs = __cosf(rr); }
        else { b = row >> 8; t = row & (SEQP - 1); }
        float ss[10];
#pragma unroll
        for (int h = 0; h < 10; ++h) ss[h] = x1[h] * x1[h] + x2[h] * x2[h];
#pragma unroll
        for (int o = 32; o >= 1; o >>= 1) {
#pragma unroll
            for (int h = 0; h < 10; ++h) ss[h] += __shfl_xor(ss[h], o); }
#pragma unroll
        for (int h = 0; h < 10; ++h) {
            const float rstd = 1.0f / sqrtf(ss[h] * (1.0f / 128.0f) + 1e-6f);
            const float a1 = x1[h] * rstd * (h < 8 ? qw1 : kw1), a2 = x2[h] * rstd * (h < 8 ? qw2 : kw2);
            if (!smp && h >= 8) { const size_t o = (((size_t)b * 2 + (h - 8)) * SEQP + t) * 128; newk[o + d1] = a1; newk[o + d2] = a2; }
            const float y1 = a1 * cs - a2 * sn, y2 = a2 * cs + a1 * sn;
            const bf16_t o1 = (bf16_t)(cvt_pk_bf16(y1, 0.f) & 0xffffu), o2 = (bf16_t)(cvt_pk_bf16(y2, 0.f) & 0xffffu);
            if (h < 8) { bf16_t* dst = Q + (size_t)row * DM + h * 128; dst[d1] = o1; dst[d2] = o2; }
            else { bf16_t* dst = smp ? KS + (((size_t)b * 2 + (h - 8)) * SKV_S + PAST + t) * 128 : KP + (((size_t)b * 2 + (h - 8)) * SEQP + t) * 128; dst[d1] = o1; dst[d2] = o2; }
        }
#pragma unroll
        for (int h = 0; h < 2; ++h) {
            if (!smp) { const size_t o = (((size_t)b * 2 + h) * SEQP + t) * 128 + lane * 2; *(float2*)(newv + o) = make_float2(vv[h][0], vv[h][1]); }
            bf16_t* dst = smp ? VS + (((size_t)b * 2 + h) * SKV_S + PAST + t) * 128 : VP + (((size_t)b * 2 + h) * SEQP + t) * 128;
            *(unsigned*)(dst + lane * 2) = cvt_pk_bf16(vv[h][0], vv[h][1]);
        }
    }
    const int ncr = 2 * 2 * PAST;
    for (int r = blockIdx.x * 8 + wid; r < 2 * ncr; r += gridDim.x * 8) {
        const bool isv = r >= ncr; const int rr = isv ? r - ncr : r; const int bh = rr >> 8, p = rr & 255;
        const float* src = (isv ? cache_v : cache_k) + ((size_t)bh * PAST + p) * 128 + lane * 2;
        bf16_t* dst = (isv ? VS : KS) + ((size_t)bh * SKV_S + p) * 128 + lane * 2;
        *(unsigned*)dst = cvt_pk_bf16(src[0], src[1]);
    }
}

__device__ __forceinline__ void attn_phase(const bf16_t* Q, const bf16_t* KP, const bf16_t* VP, const bf16_t* KS, const bf16_t* VS, bf16_t* O, char* lds) {
    for (int u = blockIdx.x; u < 384; u += gridDim.x) {
        if (u < 256) { const int b = u >> 7, h = (u >> 4) & 7, qb = u & 15, kvh = h >> 2;
            const size_t row0 = (size_t)NP + (size_t)b * SEQS + qb * 256;
            const size_t ko = ((size_t)b * 2 + kvh) * SKV_S * 128;
            att::attn_dense_body(Q + row0 * DM + h * 128, KS + ko, VS + ko, O + row0 * DM + h * 128, SKV_S, lds);
        } else { const int v = u - 256, b = v >> 3, h = v & 7, kvh = h >> 2;
            const size_t row0 = (size_t)b * SEQP;
            const size_t ko = ((size_t)b * 2 + kvh) * SEQP * 128;
            att::attn_dense_body(Q + row0 * DM + h * 128, KP + ko, VP + ko, O + row0 * DM + h * 128, SEQP, lds);
        }
    }
}

#define XB_TMO      128
#define XB_XCNT(j)  (256  + 64 * (j))
#define XB_XSUB(j)  (1280 + 64 * (j))
#define XB_XGEN(j)  (2304 + 64 * (j))
#define XB_TOP      3328
#define XB_TOPGEN   3392
#define XCD_BAR_WORDS 3456
#define XB_SPIN_CAP (1u << 18)

__device__ __forceinline__ unsigned xb_ld(unsigned* p)              { return __hip_atomic_load(p, __ATOMIC_RELAXED, __HIP_MEMORY_SCOPE_AGENT); }
__device__ __forceinline__ unsigned xb_add(unsigned* p, unsigned v) { return __hip_atomic_fetch_add(p, v, __ATOMIC_RELAXED, __HIP_MEMORY_SCOPE_AGENT); }
__device__ __forceinline__ unsigned xb_xcc_id() { return (unsigned)__builtin_amdgcn_s_getreg((3 << 11) | 20) & 0xFu; }
#define XB_SPIN(cond, bar) do { unsigned _sp = 0; while (cond) { __builtin_amdgcn_s_sleep(1); \
    if ((++_sp & 255u) == 0u) { if (xb_ld(&(bar)[XB_TMO])) break; if (_sp > XB_SPIN_CAP) { atomicAdd(&(bar)[XB_TMO], 1u); break; } } } } while (0)

struct XcdBarrier {
    unsigned* bar; unsigned x;
    volatile LAS unsigned* st;
};

__device__ __forceinline__ XcdBarrier xcd_barrier_post(unsigned* bar, volatile LAS unsigned* st) {
    XcdBarrier b; b.bar = bar; b.x = xb_xcc_id(); b.st = st;
    if (threadIdx.x == 0) (void)xb_add(&bar[XB_XCNT(b.x)], 1u);
    return b;
}
__device__ __forceinline__ void xcd_barrier_complete(unsigned* bar, unsigned x, unsigned& nloc, unsigned& nx) {
    const unsigned G = gridDim.x * gridDim.y * gridDim.z;
    unsigned sum, cnt, mine, sp = 0u;
    for (;;) {
        sum = 0u; cnt = 0u; mine = 0u;
#pragma unroll
        for (unsigned j = 0; j < 16; ++j) { const unsigned c = xb_ld(&bar[XB_XCNT(j)]); sum += c; cnt += (c > 0u) ? 1u : 0u; mine = (j == x) ? c : mine; }
        if (sum == G) break;
        __builtin_amdgcn_s_sleep(1);
        if ((++sp & 255u) == 0u) { if (xb_ld(&bar[XB_TMO])) break; if (sp > XB_SPIN_CAP) { atomicAdd(&bar[XB_TMO], 1u); break; } }
    }
    nloc = mine > 0u ? mine : 1u; nx = cnt > 0u ? cnt : 1u;
}

__device__ __forceinline__ void xcd_barrier(const XcdBarrier& b) {
    asm volatile("s_waitcnt vmcnt(0)" ::: "memory");
    __syncthreads();
    if (threadIdx.x == 0) {
        unsigned* bar = b.bar;
        __builtin_amdgcn_s_waitcnt(0);
        unsigned nloc = b.st[0], nx = b.st[1];
        if (nloc == 0u) { xcd_barrier_complete(bar, b.x, nloc, nx); b.st[0] = nloc; b.st[1] = nx; }
        const unsigned old = xb_add(&bar[XB_XSUB(b.x)], 1u);
        const unsigned gen = old / nloc;
        if (old + 1u == (gen + 1u) * nloc) {
            __builtin_amdgcn_fence(__ATOMIC_RELEASE, "agent");
            asm volatile("s_waitcnt vmcnt(0)" ::: "memory");
            const unsigned og = xb_add(&bar[XB_TOP], 1u);
            const unsigned tg = og / nx;
            if (og + 1u == (tg + 1u) * nx) xb_add(&bar[XB_TOPGEN], 1u);
            else XB_SPIN(xb_ld(&bar[XB_TOPGEN]) == tg, bar);
            __builtin_amdgcn_fence(__ATOMIC_ACQUIRE, "agent");
            xb_add(&bar[XB_XGEN(b.x)], 1u);
            asm volatile("s_waitcnt vmcnt(0)" ::: "memory");
        } else {
            XB_SPIN(xb_ld(&bar[XB_XGEN(b.x)]) == gen, bar);
            __builtin_amdgcn_fence(__ATOMIC_ACQUIRE, "agent");
            asm volatile("s_waitcnt vmcnt(0)" ::: "memory");
        }
    }
    __syncthreads();
}


constexpr int NPH = 2 + 8 * 4 + 1;

typedef const __attribute__((address_space(4))) Params* KPtr;
__device__ __forceinline__ KPtr kargs() { KPtr q = (KPtr)__builtin_amdgcn_kernarg_segment_ptr(); asm volatile("" : "+s"(q)); return q; }
#define WSP(T, off) ((T*)(q->ws + (off)))

__global__ void __launch_bounds__(NTHREADS, 2) fwd_megakernel(Params p) {
    extern __shared__ __attribute__((aligned(16))) unsigned char lds_raw[];
    LAS unsigned char* lds = (LAS unsigned char*)lds_raw;
    cg::grid_group grid = cg::this_grid();
    const int ph_lo = p.ph_lo, ph_hi = p.ph_hi;
    int ph = 0; bool need_sync = false;
    if (ph_lo < 0) grid.sync();
    volatile LAS unsigned* bst = (volatile LAS unsigned*)(lds + 131072 + 2048);
    if (threadIdx.x < 4) bst[threadIdx.x] = 0u;
    __syncthreads();
    XcdBarrier bar; bar.bar = (unsigned*)(p.ws + WS_BAR); bar.x = 0; bar.st = bst;
    if (ph_hi - ph_lo > 1) bar = xcd_barrier_post((unsigned*)(p.ws + WS_BAR), bst);
    if (threadIdx.x == 0) { bst[3] = blockIdx.x; if (ph_hi - ph_lo > 1) bst[2] = xb_add(&((unsigned*)(p.ws + WS_BAR))[3460 + 64 * bar.x], 1u); }
    __syncthreads();
#define PHASE_BEGIN_R(R) if (ph >= ph_lo && ph < ph_hi) { _Pragma("unroll 1") for (int rep_ = 0; rep_ < (R); ++rep_) { if (need_sync) xcd_barrier(bar); need_sync = true; KPtr q = kargs();
#define PHASE_BEGIN PHASE_BEGIN_R(1)
#define PHASE_END } } ++ph;

    PHASE_BEGIN_R(REP_PREP)
    {
        int uoff = 0; float* lf = (float*)lds_raw;
        adaln_units(q->in[4], q->in[5], q->in[8], q->in[9], WSP(float, WS_MOD), lf, uoff, 0, blockIdx.x, gridDim.x);
        cvt_matrix(q->in[10], 1024, 3072, WSP(bf16_t, WS_CIN), 1, uoff, lf, blockIdx.x, gridDim.x);
        cvt_matrix(q->in[12], 1024, 1024, WSP(bf16_t, WS_COUT), 0, uoff, lf, blockIdx.x, gridDim.x);
        cvt_matrix(q->in[19], 1024, 5632, WSP(bf16_t, WS_FIN), 2, uoff, lf, blockIdx.x, gridDim.x);
        cvt_matrix(q->in[20], 2816, 1024, WSP(bf16_t, WS_FOUT), 0, uoff, lf, blockIdx.x, gridDim.x);
    }
    PHASE_END
    PHASE_BEGIN_R(REP_NORM)
    {
        if (threadIdx.x == 0 && ph_hi - ph_lo > 1) {
            unsigned* bw = (unsigned*)(q->ws + WS_BAR); const unsigned per = gridDim.x >> 3; bool ok = (gridDim.x & 7u) == 0u && bar.x < 8u;
            for (unsigned jx = 0; jx < 8; ++jx) ok = ok && (xb_ld(&bw[3460 + 64 * jx]) == per);
            if (ok) bst[3] = bst[2] * 8u + bar.x;
        }
        const float* MOD = WSP(float, WS_MOD); float* SW = WSP(float, WS_SW);
        norm0_phase(q->in[0], q->in[1], q->in[6], MOD + 1 * 1024, WSP(bf16_t, WS_H), WSP(float, WS_SSQ), WSP(bf16_t, WS_X));
        const int w0 = blockIdx.x * 8 + (tid_opaque() >> 6), nw = gridDim.x * 8;
        sw_rows(WSP(bf16_t, WS_CIN), 3072, MOD + 0 * 1024, SW + 0, w0, nw);
        sw_rows(WSP(bf16_t, WS_FIN), 5632, MOD + 3 * 1024, SW + 7680, w0, nw);
    }
    PHASE_END

#pragma unroll 1
    for (int hl = 0; hl < 8; ++hl) {
        const int layer = hl >> 1, part = hl & 1, kind = layer % 3, j = layer / 3;
        if (part == 1) {
            PHASE_BEGIN_R(REP_FIN)
            pg8::Gemm g{WSP(bf16_t, WS_H), WSP(bf16_t, WS_FIN) + (size_t)layer * 5632 * 1024, MT, 5632, 1024, 1024, 0}; pg8::StaticOrder S; S.init(g.M, g.N, gridDim.x, (int)__builtin_amdgcn_readfirstlane(bst[3]), 64 * MF_FIN);
            pg8::gemm_phase<MF_FIN>(lds, g, S, pg8::EpiSwiglu<MF_FIN>{WSP(bf16_t, WS_ACT), WSP(float, WS_SSQ), WSP(float, WS_SW) + 7680 + layer * 5632});
            {
                const int nlast = (MT / (64 * MF_FIN)) * 22 % (int)gridDim.x;
                const int vc = (int)__builtin_amdgcn_readfirstlane(bst[3]);
                if (layer < 3 && nlast > 0 && vc >= nlast) {
                    KPtr q2 = kargs(); int uoff = 0; float* lf = (float*)lds_raw; const int wk = vc - nlast, nwk = gridDim.x - nlast, ln = layer + 1;
                    adaln_units(q2->in[4], q2->in[5], q2->in[8], q2->in[9], (float*)(q2->ws + WS_MOD), lf, uoff, ln, wk, nwk);
                    if (ln == 1) {
#pragma unroll 1
                        for (int gq = 0; gq < 4; ++gq) cvt_matrix(q2->in[13] + (size_t)gq * 65536, 256, 256, (bf16_t*)(q2->ws + WS_POOL) + (size_t)gq * 65536, 0, uoff, lf, wk, nwk);
                    } else if (ln == 2) {
                        cvt_matrix(q2->in[15], 1024, 1536, (bf16_t*)(q2->ws + WS_QKVW), 0, uoff, lf, wk, nwk);
                        cvt_matrix(q2->in[18], 1024, 1024, (bf16_t*)(q2->ws + WS_AOUT), 0, uoff, lf, wk, nwk);
                    } else {
                        cvt_matrix(q2->in[10] + (size_t)1024 * 3072, 1024, 3072, (bf16_t*)(q2->ws + WS_CIN) + (size_t)3072 * 1024, 1, uoff, lf, wk, nwk);
                        cvt_matrix(q2->in[12] + (size_t)1024 * 1024, 1024, 1024, (bf16_t*)(q2->ws + WS_COUT) + (size_t)1024 * 1024, 0, uoff, lf, wk, nwk);
                    }
                    cvt_matrix(q2->in[19] + (size_t)ln * 1024 * 5632, 1024, 5632, (bf16_t*)(q2->ws + WS_FIN) + (size_t)ln * 5632 * 1024, 2, uoff, lf, wk, nwk);
                    cvt_matrix(q2->in[20] + (size_t)ln * 2816 * 1024, 2816, 1024, (bf16_t*)(q2->ws + WS_FOUT) + (size_t)ln * 1024 * 2816, 0, uoff, lf, wk, nwk);
                }
            }
            PHASE_END
        } else if (kind == 0) {
            PHASE_BEGIN_R(REP_CIN)
            pg8::Gemm g{WSP(bf16_t, WS_H), WSP(bf16_t, WS_CIN) + (size_t)j * 3072 * 1024, MT, 3072, 1024, 1024, 0}; pg8::StaticOrder S; S.init(g.M, g.N, gridDim.x, (int)__builtin_amdgcn_readfirstlane(bst[3]), 64 * MF_CIN);
            pg8::gemm_phase<MF_CIN>(lds, g, S, pg8::EpiConvIn<MF_CIN>{WSP(bf16_t, WS_BB), WSP(bf16_t, WS_Z), WSP(float, WS_SSQ), WSP(float, WS_SW) + j * 3072});
            PHASE_END
        } else if (kind == 1) {
            PHASE_BEGIN_R(REP_EW)
            pool_phase(WSP(bf16_t, WS_H), WSP(float, WS_SSQ), WSP(bf16_t, WS_A2), (float*)lds_raw);
            PHASE_END
        } else {
            PHASE_BEGIN
            pg8::Gemm g{WSP(bf16_t, WS_H), WSP(bf16_t, WS_QKVW), MT, NQKV, 1024, 1024, 0}; pg8::StaticOrder S; S.init(g.M, g.N, gridDim.x, (int)__builtin_amdgcn_readfirstlane(bst[3]), 64 * MF_QKV);
            pg8::gemm_phase<MF_QKV>(lds, g, S, pg8::EpiBf16N<MF_QKV>{WSP(bf16_t, WS_QKV), NQKV, WSP(float, WS_SSQ), WSP(float, WS_SW) + 6144});
            PHASE_END
        }
        if (part == 0 && kind == 0) {
            PHASE_BEGIN_R(REP_EW)
            conv_phase(WSP(bf16_t, WS_BB), WSP(bf16_t, WS_Z), q->in[11] + (size_t)j * 3 * 1024, WSP(bf16_t, WS_A2));
            PHASE_END
        } else if (part == 0 && kind == 2) {
            PHASE_BEGIN_R(REP_EW)
            float* new_k = q->out + (size_t)MT * DM; float* new_v = new_k + 16 * 2 * 256 * 128;
            qkprep_phase(WSP(bf16_t, WS_QKV), q->in[16] + j * 128, q->in[17] + j * 128, q->in[2], q->in[3], WSP(bf16_t, WS_Q), WSP(bf16_t, WS_KP), WSP(bf16_t, WS_VP), WSP(bf16_t, WS_KS), WSP(bf16_t, WS_VS), new_k, new_v);
            PHASE_END
        } else { ++ph; }
        if (part == 0 && kind == 2) {
            PHASE_BEGIN_R(REP_ATT)
            attn_phase(WSP(bf16_t, WS_Q), WSP(bf16_t, WS_KP), WSP(bf16_t, WS_VP), WSP(bf16_t, WS_KS), WSP(bf16_t, WS_VS), WSP(bf16_t, WS_A2), (char*)lds_raw);
            PHASE_END
        } else { ++ph; }
        PHASE_BEGIN_R(part ? REP_FOUT : REP_MIXOUT)
        {
            const float* MOD = WSP(float, WS_MOD);
            const float* modl = MOD + (size_t)layer * 3 * 6144;
            pg8::Gemm g; const float* cs = nullptr;
            if (part == 1) g = pg8::Gemm{WSP(bf16_t, WS_ACT), WSP(bf16_t, WS_FOUT) + (size_t)layer * 1024 * 2816, MT, 1024, DFF, DFF, 0};
            else if (kind == 0) g = pg8::Gemm{WSP(bf16_t, WS_A2), WSP(bf16_t, WS_COUT) + (size_t)j * 1024 * 1024, MT, 1024, 1024, 1024, 0};
            else if (kind == 1) { g = pg8::Gemm{WSP(bf16_t, WS_A2), WSP(bf16_t, WS_POOL), MT, 1024, 256, 1024, 256}; cs = q->in[14] + j * 1024; }
            else g = pg8::Gemm{WSP(bf16_t, WS_A2), WSP(bf16_t, WS_AOUT), MT, 1024, 1024, 1024, 0};
            pg8::StaticOrder S; S.init(g.M, g.N, gridDim.x, (int)__builtin_amdgcn_readfirstlane(bst[3]), 64 * MF_RES);
            const float* nw = part == 0 ? q->in[7] + layer * 1024 : q->in[6] + (layer + 1) * 1024;
            const float* nsc = part == 0 ? modl + 4 * 1024 : modl + 3 * 6144 + 1 * 1024;
            bf16_t* xg = hl == 7 ? nullptr : WSP(bf16_t, WS_H);
            bf16_t* xo = rep_ + 1 < (part ? REP_FOUT : REP_MIXOUT) ? WSP(bf16_t, WS_X2) : WSP(bf16_t, WS_X);
            pg8::gemm_phase<MF_RES>(lds, g, S, pg8::EpiResid<MF_RES>{WSP(bf16_t, WS_X), xo, modl + (part ? 5 : 2) * 1024, cs, xg, WSP(float, WS_SSQ), nw, nsc});
            if (part == 1 && layer < 3) {
                const int ln = layer + 1; float* SW = WSP(float, WS_SW); const float* modn = MOD + (size_t)ln * 3 * 6144;
                const int w0 = blockIdx.x * 8 + (tid_opaque() >> 6), nwv = gridDim.x * 8;
                if (ln == 2) sw_rows(WSP(bf16_t, WS_QKVW), 1536, modn, SW + 6144, w0, nwv);
                else if (ln == 3) sw_rows(WSP(bf16_t, WS_CIN) + (size_t)3072 * 1024, 3072, modn, SW + 3072, w0, nwv);
                sw_rows(WSP(bf16_t, WS_FIN) + (size_t)ln * 5632 * 1024, 5632, modn + 3 * 1024, SW + 7680 + ln * 5632, w0, nwv);
            }
        }
        PHASE_END
    }
    PHASE_BEGIN_R(REP_NORM)
    final_norm_phase(WSP(bf16_t, WS_X), WSP(float, WS_SSQ), q->in[21], q->out);
    PHASE_END
#ifdef EXTRA_SYNCS
    if (ph_hi - ph_lo > 1) { for (int i_ = 0; i_ < EXTRA_SYNCS; ++i_) xcd_barrier(bar); }
#endif
#undef PHASE_BEGIN
#undef PHASE_END
}

extern "C" void kernel_launch(void* const* d_in, const int* in_sizes, int n_in, void* d_out, int out_size, void* d_ws, size_t ws_size, hipStream_t stream) {
    static int grid = 0;
    if (grid == 0) {
        if (n_in != 22 || ws_size < WS_END) { fprintf(stderr, "kernel_launch: unexpected n_in %d / ws %zu (need %zu)\n", n_in, ws_size, (size_t)WS_END); grid = -1; return; }
        int dev = 0, cus = 0, per_cu = 0;
        hipGetDevice(&dev);
        hipDeviceGetAttribute(&cus, hipDeviceAttributeMultiprocessorCount, dev);
        if (hipFuncSetAttribute((const void*)fwd_megakernel, hipFuncAttributeMaxDynamicSharedMemorySize, LDS_BYTES) != hipSuccess) { fprintf(stderr, "kernel_launch: hipFuncSetAttribute failed\n"); grid = -1; return; }
        if (hipOccupancyMaxActiveBlocksPerMultiprocessor(&per_cu, (const void*)fwd_megakernel, NTHREADS, LDS_BYTES) != hipSuccess || per_cu < 1) { fprintf(stderr, "kernel_launch: occupancy query gave %d\n", per_cu); per_cu = 1; }
        (void)hipGetLastError();
        grid = cus * per_cu;
        fprintf(stderr, "kernel_launch: grid %d (cus %d x %d)\n", grid, cus, per_cu);
    }
    if (grid < 0) return;
    Params p{};
    for (int i = 0; i < 22; ++i) p.in[i] = (const float*)d_in[i];
    p.out = (float*)d_out; p.ws = (unsigned char*)d_ws;
#if MK_MULTI
    for (int ph = 0; ph < NPH; ++ph) {
        p.ph_lo = ph; p.ph_hi = ph + 1;
        hipLaunchKernelGGL(fwd_megakernel, dim3(grid), dim3(NTHREADS), LDS_BYTES, stream, p);
    }
#else
    p.ph_lo = 0; p.ph_hi = NPH;
    (void)hipMemsetAsync((char*)d_ws + WS_BAR, 0, 16384, stream);
    void* args[] = {&p};
    hipError_t e = hipLaunchCooperativeKernel((const void*)fwd_megakernel, dim3(grid), dim3(NTHREADS), args, LDS_BYTES, stream);
    if (e != hipSuccess) fprintf(stderr, "kernel_launch: cooperative launch failed: %s (grid %d)\n", hipGetErrorString(e), grid);
#endif
}
```
